# Optimizing an MI355X kernel written in HIP

```python
import jax, jax.numpy as jnp
from jax import lax
import numpy as np

D_MODEL = 1024
BATCH = 4
SEQ = 8192
DEPTH = 2

GRID_W = 64
CTX_LEN = 256
MIX_W = D_MODEL
LRU_W = MIX_W // 2
LRU_HEADS = 8
LRU_HD = LRU_W // LRU_HEADS
CONV_W = MIX_W // 4
FFT_W = MIX_W - LRU_W - CONV_W
FFT_GROUPS = 4
FFT_GD = FFT_W // FFT_GROUPS
LRU_CONV_K = 4
LRU_CONV_LEFT = 1
SHORT_CONV_K = 3
SHORT_CONV_LEFT = 1
LRU_C = 8.0
IN_COLS = 2 * LRU_W + 3 * CONV_W + FFT_W
N_EXPERTS = 16
EXPERT_FF = D_MODEL
CAPACITY_FACTOR = 2
EPS = 1e-6

kernel_name = 'hybrid_lru_conv_fourier_ec_moe_dit'


def rmsnorm(x, g):
    xf = x.astype(jnp.float32)
    y = xf * lax.rsqrt(jnp.mean(xf * xf, axis=-1, keepdims=True) + EPS)
    return (y * g.astype(jnp.float32)).astype(x.dtype)


def modulate(h, shift, scale):
    return h * (1 + scale) + shift


def shift_conv(u, w, left, axis):
    k_w = w.shape[0]
    n = u.shape[axis]
    pad = [(0, 0)] * u.ndim
    pad[axis] = (left, k_w - 1 - left)
    up = jnp.pad(u, pad)
    out = w[0] * lax.slice_in_dim(up, 0, n, axis=axis)
    for k in range(1, k_w):
        out = out + w[k] * lax.slice_in_dim(up, k, k + n, axis=axis)
    return out


def conv_seq(u, w, left):
    return shift_conv(u, w, left, axis=1)


def conv_grid(u, w, left):
    b, n, ch = u.shape
    rows = n // GRID_W
    return shift_conv(u.reshape(b, rows, GRID_W, ch), w, left, axis=2).reshape(b, n, ch)


def rglru_coeffs(u, w_r, b_r, w_i, b_i, lam):
    b, n, _ = u.shape
    uh = u.astype(jnp.float32).reshape(b, n, LRU_HEADS, LRU_HD)
    r = jax.nn.sigmoid(jnp.einsum('blhi,hij->blhj', uh, w_r.astype(jnp.float32)).reshape(b, n, LRU_W) + b_r.astype(jnp.float32))
    i = jax.nn.sigmoid(jnp.einsum('blhi,hij->blhj', uh, w_i.astype(jnp.float32)).reshape(b, n, LRU_W) + b_i.astype(jnp.float32))
    log_a = -LRU_C * r * jax.nn.softplus(-lam.astype(jnp.float32))
    a = jnp.exp(log_a)
    inp = jnp.sqrt(-jnp.expm1(2.0 * log_a)) * (i * uh.reshape(b, n, LRU_W))
    return a, inp


def _combine(left, right):
    a1, b1 = left
    a2, b2 = right
    return a1 * a2, a2 * b1 + b2


def linear_scan(a, b, h0):
    b = b.at[:, 0].add(a[:, 0] * h0)
    _, h = lax.associative_scan(_combine, (a, b), axis=1)
    return h


def lru_states(u, w_r, b_r, w_i, b_i, lam, h0_f, h0_b):
    a, b = rglru_coeffs(u, w_r[0], b_r[0], w_i[0], b_i[0], lam[0])
    h_f = linear_scan(a, b, h0_f)
    a, b = rglru_coeffs(u, w_r[1], b_r[1], w_i[1], b_i[1], lam[1])
    h_b = jnp.flip(linear_scan(jnp.flip(a, 1), jnp.flip(b, 1), h0_b), 1)
    return h_f, h_b


def fourier_mix(u):
    b, n, w = u.shape
    uf = u.astype(jnp.float32).reshape(b, n, FFT_GROUPS, FFT_GD)
    y = jnp.real(jnp.fft.fftn(uf, axes=(1, 3), norm='ortho'))
    return y.reshape(b, n, w).astype(u.dtype)


def mixer_out(p, h_f, h_b, conv_fn, sc_w, g_out, w_out):
    o = 2 * LRU_W
    lru_g = p[..., LRU_W:o]
    sc_b = p[..., o:o + CONV_W]
    sc_c = p[..., o + CONV_W:o + 2 * CONV_W]
    sc_x = p[..., o + 2 * CONV_W:o + 3 * CONV_W]
    fft_x = p[..., o + 3 * CONV_W:]
    y_lru = ((h_f + h_b) * jax.nn.gelu(lru_g.astype(jnp.float32))).astype(p.dtype)
    y_sc = sc_b * conv_fn(sc_c * sc_x, sc_w, SHORT_CONV_LEFT)
    y_fft = fourier_mix(fft_x)
    y = jnp.concatenate([
        rmsnorm(y_lru, g_out[:LRU_W]),
        rmsnorm(y_sc, g_out[LRU_W:LRU_W + CONV_W]),
        rmsnorm(y_fft, g_out[LRU_W + CONV_W:]),
    ], axis=-1)
    return y @ w_out


def expert_choice_ffn(h, w_router, w_gate, w_up, w_down):
    b, n, d = h.shape
    cap = CAPACITY_FACTOR * n // N_EXPERTS
    logits = jnp.einsum('bld,de->ble', h, w_router).astype(jnp.float32)
    aff = jax.nn.softmax(logits, axis=-1)
    g, idx = lax.top_k(jnp.swapaxes(aff, 1, 2), cap)
    xs = jax.vmap(lambda hb, ib: hb[ib])(h, idx)
    hid = jax.nn.silu(jnp.einsum('becd,edf->becf', xs, w_gate)) * jnp.einsum('becd,edf->becf', xs, w_up)
    ys = jnp.einsum('becf,efd->becd', hid, w_down) * g[..., None].astype(hid.dtype)
    return jax.vmap(lambda ib, yb: jnp.zeros((n, d), yb.dtype).at[ib.reshape(-1)].add(yb.reshape(-1, d)))(idx, ys)


def setup_inputs(seed: int = 0) -> dict:
    key = jax.random.key(seed)
    ks = jax.random.split(key, 26)
    f32 = jnp.float32
    nrm = lambda k, shape, s: jax.random.normal(k, shape, f32) * s
    u = jax.random.uniform(ks[14], (DEPTH, 2, LRU_W), f32, 0.9, 0.999)
    a0 = u ** (1.0 / LRU_C)
    lam = jnp.log(a0) - jnp.log1p(-a0)
    return {
        'x': nrm(ks[0], (BATCH, SEQ, D_MODEL), 1.0),
        'c': nrm(ks[1], (BATCH, D_MODEL), 1.0),
        'ctx': nrm(ks[2], (BATCH, CTX_LEN, D_MODEL), 1.0),
        'c_ctx': nrm(ks[3], (D_MODEL,), 1.0),
        'w_ada': nrm(ks[4], (DEPTH, D_MODEL, 6 * D_MODEL), 0.5 * D_MODEL ** -0.5),
        'b_ada': nrm(ks[5], (DEPTH, 6 * D_MODEL), 0.02),
        'g_norm1': 1.0 + nrm(ks[6], (DEPTH, D_MODEL), 0.05),
        'w_in': nrm(ks[7], (DEPTH, D_MODEL, IN_COLS), D_MODEL ** -0.5),
        'lru_conv_w': nrm(ks[8], (DEPTH, LRU_CONV_K, LRU_W), LRU_CONV_K ** -0.5),
        'lru_conv_b': nrm(ks[9], (DEPTH, LRU_W), 0.02),
        'lru_wr': nrm(ks[10], (DEPTH, 2, LRU_HEADS, LRU_HD, LRU_HD), LRU_HD ** -0.5),
        'lru_br': nrm(ks[11], (DEPTH, 2, LRU_W), 0.02),
        'lru_wi': nrm(ks[12], (DEPTH, 2, LRU_HEADS, LRU_HD, LRU_HD), LRU_HD ** -0.5),
        'lru_bi': nrm(ks[13], (DEPTH, 2, LRU_W), 0.02),
        'lru_lam': lam,
        'sc_conv_w': nrm(ks[15], (DEPTH, SHORT_CONV_K, CONV_W), SHORT_CONV_K ** -0.5),
        'g_out': 1.0 + nrm(ks[16], (DEPTH, MIX_W), 0.05),
        'w_out': nrm(ks[17], (DEPTH, MIX_W, D_MODEL), MIX_W ** -0.5),
        'g_norm2': 1.0 + nrm(ks[18], (DEPTH, D_MODEL), 0.05),
        'w_router': nrm(ks[19], (DEPTH, D_MODEL, N_EXPERTS), D_MODEL ** -0.5),
        'w_gate_e': nrm(ks[20], (DEPTH, N_EXPERTS, D_MODEL, EXPERT_FF), D_MODEL ** -0.5),
        'w_up_e': nrm(ks[21], (DEPTH, N_EXPERTS, D_MODEL, EXPERT_FF), D_MODEL ** -0.5),
        'w_down_e': nrm(ks[22], (DEPTH, N_EXPERTS, EXPERT_FF, D_MODEL), EXPERT_FF ** -0.5),
        'g_final': 1.0 + nrm(ks[23], (D_MODEL,), 0.05),
    }


def reference(x, c, ctx, c_ctx, w_ada, b_ada, g_norm1, w_in, lru_conv_w, lru_conv_b, lru_wr, lru_br,
              lru_wi, lru_bi, lru_lam, sc_conv_w, g_out, w_out, g_norm2, w_router, w_gate_e, w_up_e,
              w_down_e, g_final):
    b = x.shape[0]
    for l in range(DEPTH):
        last = l == DEPTH - 1
        mx = jnp.split((jax.nn.silu(c) @ w_ada[l] + b_ada[l])[:, None, :], 6, axis=-1)
        mc = jnp.split(jax.nn.silu(c_ctx) @ w_ada[l] + b_ada[l], 6, axis=-1)
        lru_p = (lru_wr[l], lru_br[l], lru_wi[l], lru_bi[l], lru_lam[l])

        hc = modulate(rmsnorm(ctx, g_norm1[l]), mc[0], mc[1])
        pc = hc @ (w_in[l][:, :LRU_W] if last else w_in[l])
        uc = conv_seq(pc[..., :LRU_W], lru_conv_w[l], LRU_CONV_LEFT) + lru_conv_b[l]
        h0 = jnp.zeros((b, LRU_W), jnp.float32)
        hf_c, hb_c = lru_states(uc, *lru_p, h0, h0)
        state_f = hf_c[:, -1]
        state_b = hb_c[:, 0]

        hx = modulate(rmsnorm(x, g_norm1[l]), mx[0], mx[1])
        px = hx @ w_in[l]
        ux = conv_grid(px[..., :LRU_W], lru_conv_w[l], LRU_CONV_LEFT) + lru_conv_b[l]
        hf_x, hb_x = lru_states(ux, *lru_p, state_f, state_b)
        x = x + mx[2] * mixer_out(px, hf_x, hb_x, conv_grid, sc_conv_w[l], g_out[l], w_out[l])

        if not last:
            ctx = ctx + mc[2] * mixer_out(pc, hf_c, hb_c, conv_seq, sc_conv_w[l], g_out[l], w_out[l])
            hc2 = modulate(rmsnorm(ctx, g_norm2[l]), mc[3], mc[4])
            ctx = ctx + mc[5] * expert_choice_ffn(hc2, w_router[l], w_gate_e[l], w_up_e[l], w_down_e[l])

        hx2 = modulate(rmsnorm(x, g_norm2[l]), mx[3], mx[4])
        x = x + mx[5] * expert_choice_ffn(hx2, w_router[l], w_gate_e[l], w_up_e[l], w_down_e[l])
    return rmsnorm(x, g_final)
```

```cpp
#include <hip/hip_runtime.h>
#include <cstdio>
#include <cstdint>
#define LAS __attribute__((address_space(3)))
namespace pg8 {
#define PG8_LAS __attribute__((address_space(3)))
typedef unsigned short bf16_t;
typedef short bf16x8 __attribute__((ext_vector_type(8)));
typedef float f32x4 __attribute__((ext_vector_type(4)));
typedef unsigned u32x4 __attribute__((ext_vector_type(4)));
constexpr int BM = 256, BK = 64, HALF = 128, HTB = HALF * BK * 2  , STAGE_BYTES = 8 * HTB, NXCD = 8, WGM = 8;

__host__ __device__ __forceinline__ int lds_byte(int r, int c) { const int st = (r >> 4) * 2 + (c >> 5), rr = r & 15, cc = c & 31, ob = rr * 64 + cc * 2; return st * 1024 + (ob ^ (((ob >> 9) & 1) << 5)); }
__host__ __device__ __forceinline__ void stage_rc(int b, int& R, int& C) { const int st = b / 1024, sb = b % 1024, swz = sb ^ (((sb >> 9) & 1) << 5); R = (st >> 1) * 16 + swz / 64; C = (st & 1) * 32 + (swz % 64) / 2; }
__host__ __device__ __forceinline__ int perm32(int rho) { const int n = rho >> 4, i = rho & 15; return 8 * (i >> 2) + 4 * n + (i & 3); }

struct Unit { int pm, pn; };
struct Gemm { const bf16_t* A; const bf16_t* Bt; int M, N, K; const int* gidx; };

struct StaticOrder {
    int nM, nN, nwg, G, c;
    __host__ __device__ void init(int M, int N, int G_, int c_) { nM = M / BM; nN = N / BM; nwg = nM * nN; G = G_; c = c_; }
    __host__ __device__ bool next(int i, Unit& u) const {
        const long L = (long)i * G + c; if (L >= nwg) return false;
        int wgid = (int)L; { const int q = nwg / NXCD, r = nwg % NXCD, xcd = wgid % NXCD, off = wgid / NXCD; wgid = (xcd < r ? xcd * (q + 1) : r * (q + 1) + (xcd - r) * q) + off; }
        const int nig = WGM * nN, gid = wgid / nig, fm = gid * WGM, gsz = (nM - fm) < WGM ? (nM - fm) : WGM;
        u.pm = fm + ((wgid % nig) % gsz); u.pn = (wgid % nig) / gsz; return true;
    }
    __device__ __forceinline__ void a_ready(const Unit&) const {}
    __device__ __forceinline__ void done(const Unit&) const {}
};


__device__ __forceinline__ unsigned cvt_pk_bf16(float lo, float hi) { unsigned r; asm volatile("v_cvt_pk_bf16_f32 %0, %1, %2" : "=v"(r) : "v"(lo), "v"(hi)); return r; }

struct EpiBf16Plain {
    static constexpr bool PERM = true, AFTER_DRAIN = false;
    bf16_t* O; int ldc;
    __device__ __forceinline__ void operator()(const f32x4 (&acc)[2][2][4][2], const Unit& u, int wr, int wc, int fr, int fq) const {
        const int row0 = u.pm * BM + wr * 64 + fr; const int col0 = u.pn * BM + wc * 32 + 8 * fq;
#pragma unroll
        for (int ai = 0; ai < 2; ++ai)
#pragma unroll
            for (int m = 0; m < 4; ++m) { bf16_t* rowp = O + (size_t)(row0 + ai * HALF + m * 16) * ldc + col0;
#pragma unroll
                for (int bj = 0; bj < 2; ++bj) { const f32x4 v0 = acc[ai][bj][m][0], v1 = acc[ai][bj][m][1];
                    u32x4 w; w.x = cvt_pk_bf16(v0[0], v0[1]); w.y = cvt_pk_bf16(v0[2], v0[3]); w.z = cvt_pk_bf16(v1[0], v1[1]); w.w = cvt_pk_bf16(v1[2], v1[3]);
                    *(u32x4*)(rowp + bj * HALF) = w; } }
    }
};
struct EpiInProj {
    static constexpr bool PERM = true, AFTER_DRAIN = false;
    bf16_t* O; int ldc;
    __device__ __forceinline__ void operator()(const f32x4 (&acc)[2][2][4][2], const Unit& u, int wr, int wc, int fr, int fq) const {
        const int row0 = u.pm * BM + wr * 64 + fr;
        if (u.pn == 5 || u.pn == 6) { const int col0 = 1280 + (u.pn - 5) * HALF + wc * 32 + 8 * fq;
#pragma unroll
            for (int ai = 0; ai < 2; ++ai)
#pragma unroll
                for (int m = 0; m < 4; ++m) { const f32x4 v0 = acc[ai][0][m][0] * acc[ai][1][m][0], v1 = acc[ai][0][m][1] * acc[ai][1][m][1];
                    u32x4 w; w.x = cvt_pk_bf16(v0[0], v0[1]); w.y = cvt_pk_bf16(v0[2], v0[3]); w.z = cvt_pk_bf16(v1[0], v1[1]); w.w = cvt_pk_bf16(v1[2], v1[3]);
                    *(u32x4*)(O + (size_t)(row0 + ai * HALF + m * 16) * ldc + col0) = w; }
        } else { const int col0 = (u.pn < 5 ? u.pn : u.pn - 1) * BM + wc * 32 + 8 * fq;
#pragma unroll
            for (int ai = 0; ai < 2; ++ai)
#pragma unroll
                for (int m = 0; m < 4; ++m) { bf16_t* rowp = O + (size_t)(row0 + ai * HALF + m * 16) * ldc + col0;
#pragma unroll
                    for (int bj = 0; bj < 2; ++bj) { const f32x4 v0 = acc[ai][bj][m][0], v1 = acc[ai][bj][m][1];
                        u32x4 w; w.x = cvt_pk_bf16(v0[0], v0[1]); w.y = cvt_pk_bf16(v0[2], v0[3]); w.z = cvt_pk_bf16(v1[0], v1[1]); w.w = cvt_pk_bf16(v1[2], v1[3]);
                        *(u32x4*)(rowp + bj * HALF) = w; } }
        }
    }
};
struct EpiSwiGLU {
    static constexpr bool PERM = true, AFTER_DRAIN = false;
    bf16_t* H; int ldc;
    __device__ __forceinline__ void operator()(const f32x4 (&acc)[2][2][4][2], const Unit& u, int wr, int wc, int fr, int fq) const {
        const int row0 = u.pm * BM + wr * 64 + fr; const int col0 = (u.pn & 7) * HALF + wc * 32 + 8 * fq;
#pragma unroll
        for (int ai = 0; ai < 2; ++ai)
#pragma unroll
            for (int m = 0; m < 4; ++m) { bf16_t* rowp = H + (size_t)(row0 + ai * HALF + m * 16) * ldc + col0;
                float o[8];
#pragma unroll
                for (int n = 0; n < 2; ++n)
#pragma unroll
                    for (int i = 0; i < 4; ++i) { const float g = acc[ai][0][m][n][i], up = acc[ai][1][m][n][i];
                        o[n * 4 + i] = g * __builtin_amdgcn_rcpf(1.0f + __expf(-g)) * up; }
                u32x4 w; w.x = cvt_pk_bf16(o[0], o[1]); w.y = cvt_pk_bf16(o[2], o[3]); w.z = cvt_pk_bf16(o[4], o[5]); w.w = cvt_pk_bf16(o[6], o[7]);
                *(u32x4*)rowp = w; }
    }
};
struct EpiScaleBf16 {
    static constexpr bool PERM = true, AFTER_DRAIN = false;
    bf16_t* Y; int ldc; const float* gval;
    __device__ __forceinline__ void operator()(const f32x4 (&acc)[2][2][4][2], const Unit& u, int wr, int wc, int fr, int fq) const {
        const int row0 = u.pm * BM + wr * 64 + fr; const int col0 = (u.pn & 3) * BM + wc * 32 + 8 * fq;
#pragma unroll
        for (int ai = 0; ai < 2; ++ai)
#pragma unroll
            for (int m = 0; m < 4; ++m) { const int row = row0 + ai * HALF + m * 16; const float g = gval[row]; bf16_t* rowp = Y + (size_t)row * ldc + col0;
#pragma unroll
                for (int bj = 0; bj < 2; ++bj) { const f32x4 v0 = acc[ai][bj][m][0] * g, v1 = acc[ai][bj][m][1] * g;
                    u32x4 w; w.x = cvt_pk_bf16(v0[0], v0[1]); w.y = cvt_pk_bf16(v0[2], v0[3]); w.z = cvt_pk_bf16(v1[0], v1[1]); w.w = cvt_pk_bf16(v1[2], v1[3]);
                    *(u32x4*)(rowp + bj * HALF) = w; } }
    }
};
struct EpiResid {
    static constexpr bool PERM = true, AFTER_DRAIN = false;
    const float* xin_lat; const float* xin_ctx; bf16_t* xb; const float* gate  ; int nlat; bool in_f32;
    __device__ __forceinline__ void operator()(const f32x4 (&acc)[2][2][4][2], const Unit& u, int wr, int wc, int fr, int fq) const {
        const int trow = u.pm * BM; const bool isctx = trow >= nlat;
        const int s = isctx ? 4 : (trow >> 13);
        const float* xin = isctx ? xin_ctx - (size_t)nlat * 1024 : xin_lat;
        const float* gp = gate + (size_t)s * 6144;
        const int row0 = trow + wr * 64 + fr, col0 = u.pn * BM + wc * 32 + 8 * fq;
        f32x4 gv[2][2];
#pragma unroll
        for (int bj = 0; bj < 2; ++bj)
#pragma unroll
            for (int n = 0; n < 2; ++n) gv[bj][n] = *(const f32x4*)(gp + col0 + bj * HALF + 4 * n);
#pragma unroll
        for (int ai = 0; ai < 2; ++ai)
#pragma unroll
            for (int m = 0; m < 4; ++m) { const size_t off = (size_t)(row0 + ai * HALF + m * 16) * 1024 + col0;
#pragma unroll
                for (int bj = 0; bj < 2; ++bj) { f32x4 x0, x1;
                    if (in_f32) { x0 = *(const f32x4*)(xin + off + bj * HALF); x1 = *(const f32x4*)(xin + off + bj * HALF + 4); }
                    else { const u32x4 w = *(const u32x4*)(xb + off + bj * HALF);
                        x0 = (f32x4){__builtin_bit_cast(float, w.x << 16), __builtin_bit_cast(float, w.x & 0xffff0000u), __builtin_bit_cast(float, w.y << 16), __builtin_bit_cast(float, w.y & 0xffff0000u)};
                        x1 = (f32x4){__builtin_bit_cast(float, w.z << 16), __builtin_bit_cast(float, w.z & 0xffff0000u), __builtin_bit_cast(float, w.w << 16), __builtin_bit_cast(float, w.w & 0xffff0000u)}; }
                    x0 += gv[bj][0] * acc[ai][bj][m][0]; x1 += gv[bj][1] * acc[ai][bj][m][1];
                    u32x4 o; o.x = cvt_pk_bf16(x0[0], x0[1]); o.y = cvt_pk_bf16(x0[2], x0[3]); o.z = cvt_pk_bf16(x1[0], x1[1]); o.w = cvt_pk_bf16(x1[2], x1[3]);
                    *(u32x4*)(xb + off + bj * HALF) = o; } }
    }
};
struct MoeOrder1 {
    int c; bool ctx;
    __device__ __forceinline__ bool next(int i, Unit& u) const {
        if (i < 8) { const int P = i * 8 + (c & 7), j = c >> 3, e = P >> 2, b = P & 3; u.pm = (b * 16 + e) * 4 + (j >> 3); u.pn = e * 8 + (j & 7); return true; }
        if (i == 8 && ctx && c < 128) { const int e = c >> 3; u.pm = 256 + e; u.pn = e * 8 + (c & 7); return true; }
        return false;
    }
    __device__ __forceinline__ void a_ready(const Unit&) const {}
    __device__ __forceinline__ void done(const Unit&) const {}
};
struct CtxOrder {
    int c;
    __device__ __forceinline__ bool next(int i, Unit& u) const { if (i != 0 || c >= 16) return false; u.pm = 128 + (c >> 2); u.pn = c & 3; return true; }
    __device__ __forceinline__ void a_ready(const Unit&) const {}
    __device__ __forceinline__ void done(const Unit&) const {}
};
struct MoeOrder2 {
    int c; bool ctx;
    __device__ __forceinline__ bool next(int i, Unit& u) const {
        if (i < 4) { const int j = c >> 3, P = i * 16 + (c & 7) * 2 + (j >> 4), e = P >> 2, b = P & 3; u.pm = (b * 16 + e) * 4 + ((j >> 2) & 3); u.pn = e * 4 + (j & 3); return true; }
        if (i == 4 && ctx && c < 64) { const int e = c >> 2; u.pm = 256 + e; u.pn = e * 4 + (c & 3); return true; }
        return false;
    }
    __device__ __forceinline__ void a_ready(const Unit&) const {}
    __device__ __forceinline__ void done(const Unit&) const {}
};

template <class Epi, class Sched, bool ALIGN_EPI = false, bool SP2 = false, bool GATHER = false>
__device__ __forceinline__ void gemm_phase(PG8_LAS unsigned char* lds, const Gemm g, const Sched& S, const Epi& E) {
    const int tid = threadIdx.x, wid = __builtin_amdgcn_readfirstlane(tid >> 6), lane = tid & 63, wr = wid >> 2, wc = wid & 3, fr = lane & 15, fq = lane >> 4;
    const int K = g.K, nt = K / BK;
    unsigned voffA[2], voffB[2]; int rowA[2]; unsigned colA2[2];
#pragma unroll
    for (int i = 0; i < 2; ++i) { int R, C; stage_rc(tid * 16 + i * 8192, R, C); const int Rb = Epi::PERM ? ((R & ~31) + perm32(R & 31)) : R;
        voffA[i] = (unsigned)(R * K + C) * 2u; voffB[i] = (unsigned)(Rb * K + C) * 2u; rowA[i] = R; colA2[i] = (unsigned)C * 2u; }
    unsigned gA[2][2], gN[2][2], gS[2][2], gRaw[2][2];
#define PG8_VA(h) (GATHER ? gA[h] : voffA)
#define PG8_VS(h) (GATHER ? gS[h] : voffA)
#define PG8_IDX_ISSUE(u) do { _Pragma("unroll") for (int _h = 0; _h < 2; ++_h) _Pragma("unroll") for (int _i = 0; _i < 2; ++_i) { const int* _p = g.gidx + (u).pm * BM + _h * HALF + rowA[_i]; \
        asm volatile("global_load_dword %0, %1, off" : "=v"(gRaw[_h][_i]) : "v"(_p) : "memory"); } } while (0)
#define PG8_IDX_TAKE(dst) do { _Pragma("unroll") for (int _h = 0; _h < 2; ++_h) _Pragma("unroll") for (int _i = 0; _i < 2; ++_i) { asm volatile("" : "+v"(gRaw[_h][_i])); dst[_h][_i] = gRaw[_h][_i] * (unsigned)(K * 2) + colA2[_i]; } } while (0)
    const size_t kstep = (size_t)(BK * 2);
    const size_t hstep = (size_t)HALF * K * 2;
    const size_t hstepA = GATHER ? 0 : hstep;
    const size_t tstep = 2 * hstep;
    const unsigned ldsw = (unsigned)wid * 1024u;
    const int aoff = lds_byte(wr * 64 + fr, fq * 8), boff = lds_byte(wc * 32 + fr, fq * 8);
#define PG8_SA(b, h) (((b) * 2 + (h)) * HTB)
#define PG8_SB(b, h) ((4 + (b) * 2 + (h)) * HTB)
#define PG8_STAGE(bufoff, gbase, voff) do { _Pragma("unroll") for (int _i = 0; _i < 2; ++_i) \
        __builtin_amdgcn_global_load_lds((const unsigned*)((const char*)(gbase) + (voff)[_i]), (PG8_LAS unsigned*)(lds + (bufoff) + ldsw + _i * 8192), 16, 0, 0); } while (0)
#define PG8_LDA(dst, b, h) do { _Pragma("unroll") for (int m = 0; m < 4; ++m) _Pragma("unroll") for (int k = 0; k < 2; ++k) dst[m][k] = *(const PG8_LAS bf16x8*)(lds + PG8_SA(b, h) + aoff + m * 2048 + k * 1024); } while (0)
#define PG8_LDB(dst, b, h) do { _Pragma("unroll") for (int n = 0; n < 2; ++n) _Pragma("unroll") for (int k = 0; k < 2; ++k) dst[n][k] = *(const PG8_LAS bf16x8*)(lds + PG8_SB(b, h) + boff + n * 2048 + k * 1024); } while (0)
#define PG8_MMA(ai, bj, At, Bt) do { __builtin_amdgcn_s_setprio(1); _Pragma("unroll") for (int m = 0; m < 4; ++m) _Pragma("unroll") for (int n = 0; n < 2; ++n) _Pragma("unroll") for (int k = 0; k < 2; ++k) \
        acc[ai][bj][m][n] = __builtin_amdgcn_mfma_f32_16x16x32_bf16(Bt[n][k], At[m][k], acc[ai][bj][m][n], 0, 0, 0); __builtin_amdgcn_s_setprio(0); } while (0)
#define PG8_WAIT_V(n) asm volatile("s_waitcnt vmcnt(" #n ")" ::: "memory")
#define PG8_WAIT_L(n) asm volatile("s_waitcnt lgkmcnt(" #n ")" ::: "memory")
#define PG8_BAR __builtin_amdgcn_s_barrier()
#define PG8_SCHED __builtin_amdgcn_sched_barrier(0)
    Unit cur, nxt; int ui = 0;
    if (!S.next(0, cur)) return;
    f32x4 acc[2][2][4][2];
#pragma unroll
    for (int a = 0; a < 2; ++a)
#pragma unroll
        for (int b = 0; b < 2; ++b)
#pragma unroll
            for (int m = 0; m < 4; ++m)
#pragma unroll
                for (int n = 0; n < 2; ++n) acc[a][b][m][n] = (f32x4){0.f, 0.f, 0.f, 0.f};
    bf16x8 At[4][2], B0[2][2], B1[2][2];
    const char* cA = (const char*)g.A + (GATHER ? (size_t)0 : (size_t)cur.pm * tstep); const char* cB = (const char*)g.Bt + (size_t)cur.pn * tstep;
    S.a_ready(cur);
    if constexpr (GATHER) { PG8_IDX_ISSUE(cur); asm volatile("s_waitcnt vmcnt(0)" ::: "memory"); PG8_IDX_TAKE(gA); }
    if constexpr (SP2) {
        PG8_STAGE(PG8_SB(0, 0), cB, voffB); PG8_STAGE(PG8_SB(0, 1), cB + hstep, voffB); PG8_STAGE(PG8_SA(0, 0), cA, PG8_VA(0)); PG8_STAGE(PG8_SA(0, 1), cA + hstepA, PG8_VA(1));
        if (wr == 1) PG8_BAR;
        PG8_WAIT_V(2); PG8_BAR;
        PG8_STAGE(PG8_SB(1, 0), cB + kstep, voffB); PG8_STAGE(PG8_SA(1, 0), cA + kstep, PG8_VA(0)); PG8_STAGE(PG8_SB(1, 1), cB + hstep + kstep, voffB);
        PG8_WAIT_V(6); PG8_BAR;
    } else {
        PG8_STAGE(PG8_SB(0, 0), cB, voffB); PG8_STAGE(PG8_SA(0, 0), cA, PG8_VA(0)); PG8_STAGE(PG8_SB(0, 1), cB + hstep, voffB); PG8_STAGE(PG8_SA(0, 1), cA + hstepA, PG8_VA(1));
        if (wr == 1) PG8_BAR;
        PG8_WAIT_V(4); PG8_BAR;
        PG8_STAGE(PG8_SB(1, 0), cB + kstep, voffB); PG8_STAGE(PG8_SA(1, 0), cA + kstep, PG8_VA(0)); PG8_STAGE(PG8_SB(1, 1), cB + hstep + kstep, voffB);
        PG8_WAIT_V(6); PG8_BAR;
    }
    for (;;) {
        const bool has_next = S.next(ui + 1, nxt);
        const char* nA = (has_next && !GATHER) ? (const char*)g.A + (size_t)nxt.pm * tstep : cA; const char* nB = has_next ? (const char*)g.Bt + (size_t)nxt.pn * tstep : cB;
        if constexpr (GATHER) { if (has_next) PG8_IDX_ISSUE(nxt); }
        for (int t = 0; t < nt; t += 2) {
            const bool last = (t == nt - 2);
            const char* a1 = cA + (size_t)(t + 1) * kstep;
            const char* a2 = last ? nA : cA + (size_t)(t + 2) * kstep; const char* b2 = last ? nB : cB + (size_t)(t + 2) * kstep;
            const char* a3 = a2 + kstep; const char* b3 = b2 + kstep;
            if (last && has_next) S.a_ready(nxt);
            if constexpr (GATHER) { if (last) { if (has_next) PG8_IDX_TAKE(gN); else { _Pragma("unroll") for (int _h = 0; _h < 2; ++_h) _Pragma("unroll") for (int _i = 0; _i < 2; ++_i) gN[_h][_i] = gA[_h][_i]; } }
                _Pragma("unroll") for (int _h = 0; _h < 2; ++_h) _Pragma("unroll") for (int _i = 0; _i < 2; ++_i) gS[_h][_i] = last ? gN[_h][_i] : gA[_h][_i]; }
            if constexpr (SP2) {
            PG8_LDB(B0, 0, 0); PG8_LDB(B1, 0, 1); PG8_SCHED; PG8_LDA(At, 0, 0); PG8_STAGE(PG8_SA(1, 1), a1 + hstepA, PG8_VA(1));
            PG8_WAIT_V(8); PG8_WAIT_L(0); PG8_BAR; PG8_MMA(0, 0, At, B0); PG8_MMA(0, 1, At, B1); PG8_BAR; PG8_SCHED;
            PG8_LDA(At, 0, 1); PG8_STAGE(PG8_SB(0, 0), b2, voffB); PG8_STAGE(PG8_SB(0, 1), b2 + hstep, voffB); PG8_STAGE(PG8_SA(0, 0), a2, PG8_VS(0));
            PG8_WAIT_V(8); PG8_WAIT_L(0); PG8_BAR; PG8_MMA(1, 0, At, B0); PG8_MMA(1, 1, At, B1); PG8_BAR; PG8_SCHED;
            PG8_LDB(B0, 1, 0); PG8_LDB(B1, 1, 1); PG8_SCHED; PG8_LDA(At, 1, 0); PG8_STAGE(PG8_SA(0, 1), a2 + hstepA, PG8_VS(1));
            PG8_WAIT_V(8); PG8_WAIT_L(0); PG8_BAR; PG8_MMA(0, 0, At, B0); PG8_MMA(0, 1, At, B1); PG8_BAR; PG8_SCHED;
            PG8_LDA(At, 1, 1); PG8_STAGE(PG8_SB(1, 0), b3, voffB); PG8_STAGE(PG8_SB(1, 1), b3 + hstep, voffB); PG8_STAGE(PG8_SA(1, 0), a3, PG8_VS(0));
            PG8_WAIT_V(8); PG8_WAIT_L(0); PG8_BAR; PG8_MMA(1, 0, At, B0); PG8_MMA(1, 1, At, B1); PG8_BAR; PG8_SCHED;
            } else {
            PG8_LDB(B0, 0, 0); PG8_SCHED; PG8_LDA(At, 0, 0); PG8_STAGE(PG8_SA(1, 1), a1 + hstepA, PG8_VA(1));
            PG8_WAIT_L(8); PG8_BAR; PG8_WAIT_L(0); PG8_MMA(0, 0, At, B0); PG8_BAR; PG8_SCHED;
            PG8_LDB(B1, 0, 1); PG8_STAGE(PG8_SB(0, 0), b2, voffB);
            PG8_BAR; PG8_WAIT_L(0); PG8_MMA(0, 1, At, B1); PG8_BAR;
            PG8_LDA(At, 0, 1); PG8_STAGE(PG8_SA(0, 0), a2, PG8_VS(0));
            PG8_BAR; PG8_WAIT_L(0); PG8_MMA(1, 0, At, B0); PG8_BAR; PG8_SCHED;
            PG8_STAGE(PG8_SB(0, 1), b2 + hstep, voffB);
            PG8_WAIT_V(6); PG8_BAR; PG8_MMA(1, 1, At, B1); PG8_BAR;
            PG8_LDB(B0, 1, 0); PG8_SCHED; PG8_LDA(At, 1, 0); PG8_STAGE(PG8_SA(0, 1), a2 + hstepA, PG8_VS(1));
            PG8_WAIT_L(8); PG8_BAR; PG8_WAIT_L(0); PG8_MMA(0, 0, At, B0); PG8_BAR; PG8_SCHED;
            PG8_LDB(B1, 1, 1); PG8_STAGE(PG8_SB(1, 0), b3, voffB);
            PG8_BAR; PG8_WAIT_L(0); PG8_MMA(0, 1, At, B1); PG8_BAR;
            PG8_LDA(At, 1, 1); PG8_STAGE(PG8_SA(1, 0), a3, PG8_VS(0));
            PG8_BAR; PG8_WAIT_L(0); PG8_MMA(1, 0, At, B0); PG8_BAR; PG8_SCHED;
            PG8_STAGE(PG8_SB(1, 1), b3 + hstep, voffB);
            PG8_WAIT_V(6); PG8_BAR; PG8_MMA(1, 1, At, B1); PG8_BAR;
            }
        }
        if constexpr (ALIGN_EPI) { if (wr == 0) PG8_BAR; }
        if constexpr (!Epi::AFTER_DRAIN) { E(acc, cur, wr, wc, fr, fq); S.done(cur); }
        if (!has_next) break;
#pragma unroll
        for (int a = 0; a < 2; ++a)
#pragma unroll
            for (int b = 0; b < 2; ++b)
#pragma unroll
                for (int m = 0; m < 4; ++m)
#pragma unroll
                    for (int n = 0; n < 2; ++n) acc[a][b][m][n] = (f32x4){0.f, 0.f, 0.f, 0.f};
        cur = nxt; cA = nA; cB = nB; ++ui;
        if constexpr (GATHER) { _Pragma("unroll") for (int _h = 0; _h < 2; ++_h) _Pragma("unroll") for (int _i = 0; _i < 2; ++_i) gA[_h][_i] = gN[_h][_i]; }
        if constexpr (ALIGN_EPI) { if (wr == 1) PG8_BAR; }
    }
    PG8_WAIT_V(0);
    if constexpr (!ALIGN_EPI) { if (wr == 0) PG8_BAR; }
    PG8_BAR;
    if constexpr (Epi::AFTER_DRAIN) { E.fused(acc, cur, wr, wc, fr, fq, lds, wid, lane); S.done(cur); }
#undef PG8_SA
#undef PG8_VA
#undef PG8_VS
#undef PG8_IDX_ISSUE
#undef PG8_IDX_TAKE
#undef PG8_SB
#undef PG8_STAGE
#undef PG8_LDA
#undef PG8_LDB
#undef PG8_MMA
#undef PG8_WAIT_V
#undef PG8_WAIT_L
#undef PG8_BAR
#undef PG8_SCHED
}
}
#define XB_TMO      128
#define XB_XCNT(j)  (256  + 64 * (j))
#define XB_XSUB(j)  (1280 + 64 * (j))
#define XB_XGEN(j)  (2304 + 64 * (j))
#define XB_TOP      3328
#define XB_TOPGEN   3392
#define XCD_BAR_WORDS 3456
#define XB_SPIN_CAP (1u << 18)

__device__ __forceinline__ unsigned xb_ld(unsigned* p)              { return __hip_atomic_load(p, __ATOMIC_RELAXED, __HIP_MEMORY_SCOPE_AGENT); }
__device__ __forceinline__ unsigned xb_add(unsigned* p, unsigned v) { return __hip_atomic_fetch_add(p, v, __ATOMIC_RELAXED, __HIP_MEMORY_SCOPE_AGENT); }
__device__ __forceinline__ unsigned xb_xcc_id() { return (unsigned)__builtin_amdgcn_s_getreg((3 << 11) | 20) & 0xFu; }
#define XB_SPIN(cond, bar) do { unsigned _sp = 0; while (cond) { __builtin_amdgcn_s_sleep(1); \
    if ((++_sp & 255u) == 0u) { if (xb_ld(&(bar)[XB_TMO])) break; if (_sp > XB_SPIN_CAP) { atomicAdd(&(bar)[XB_TMO], 1u); break; } } } } while (0)

struct XcdBarrier {
    unsigned* bar; unsigned x;
    volatile LAS unsigned* st;
};

__device__ __forceinline__ XcdBarrier xcd_barrier_post(unsigned* bar, volatile LAS unsigned* st) {
    XcdBarrier b; b.bar = bar; b.x = xb_xcc_id(); b.st = st;
    if (threadIdx.x == 0) (void)xb_add(&bar[XB_XCNT(b.x)], 1u);
    return b;
}
__device__ __forceinline__ void xcd_barrier_complete(unsigned* bar, unsigned x, unsigned& nloc, unsigned& nx) {
    const unsigned G = gridDim.x * gridDim.y * gridDim.z;
    unsigned sum, cnt, mine, sp = 0u;
    for (;;) {
        sum = 0u; cnt = 0u; mine = 0u;
#pragma unroll
        for (unsigned j = 0; j < 16; ++j) { const unsigned c = xb_ld(&bar[XB_XCNT(j)]); sum += c; cnt += (c > 0u) ? 1u : 0u; mine = (j == x) ? c : mine; }
        if (sum == G) break;
        __builtin_amdgcn_s_sleep(1);
        if ((++sp & 255u) == 0u) { if (xb_ld(&bar[XB_TMO])) break; if (sp > XB_SPIN_CAP) { atomicAdd(&bar[XB_TMO], 1u); break; } }
    }
    nloc = mine > 0u ? mine : 1u; nx = cnt > 0u ? cnt : 1u;
}

__device__ __forceinline__ void xcd_barrier(const XcdBarrier& b) {
    asm volatile("s_waitcnt vmcnt(0)" ::: "memory");
    __syncthreads();
    if (threadIdx.x == 0) {
        unsigned* bar = b.bar;
        __builtin_amdgcn_s_waitcnt(0);
        unsigned nloc = b.st[0], nx = b.st[1];
        if (nloc == 0u) { xcd_barrier_complete(bar, b.x, nloc, nx); b.st[0] = nloc; b.st[1] = nx; }
        const unsigned old = xb_add(&bar[XB_XSUB(b.x)], 1u);
        const unsigned gen = old / nloc;
        if (old + 1u == (gen + 1u) * nloc) {
            __builtin_amdgcn_fence(__ATOMIC_RELEASE, "agent");
            asm volatile("s_waitcnt vmcnt(0)" ::: "memory");
            const unsigned og = xb_add(&bar[XB_TOP], 1u);
            const unsigned tg = og / nx;
            if (og + 1u == (tg + 1u) * nx) xb_add(&bar[XB_TOPGEN], 1u);
            else XB_SPIN(xb_ld(&bar[XB_TOPGEN]) == tg, bar);
            __builtin_amdgcn_fence(__ATOMIC_ACQUIRE, "agent");
            xb_add(&bar[XB_XGEN(b.x)], 1u);
            asm volatile("s_waitcnt vmcnt(0)" ::: "memory");
        } else {
            XB_SPIN(xb_ld(&bar[XB_XGEN(b.x)]) == gen, bar);
            __builtin_amdgcn_fence(__ATOMIC_ACQUIRE, "agent");
            asm volatile("s_waitcnt vmcnt(0)" ::: "memory");
        }
    }
    __syncthreads();
}

typedef unsigned short bf16;
typedef unsigned v4u __attribute__((ext_vector_type(4)));
typedef unsigned v2u __attribute__((ext_vector_type(2)));
typedef float f32x4 __attribute__((ext_vector_type(4)));
typedef float f32x16 __attribute__((ext_vector_type(16)));
typedef short bf16x8 __attribute__((ext_vector_type(8)));
typedef unsigned short u16x8 __attribute__((ext_vector_type(8)));
#define LDS_WAIT() asm volatile("s_waitcnt lgkmcnt(0)" ::: "memory")
#define VM_WAIT() asm volatile("s_waitcnt vmcnt(0)" ::: "memory")

constexpr int NWAVES = 8, NTHR = 512;
constexpr int D = 1024, NB = 4, SEQ = 8192, CTXL = 256, NLAT = NB * SEQ, NCTX = NB * CTXL, NROW = NLAT + NCTX;
constexpr int INC = 2304;
constexpr int PXC = 2048;
constexpr int PX_Z = 1536;
constexpr int NE = 16, CAP_L = 1024, CAP_C = 32;
constexpr int SLAB_L = NB * NE * CAP_L;
constexpr int SLAB_ROWS = SLAB_L + NE * 256;
constexpr int NCHUNK = NROW / 64;
constexpr float EPS = 1e-6f;

enum { I_X = 0, I_C, I_CTX, I_CCTX, I_WADA, I_BADA, I_GN1, I_WIN, I_LCW, I_LCB, I_LWR, I_LBR, I_LWI, I_LBI, I_LAM, I_SCW, I_GOUT, I_WOUT, I_GN2, I_WRT, I_WG, I_WU, I_WD, I_GF, N_IN };

constexpr size_t MiB = 1u << 20;
constexpr size_t WS_CTL = 0, CTL_ZERO_BYTES = 64 * 1024;
constexpr size_t WS_MODP_OLD = 1 * MiB;
constexpr size_t WS_MODS = WS_MODP_OLD + 2 * MiB;
constexpr size_t WS_SP8 = WS_MODS + 256 * 1024;
constexpr size_t WS_TW = WS_SP8 + 8 * 1024;
constexpr size_t WS_C128 = WS_TW + 64 * 1024;
constexpr size_t WS_S128 = WS_C128 + 32 * 1024;
constexpr size_t WS_T2M = WS_S128 + 32 * 1024;
constexpr size_t WS_TCM = WS_T2M + 16 * 1024;
constexpr size_t WS_WGL = WS_TCM + 256 * 1024;
constexpr size_t WS_WIN = 5 * MiB;
constexpr size_t WS_WOUT = WS_WIN + 9 * MiB;
constexpr size_t WS_WGU = WS_WOUT + 4 * MiB;
constexpr size_t WS_WD = WS_WGU + 64 * MiB;
constexpr size_t WS_WEXP_L = 96 * MiB;
constexpr size_t WS_XB = WS_WGU + 2 * WS_WEXP_L;
constexpr size_t WS_HX = WS_XB;
constexpr size_t WS_REGA = WS_HX + 66 * MiB;
constexpr size_t WS_REGB = WS_REGA + 149 * MiB;
constexpr size_t WS_T1 = WS_REGB, WS_Y = WS_REGB + 32 * MiB;
constexpr size_t WS_MODP = WS_REGB;
constexpr size_t WS_CTXX = WS_REGB + 136 * MiB;
constexpr size_t WS_AFFL = WS_CTXX + 4 * MiB;
constexpr size_t WS_AFFC = WS_AFFL + 2 * MiB;
constexpr size_t WS_ENT = WS_AFFC + 1 * MiB;
constexpr size_t WS_IDX = WS_ENT + 3 * MiB;
constexpr size_t WS_GVAL = WS_IDX + 1 * MiB;
constexpr size_t WS_SUMM = WS_GVAL + 1 * MiB;
constexpr size_t WS_CARRY = WS_SUMM + 5 * MiB;
constexpr size_t WS_END = WS_CARRY + 3 * MiB;
static_assert(WS_WGL + 2 * 8 * 256 * 64 * 2 <= WS_WIN, "ws map");
static_assert((size_t)NROW * INC * 2 <= 149 * MiB && (size_t)SLAB_ROWS * 1024 * 2 <= 136 * MiB && 32 * MiB + (size_t)NROW * 1024 * 2 <= 136 * MiB, "ws map");

constexpr int CW_BAR = 1024;

constexpr int LDS_BYTES = 147456;
constexpr int RING_BYTES = 135168;
constexpr int MISC_OFF = RING_BYTES;

__device__ __forceinline__ unsigned f2bf(float f) { unsigned u = __builtin_bit_cast(unsigned, f); return (u + 0x7fffu + ((u >> 16) & 1u)) >> 16; }
__device__ __forceinline__ unsigned pk2(float lo, float hi) { unsigned r; asm volatile("v_cvt_pk_bf16_f32 %0, %1, %2" : "=v"(r) : "v"(lo), "v"(hi)); return r; }
__device__ __forceinline__ float bf2f(unsigned h) { return __builtin_bit_cast(float, h << 16); }
__device__ __forceinline__ float sigmoidf_(float x) { return __builtin_amdgcn_rcpf(1.0f + __builtin_amdgcn_exp2f(-1.4426950408889634f * x)); }
__device__ __forceinline__ float rsq_(float x) { return __builtin_amdgcn_rsqf(x); }
__device__ __forceinline__ float wave_sum(float v) {
#pragma unroll
    for (int o = 1; o < 64; o <<= 1) v += __shfl_xor(v, o);
    return v;
}

struct Args { const float* in[N_IN]; float* out; unsigned char* ws; int ph_lo, ph_hi, bar_region, pad_; };
template <int CTRL> __device__ __forceinline__ float dpp_(float v) { return __builtin_bit_cast(float, __builtin_amdgcn_update_dpp(0, __builtin_bit_cast(int, v), CTRL, 0xf, 0xf, false)); }
__device__ __forceinline__ float row_sum16(float v) { v += dpp_<0xB1>(v); v += dpp_<0x4E>(v); v += dpp_<0x141>(v); v += dpp_<0x140>(v); return v; }
__device__ __forceinline__ float row_max16(float v) { v = fmaxf(v, dpp_<0xB1>(v)); v = fmaxf(v, dpp_<0x4E>(v)); v = fmaxf(v, dpp_<0x141>(v)); v = fmaxf(v, dpp_<0x140>(v)); return v; }
__device__ __forceinline__ float wave_sum_fast(float v) { v = row_sum16(v);
    const int i = __builtin_bit_cast(int, v);
    return (__builtin_bit_cast(float, __builtin_amdgcn_readlane(i, 0)) + __builtin_bit_cast(float, __builtin_amdgcn_readlane(i, 16))) + (__builtin_bit_cast(float, __builtin_amdgcn_readlane(i, 32)) + __builtin_bit_cast(float, __builtin_amdgcn_readlane(i, 48))); }
struct Frame {
    LAS unsigned char* lds;
    int tid, lane, wave, wg, G;
};
constexpr int PT_OFF = 135168 + 256;
__device__ __forceinline__ unsigned long long ptab_(LAS unsigned char* lds, int i) { const unsigned long long v = ((const LAS unsigned long long*)(lds + PT_OFF))[i];
    const unsigned lo = __builtin_amdgcn_readfirstlane((unsigned)v), hi = __builtin_amdgcn_readfirstlane((unsigned)(v >> 32)); return ((unsigned long long)hi << 32) | lo; }
#define GAS __attribute__((address_space(1)))
template <class T> __device__ __forceinline__ T* as_global_(unsigned long long v) { return (T*)(GAS T*)v; }
#define INP(i) as_global_<const float>(ptab_(F.lds, (i)))
#define OUTP() as_global_<float>(ptab_(F.lds, N_IN))
#define HXP() as_global_<bf16>(ptab_(F.lds, N_IN))
#define XBP() WSP(bf16, WS_XB)
__device__ __forceinline__ void relaunder(Frame& F) { int t_ = threadIdx.x; asm volatile("" : "+v"(t_)); F.tid = t_; F.lane = t_ & 63; F.wave = __builtin_amdgcn_readfirstlane(t_ >> 6); }
#define WSP(T, off) as_global_<T>(ptab_(F.lds, N_IN + 1) + (off))

__device__ __forceinline__ void transpose_item(const float* __restrict__ W, int ldw, int k0, int n0, bf16* __restrict__ WT, int ldk, int drow0, LAS float* scr, int lane) {
#pragma unroll 8
    for (int i = 0; i < 32; ++i) { const int kk = 2 * i + (lane >> 5); scr[kk * 33 + (lane & 31)] = W[(size_t)(k0 + kk) * ldw + n0 + (lane & 31)]; }
    LDS_WAIT(); asm volatile("" ::: "memory");
    const int c = lane & 7;
#pragma unroll
    for (int j = 0; j < 4; ++j) { const int n = (lane >> 3) + 8 * j; const LAS float* s = scr + (8 * c) * 33 + n;
        v4u o; o.x = pk2(s[0 * 33], s[1 * 33]); o.y = pk2(s[2 * 33], s[3 * 33]); o.z = pk2(s[4 * 33], s[5 * 33]); o.w = pk2(s[6 * 33], s[7 * 33]);
        *(v4u*)(WT + (size_t)(drow0 + n) * ldk + k0 + 8 * c) = o; }
    LDS_WAIT(); asm volatile("" ::: "memory");
}
__device__ __forceinline__ void transpose_item64(const float* __restrict__ W, int ldw, int k0, int n0, bf16* __restrict__ WT, int ldk, int drow0, LAS float* scr, int lane) {
    const int q = lane & 15, kr = lane >> 4;
    f32x4 v[16];
#pragma unroll
    for (int i = 0; i < 16; ++i) v[i] = __builtin_nontemporal_load((const f32x4*)(W + (size_t)(k0 + 4 * i + kr) * ldw + n0 + 4 * q));
#pragma unroll
    for (int i = 0; i < 16; ++i) { LAS float* d = scr + (4 * i + kr) * 65 + 4 * q; d[0] = v[i].x; d[1] = v[i].y; d[2] = v[i].z; d[3] = v[i].w; }
    LDS_WAIT(); asm volatile("" ::: "memory");
    const int c = lane & 7;
#pragma unroll
    for (int j = 0; j < 8; ++j) { const int n = (lane >> 3) + 8 * j; const LAS float* s = scr + (8 * c) * 65 + n;
        v4u o; o.x = pk2(s[0 * 65], s[1 * 65]); o.y = pk2(s[2 * 65], s[3 * 65]); o.z = pk2(s[4 * 65], s[5 * 65]); o.w = pk2(s[6 * 65], s[7 * 65]);
        *(v4u*)(WT + (size_t)(drow0 + n) * ldk + k0 + 8 * c) = o; }
    LDS_WAIT(); asm volatile("" ::: "memory");
}
constexpr int N_EXP_ITEMS = 3 * 16 * 256;
constexpr int CW_FILL = 64;
__device__ __forceinline__ void convert_item(Frame& F, int l, int it) {
    LAS float* scr = (LAS float*)(F.lds + F.wave * 16640);
    bf16* WGU = WSP(bf16, WS_WGU + (size_t)l * WS_WEXP_L); bf16* WD = WSP(bf16, WS_WD + (size_t)l * WS_WEXP_L);
    const int mat = it / (16 * 256), r = it % (16 * 256), e = r >> 8, t = r & 255, kb = t >> 4, nb = t & 15, k0 = kb * 64, n0 = nb * 64;
    const size_t eoff = ((size_t)l * 16 + e) * 1024 * 1024;
    if (mat == 0)      transpose_item64(INP(I_WG) + eoff, 1024, k0, n0, WGU + (size_t)e * 2048 * 1024, 1024, (n0 >> 7) * 256 + (n0 & 127), scr, F.lane);
    else if (mat == 1) transpose_item64(INP(I_WU) + eoff, 1024, k0, n0, WGU + (size_t)e * 2048 * 1024, 1024, (n0 >> 7) * 256 + 128 + (n0 & 127), scr, F.lane);
    else               transpose_item64(INP(I_WD) + eoff, 1024, k0, n0, WD + (size_t)e * 1024 * 1024, 1024, n0, scr, F.lane);
}
__device__ __forceinline__ void filler(Frame& F, int budget, int only_l) {
    volatile LAS unsigned* MISC = (volatile LAS unsigned*)(F.lds + MISC_OFF);
    unsigned* ctr = WSP(unsigned, WS_CTL) + CW_FILL;
    int l = only_l >= 0 ? only_l : 0;
    for (int g = 0; only_l >= 0 || g < budget; ++g) {
        __syncthreads();
        if (F.tid == 0) { unsigned base = __hip_atomic_fetch_add(ctr + 64 * l, 8u, __ATOMIC_RELAXED, __HIP_MEMORY_SCOPE_AGENT);
            if (base >= (unsigned)N_EXP_ITEMS && only_l < 0 && l == 0) { base = __hip_atomic_fetch_add(ctr + 64, 8u, __ATOMIC_RELAXED, __HIP_MEMORY_SCOPE_AGENT) | 0x80000000u; }
            MISC[20] = base; }
        LDS_WAIT(); __syncthreads();
        unsigned base = MISC[20]; int ll = l;
        if (base & 0x80000000u) { base &= 0x7fffffffu; ll = 1; l = 1; }
        if (base >= (unsigned)N_EXP_ITEMS) break;
        convert_item(F, ll, (int)base + F.wave);
    }
    __syncthreads();
}
__device__ __forceinline__ void p0_prep(Frame& F) {
    const int gw = F.wg * NWAVES + F.wave, NGW = F.G * NWAVES;
    LAS float* sil = (LAS float*)(F.lds + 8 * 8448);
    for (int i = F.tid; i < 5 * 1024; i += NTHR) { const int s = i >> 10, k = i & 1023; const float cv = s < 4 ? INP(I_C)[s * 1024 + k] : INP(I_CCTX)[k]; sil[i] = cv * sigmoidf_(cv); }
    LAS float* cst = (LAS float*)(F.lds + 8 * 8448 + 5 * 1024 * 4);
    if (F.tid < 64) { cst[F.tid] = cospif((float)F.tid / 32.0f); cst[64 + F.tid] = sinpif((float)F.tid / 32.0f); }
    LDS_WAIT(); __syncthreads();
    constexpr int N_ADA = 16 * 24, N_FOLD = 256, N_IN_ITEMS = 16 * 56, N_OUT_ITEMS = 16 * 32, N_LRU = 32;
    constexpr int PER_L = N_ADA + N_FOLD + N_IN_ITEMS + N_OUT_ITEMS + N_LRU;
    LAS float* scr = (LAS float*)(F.lds + F.wave * 8448);
    for (int it = gw; it < 2 * PER_L; it += NGW) {
        const int l = it & 1; int r = it >> 1;
        if (r < N_ADA) {
            const int kq = r / 24, cb = r % 24, j0 = cb * 256 + 4 * F.lane;
            const float* W = INP(I_WADA) + (size_t)l * 1024 * 6144 + j0;
            f32x4 acc[5];
#pragma unroll
            for (int s = 0; s < 5; ++s) acc[s] = (f32x4){0.f, 0.f, 0.f, 0.f};
            for (int kb = 0; kb < 4; ++kb) { f32x4 w[16];
#pragma unroll
                for (int i = 0; i < 16; ++i) w[i] = __builtin_nontemporal_load((const f32x4*)(W + (size_t)(kq * 64 + kb * 16 + i) * 6144));
#pragma unroll
                for (int i = 0; i < 16; ++i)
#pragma unroll
                    for (int s = 0; s < 5; ++s) acc[s] += w[i] * sil[s * 1024 + kq * 64 + kb * 16 + i]; }
            float* MP = WSP(float, WS_MODP);
#pragma unroll
            for (int s = 0; s < 5; ++s) *(f32x4*)(MP + ((size_t)(kq * 2 + l) * 5 + s) * 6144 + j0) = acc[s];
            continue; }
        r -= N_ADA;
        if (r < N_FOLD) {
            const int kb = r >> 4, g = (r >> 2) & 3, mq = r & 3, k = kb * 64 + F.lane;
            const float* Wr = INP(I_WIN) + (size_t)l * 1024 * 2048 + (size_t)k * 2048 + 1792 + 64 * g;
            float wrow[64];
#pragma unroll
            for (int c4 = 0; c4 < 16; ++c4) { const f32x4 t = *(const f32x4*)(Wr + 4 * c4); wrow[4 * c4] = t.x; wrow[4 * c4 + 1] = t.y; wrow[4 * c4 + 2] = t.z; wrow[4 * c4 + 3] = t.w; }
            bf16* WT = WSP(bf16, WS_WIN) + (size_t)l * INC * 1024;
            for (int m = 16 * mq; m < 16 * mq + 16; ++m) { float re = 0.f, im = 0.f;
#pragma unroll
                for (int c = 0; c < 64; ++c) { const int a = (m * c) & 63; re += wrow[c] * cst[a]; im -= wrow[c] * cst[64 + a]; }
                WT[(size_t)(1792 + 64 * g + m) * 1024 + k] = (bf16)f2bf(re);
                WT[(size_t)(2048 + 64 * g + m) * 1024 + k] = (bf16)f2bf(im); }
            continue; }
        r -= N_FOLD;
        if (r < N_IN_ITEMS) {
            const int kb = r / 56, nb = r % 56;
            const int n0 = nb * 32, j = n0 < 1536 ? n0 - 1280 : n0 - 1536;
            const int drow = n0 < 1280 ? n0 : 1280 + (j >> 7) * 256 + (n0 < 1536 ? 0 : 128) + (j & 127);
            transpose_item(INP(I_WIN) + (size_t)l * 1024 * 2048, 2048, kb * 64, n0, WSP(bf16, WS_WIN) + (size_t)l * INC * 1024, 1024, drow, scr, F.lane); continue; }
        r -= N_IN_ITEMS;
        if (r < N_OUT_ITEMS) { const int kb = r >> 5, nb = r & 31;
            transpose_item(INP(I_WOUT) + (size_t)l * 1024 * 1024, 1024, kb * 64, nb * 32, WSP(bf16, WS_WOUT) + (size_t)l * 1024 * 1024, 1024, nb * 32, scr, F.lane); continue; }
        r -= N_OUT_ITEMS;
        {
            const int dir = r >> 4, gate = (r >> 3) & 1, h = r & 7;
            const float* W = INP(gate ? I_LWI : I_LWR) + ((size_t)(l * 2 + dir) * 8 + h) * 4096;
            bf16* WT = WSP(bf16, WS_WGL) + ((size_t)l * 8 + h) * 256 * 64 + (size_t)(dir * 2 + gate) * 64 * 64;
            for (int i = 0; i < 64; ++i) WT[F.lane * 64 + i] = (bf16)f2bf(W[i * 64 + F.lane]);
        }
    }
    const int gt = F.wg * NTHR + F.tid, NGT = F.G * NTHR;
    float* TW = WSP(float, WS_TW); bf16* C128 = WSP(bf16, WS_C128); bf16* S128 = WSP(bf16, WS_S128); bf16* T2M = WSP(bf16, WS_T2M); bf16* TCM = WSP(bf16, WS_TCM); float* SP8 = WSP(float, WS_SP8);
    for (int i = gt; i < 8192; i += NGT) { TW[2 * i] = cospif((float)i / 4096.0f); TW[2 * i + 1] = sinpif((float)i / 4096.0f); }
    for (int i = gt; i < 128 * 128; i += NGT) { const int k = i >> 7, n = i & 127, a = (k * n) & 127; C128[i] = (bf16)f2bf(cospif((float)a / 64.0f)); S128[i] = (bf16)f2bf(sinpif((float)a / 64.0f)); }
    for (int i = gt; i < 64 * 128; i += NGT) { const int k = i >> 7, nq = (i & 127) >> 1, ri = i & 1, a = (k * nq) & 63; T2M[i] = (bf16)f2bf(ri ? sinpif((float)a / 32.0f) : cospif((float)a / 32.0f)); }
    for (int i = gt; i < 256 * 512; i += NGT) { const int k = i >> 9, n = (i & 511) >> 1, ri = i & 1, a = (k * n) & 255; TCM[i] = (bf16)f2bf(ri ? sinpif((float)a / 128.0f) : cospif((float)a / 128.0f)); }
    for (int i = gt; i < 2048; i += NGT) { const float lam = INP(I_LAM)[i]; SP8[i] = 8.0f * log1pf(expf(-lam)); }
}
__device__ __forceinline__ void p0b_mods(Frame& F) {
    const int gt = F.wg * NTHR + F.tid, NGT = F.G * NTHR;
    const float* MP = WSP(float, WS_MODP); float* MS = WSP(float, WS_MODS);
    for (int i = gt; i < 2 * 5 * 6144; i += NGT) { const int l = i / (5 * 6144), r = i % (5 * 6144), s = r / 6144, j = r % 6144;
        float a = INP(I_BADA)[l * 6144 + j];
#pragma unroll
        for (int kq = 0; kq < 16; ++kq) a += MP[((size_t)(kq * 2 + l) * 5 + s) * 6144 + j];
        MS[i] = a; }
}

__device__ __forceinline__ int row_set(int row) { return row < NLAT ? (row >> 13) : 4; }
__device__ __forceinline__ void norm_mod_store(const f32x4 (&v)[4], const float* g, const float* shift, const float* scale, bf16* orow, int lane) {
    float ss = 0.f;
#pragma unroll
    for (int j = 0; j < 4; ++j) ss += (v[j].x * v[j].x + v[j].y * v[j].y) + (v[j].z * v[j].z + v[j].w * v[j].w);
    const float rstd = rsq_(wave_sum_fast(ss) * (1.0f / D) + EPS);
    unsigned long long* o8 = (unsigned long long*)orow + lane;
#pragma unroll
    for (int j = 0; j < 4; ++j) { const int c = 4 * lane + 256 * j;
        const f32x4 gg = *(const f32x4*)(g + c), sh = *(const f32x4*)(shift + c), sc = *(const f32x4*)(scale + c);
        const f32x4 o = (v[j] * rstd * gg) * (sc + 1.0f) + sh;
        o8[64 * j] = (unsigned long long)pk2(o.x, o.y) | ((unsigned long long)pk2(o.z, o.w) << 32); }
}
#define ROWCOL(lane, j) (8 * (lane) + 512 * ((j) >> 1) + 4 * ((j) & 1))
__device__ __forceinline__ void norm_mod_store8(const f32x4 (&v)[4], const float* g, const float* shift, const float* scale, bf16* orow, int lane) {
    float ss = 0.f;
#pragma unroll
    for (int j = 0; j < 4; ++j) ss += (v[j].x * v[j].x + v[j].y * v[j].y) + (v[j].z * v[j].z + v[j].w * v[j].w);
    const float rstd = rsq_(wave_sum_fast(ss) * (1.0f / D) + EPS);
#pragma unroll
    for (int h = 0; h < 2; ++h) { const int c = 8 * lane + 512 * h; f32x4 o[2];
#pragma unroll
        for (int q = 0; q < 2; ++q) { const f32x4 gg = *(const f32x4*)(g + c + 4 * q), sh = *(const f32x4*)(shift + c + 4 * q), sc = *(const f32x4*)(scale + c + 4 * q);
            o[q] = (v[2 * h + q] * rstd * gg) * (sc + 1.0f) + sh; }
        v4u w; w.x = pk2(o[0].x, o[0].y); w.y = pk2(o[0].z, o[0].w); w.z = pk2(o[1].x, o[1].y); w.w = pk2(o[1].z, o[1].w);
        *(v4u*)(orow + c) = w; }
}
__device__ __forceinline__ void load_row8(const bf16* row, int lane, f32x4 (&v)[4]) {
#pragma unroll
    for (int h = 0; h < 2; ++h) { const v4u w = *(const v4u*)(row + 8 * lane + 512 * h);
        v[2 * h] = (f32x4){bf2f(w.x & 0xffffu), bf2f(w.x >> 16), bf2f(w.y & 0xffffu), bf2f(w.y >> 16)}; v[2 * h + 1] = (f32x4){bf2f(w.z & 0xffffu), bf2f(w.z >> 16), bf2f(w.w & 0xffffu), bf2f(w.w >> 16)}; }
}
__device__ __forceinline__ void store_row8(bf16* row, int lane, const f32x4 (&v)[4]) {
#pragma unroll
    for (int h = 0; h < 2; ++h) { v4u w; w.x = pk2(v[2 * h].x, v[2 * h].y); w.y = pk2(v[2 * h].z, v[2 * h].w); w.z = pk2(v[2 * h + 1].x, v[2 * h + 1].y); w.w = pk2(v[2 * h + 1].z, v[2 * h + 1].w);
        *(v4u*)(row + 8 * lane + 512 * h) = w; }
}
__device__ __forceinline__ void s0_norm1(Frame& F) {
    const int gw = F.wg * NWAVES + F.wave, NGW = F.G * NWAVES;
    const float* MS = WSP(float, WS_MODS); bf16* HX = HXP();
    const int npairs = NROW / 2;
    f32x4 va[4], vb[4];
    if (gw < npairs) { const int ra = 2 * gw; const float* xr = ra < NLAT ? INP(I_X) + (size_t)ra * D : INP(I_CTX) + (size_t)(ra - NLAT) * D;
#pragma unroll
        for (int j = 0; j < 4; ++j) { va[j] = *(const f32x4*)(xr + 4 * F.lane + 256 * j); vb[j] = *(const f32x4*)(xr + D + 4 * F.lane + 256 * j); } }
    for (int rp = gw; rp < npairs; rp += NGW) {
        const int ra = 2 * rp; f32x4 na[4], nb[4]; const bool more = rp + NGW < npairs;
        if (more) { const int rn = 2 * (rp + NGW); const float* xr = rn < NLAT ? INP(I_X) + (size_t)rn * D : INP(I_CTX) + (size_t)(rn - NLAT) * D;
#pragma unroll
            for (int j = 0; j < 4; ++j) { na[j] = *(const f32x4*)(xr + 4 * F.lane + 256 * j); nb[j] = *(const f32x4*)(xr + D + 4 * F.lane + 256 * j); } }
        const float* m = MS + (size_t)row_set(ra) * 6144;
        norm_mod_store(va, INP(I_GN1), m, m + 1024, HX + (size_t)ra * D, F.lane);
        norm_mod_store(vb, INP(I_GN1), m, m + 1024, HX + (size_t)(ra + 1) * D, F.lane);
        if (more) {
#pragma unroll
            for (int j = 0; j < 4; ++j) { va[j] = na[j]; vb[j] = nb[j]; } }
    }
}

#define MFMA32(a, b, c) __builtin_amdgcn_mfma_f32_32x32x16_bf16((a), (b), (c), 0, 0, 0)
__device__ __forceinline__ bf16x8 ldsB_frag(const LAS bf16* t, int stride, int k0, int col, int lane) {
    const LAS bf16* p = t + (k0 + 8 * (lane >> 5)) * stride + col; bf16x8 r;
#pragma unroll
    for (int j = 0; j < 8; ++j) r[j] = (short)p[j * stride];
    return r;
}
__device__ __forceinline__ bf16x8 neg_frag(bf16x8 a) { v4u u = __builtin_bit_cast(v4u, a); u ^= 0x80008000u; return __builtin_bit_cast(bf16x8, u); }
__device__ __forceinline__ int rowmap(int r, int hh) { return (r & 3) + 8 * (r >> 2) + 4 * hh; }

constexpr int D1_STRIDE = 520;
__device__ __forceinline__ void dft1_unit(Frame& F, int b, int nq) {
    relaunder(F);
    LAS bf16* tile = (LAS bf16*)F.lds;
    const bf16* PX = WSP(bf16, WS_REGA);
#pragma unroll 4
    for (int i = 0; i < 16; ++i) { const int q = F.tid + NTHR * i, row = q >> 6, ch = q & 63;
        const v4u v = *(const v4u*)(PX + (size_t)(b * SEQ + 64 * row + nq) * PXC + PX_Z + ch * 8);
        *(LAS v4u*)(tile + row * D1_STRIDE + ch * 8) = v; }
    LDS_WAIT(); __syncthreads();
    const bf16* C128 = WSP(bf16, WS_C128); const bf16* S128 = WSP(bf16, WS_S128);
    const int hh = F.lane >> 5, ln = F.lane & 31, cw = 32 * F.wave + ln;
    f32x16 are[4], aim[4];
#pragma unroll
    for (int mb = 0; mb < 4; ++mb)
#pragma unroll
        for (int r = 0; r < 16; ++r) { are[mb][r] = 0.f; aim[mb][r] = 0.f; }
    for (int ks = 0; ks < 8; ++ks) {
        const bf16x8 xre = ldsB_frag(tile, D1_STRIDE, 16 * ks, cw, F.lane), xim = ldsB_frag(tile, D1_STRIDE, 16 * ks, 256 + cw, F.lane);
#pragma unroll
        for (int mb = 0; mb < 4; ++mb) {
            const bf16x8 cf = *(const bf16x8*)(C128 + (32 * mb + ln) * 128 + 16 * ks + 8 * hh), sf = *(const bf16x8*)(S128 + (32 * mb + ln) * 128 + 16 * ks + 8 * hh);
            are[mb] = MFMA32(cf, xre, are[mb]); are[mb] = MFMA32(sf, xim, are[mb]);
            aim[mb] = MFMA32(cf, xim, aim[mb]); aim[mb] = MFMA32(neg_frag(sf), xre, aim[mb]);
        }
    }
    const float* TW = WSP(float, WS_TW); bf16* T1 = WSP(bf16, WS_T1);
#pragma unroll
    for (int mb = 0; mb < 4; ++mb)
#pragma unroll
        for (int r = 0; r < 16; ++r) { const int kp = 32 * mb + rowmap(r, hh); const int a = (kp * nq) & 8191; const float c = TW[2 * a], s = TW[2 * a + 1];
            const float re = are[mb][r], im = aim[mb][r];
            bf16* o = T1 + ((size_t)((b * 128 + kp) * 64 + nq) * 2) * 256 + cw;
            o[0] = (bf16)f2bf(re * c + im * s); o[256] = (bf16)f2bf(im * c - re * s); }
    __syncthreads();
}
constexpr int D2_STRIDE = 264;
__device__ __forceinline__ void dft2_unit(Frame& F, int l, const bf16* Amat, int lda, int m0, int nchunks, const bf16* dbase, size_t tokstride, size_t chunkstride, float scale, int orow0, int ostride, const LAS bf16* Alds) {
    relaunder(F);
    LAS bf16* tile = (LAS bf16*)F.lds;
    const int hh = F.lane >> 5, ln = F.lane & 31, cw = 32 * F.wave + ln;
    f32x16 acc[2];
#pragma unroll
    for (int mb = 0; mb < 2; ++mb)
#pragma unroll
        for (int r = 0; r < 16; ++r) acc[mb][r] = 0.f;
    for (int ck = 0; ck < nchunks; ++ck) {
        const bf16* dsrc = dbase + (size_t)ck * chunkstride;
        { v4u dv[8];
#pragma unroll
          for (int i = 0; i < 8; ++i) { const int q = F.tid + NTHR * i, krow = q >> 5, ch = q & 31;
              dv[i] = *(const v4u*)(dsrc + (size_t)(krow >> 1) * tokstride + (krow & 1) * 256 + ch * 8); }
#pragma unroll
          for (int i = 0; i < 8; ++i) { const int q = F.tid + NTHR * i, krow = q >> 5, ch = q & 31; *(LAS v4u*)(tile + krow * D2_STRIDE + ch * 8) = dv[i]; } }
        LDS_WAIT(); __syncthreads();
        for (int ks = 0; ks < 8; ++ks) {
            const bf16x8 xf = ldsB_frag(tile, D2_STRIDE, 16 * ks, cw, F.lane);
#pragma unroll
            for (int mb = 0; mb < 2; ++mb) { const bf16x8 af = Alds ? *(const LAS bf16x8*)(Alds + (32 * mb + ln) * 136 + 16 * ks + 8 * hh) : *(const bf16x8*)(Amat + (size_t)(m0 + 32 * mb + ln) * lda + ck * 128 + 16 * ks + 8 * hh);
                acc[mb] = MFMA32(af, xf, acc[mb]); }
        }
        __syncthreads();
    }
    LAS float* yt = (LAS float*)F.lds;
#pragma unroll
    for (int mb = 0; mb < 2; ++mb)
#pragma unroll
        for (int r = 0; r < 16; ++r) yt[(32 * mb + rowmap(r, hh)) * 260 + cw] = acc[mb][r] * scale;
    LDS_WAIT(); __syncthreads();
    { const int m = F.tid >> 3, seg = F.tid & 7; const LAS float* p = yt + m * 260 + 32 * seg;
        f32x4 v[8]; float ss = 0.f;
#pragma unroll
        for (int j = 0; j < 8; ++j) { v[j] = *(const LAS f32x4*)(p + 4 * j); ss += (v[j].x * v[j].x + v[j].y * v[j].y) + (v[j].z * v[j].z + v[j].w * v[j].w); }
        ss += __shfl_xor(ss, 1); ss += __shfl_xor(ss, 2); ss += __shfl_xor(ss, 4);
        const float rstd = rsq_(ss * (1.0f / 256.0f) + EPS);
        const float* g = INP(I_GOUT) + l * 1024 + 768 + 32 * seg;
        bf16* o = WSP(bf16, WS_Y) + (size_t)(orow0 + m * ostride) * D + 768 + 32 * seg;
#pragma unroll
        for (int j = 0; j < 4; ++j) { const f32x4 g0 = *(const f32x4*)(g + 8 * j), g1 = *(const f32x4*)(g + 8 * j + 4); const f32x4 a = v[2 * j] * rstd * g0, c = v[2 * j + 1] * rstd * g1;
            v4u w; w.x = pk2(a.x, a.y); w.y = pk2(a.z, a.w); w.z = pk2(c.x, c.y); w.w = pk2(c.z, c.w); *(v4u*)(o + 8 * j) = w; } }
    __syncthreads();
}

constexpr int UT_STRIDE = 520;
constexpr int UT_BYTES = 64 * UT_STRIDE * 2;
struct UWin { u16x8 rows[11]; };
__device__ __forceinline__ void lru_bounds(int cid, int& lo, int& hi) { if (cid < 512) { lo = cid * 64; hi = lo + 64; } else { lo = NLAT + ((cid - 512) >> 2) * CTXL; hi = lo + CTXL; } }
__device__ __forceinline__ void lru_issue_u(Frame& F, int cid, UWin& w) {
    const bf16* PX = WSP(bf16, WS_REGA);
    const int row0 = cid * 64; int lo, hi; lru_bounds(cid, lo, hi);
    const int ch0 = (F.tid & 63) * 8, t0 = (F.tid >> 6) * 8;
#pragma unroll
    for (int k = 0; k < 11; ++k) { const int rr = row0 + t0 - 1 + k, rc = rr < lo ? lo : (rr >= hi ? hi - 1 : rr);
        w.rows[k] = *(const u16x8*)(PX + (size_t)rc * PXC + ch0); }
}
__device__ __forceinline__ void lru_finish_u(Frame& F, int l, int cid, UWin& win, LAS bf16* ut) {
    const int row0 = cid * 64; int lo, hi; lru_bounds(cid, lo, hi);
    const int ch0 = (F.tid & 63) * 8, t0 = (F.tid >> 6) * 8;
    f32x4 w[4][2], bias[2];
#pragma unroll
    for (int k = 0; k < 4; ++k) { w[k][0] = *(const f32x4*)(INP(I_LCW) + (l * 4 + k) * 512 + ch0); w[k][1] = *(const f32x4*)(INP(I_LCW) + (l * 4 + k) * 512 + ch0 + 4); }
    bias[0] = *(const f32x4*)(INP(I_LCB) + l * 512 + ch0); bias[1] = *(const f32x4*)(INP(I_LCB) + l * 512 + ch0 + 4);
#pragma unroll
    for (int k = 0; k < 11; ++k) { const int rr = row0 + t0 - 1 + k; if (rr < lo || rr >= hi) win.rows[k] = (u16x8){0, 0, 0, 0, 0, 0, 0, 0}; }
#pragma unroll
    for (int t = 0; t < 8; ++t) { f32x4 a0 = bias[0], a1 = bias[1];
#pragma unroll
        for (int k = 0; k < 4; ++k) { const u16x8 v = win.rows[t + k];
            a0 += w[k][0] * (f32x4){bf2f(v[0]), bf2f(v[1]), bf2f(v[2]), bf2f(v[3])}; a1 += w[k][1] * (f32x4){bf2f(v[4]), bf2f(v[5]), bf2f(v[6]), bf2f(v[7])}; }
        v4u o; o.x = pk2(a0.x, a0.y); o.y = pk2(a0.z, a0.w); o.z = pk2(a1.x, a1.y); o.w = pk2(a1.z, a1.w);
        *(LAS v4u*)(ut + (t0 + t) * UT_STRIDE + ch0) = o; }
}
struct LruOps { bf16x8 fr[2][4], fi[2][4]; float b_r[2], b_i[2], sp[2]; };
template <int dir> __device__ __forceinline__ void lru_load_ops(Frame& F, int l, int nb, LruOps& o) {
    const int hd = F.wave, hh = F.lane >> 5, ln = F.lane & 31, ch = hd * 64 + nb * 32 + ln;
    const bf16* WG = WSP(bf16, WS_WGL) + ((size_t)l * 8 + hd) * 256 * 64;
#pragma unroll
    for (int ks = 0; ks < 4; ++ks) {
        o.fr[dir][ks] = *(const bf16x8*)(WG + (size_t)((dir * 2 + 0) * 64 + nb * 32 + ln) * 64 + 16 * ks + 8 * hh);
        o.fi[dir][ks] = *(const bf16x8*)(WG + (size_t)((dir * 2 + 1) * 64 + nb * 32 + ln) * 64 + 16 * ks + 8 * hh); }
    o.b_r[dir] = -1.4426950408889634f * INP(I_LBR)[(l * 2 + dir) * 512 + ch]; o.b_i[dir] = -1.4426950408889634f * INP(I_LBI)[(l * 2 + dir) * 512 + ch]; o.sp[dir] = -1.4426950408889634f * WSP(float, WS_SP8)[(l * 2 + dir) * 512 + ch];
}
template <int dir> __device__ __forceinline__ void lru_gates(Frame& F, const LruOps& o, const LAS bf16* ut, int mb, f32x16& a, f32x16& bb) {
    const int hd = F.wave, hh = F.lane >> 5, ln = F.lane & 31;
#pragma unroll
    for (int r = 0; r < 16; ++r) { a[r] = 0.f; bb[r] = 0.f; }
#pragma unroll
    for (int ks = 0; ks < 4; ++ks) {
        const bf16x8 af = *(const LAS bf16x8*)(ut + (32 * mb + ln) * UT_STRIDE + hd * 64 + 16 * ks + 8 * hh);
        a = MFMA32(af, o.fr[dir][ks], a); bb = MFMA32(af, o.fi[dir][ks], bb);
    }
}
template <int dir> __device__ __forceinline__ void lru_elem(Frame& F, const LruOps& o, const LAS bf16* ut, int nb, int mb, f32x16& a, f32x16& bb) {
    const int hd = F.wave, hh = F.lane >> 5, ln = F.lane & 31, ch = hd * 64 + nb * 32 + ln;
    const float nb_r = o.b_r[dir], nb_i = o.b_i[dir], spl = o.sp[dir];
    const LAS bf16* ub = ut + (32 * mb + 4 * hh) * UT_STRIDE + ch;
#pragma unroll
    for (int r = 0; r < 16; ++r) {
        const float rr = __builtin_amdgcn_rcpf(1.0f + __builtin_amdgcn_exp2f(__builtin_fmaf(a[r], -1.4426950408889634f, nb_r)));
        const float ii = __builtin_amdgcn_rcpf(1.0f + __builtin_amdgcn_exp2f(__builtin_fmaf(bb[r], -1.4426950408889634f, nb_i)));
        const float av = __builtin_amdgcn_exp2f(rr * spl), mult = __builtin_amdgcn_sqrtf(__builtin_fmaf(-av, av, 1.0f));
        const float uv = bf2f(ub[((r & 3) + 8 * (r >> 2)) * UT_STRIDE]);
        a[r] = av; bb[r] = (mult * ii) * uv; }
}
#define MEMFENCE() asm volatile("" ::: "memory")
template <int dir> __device__ __forceinline__ float lru_scan(int lane, float hin, const f32x16& a, f32x16& bb, float* Atot) {
    const bool hi = (lane >> 5) != 0;
    const bool own_first = dir == 0 ? !hi : hi;
    float oA[4], oB[4];
#pragma unroll
    for (int q = 0; q < 4; ++q) {
        const float a0 = a[4 * q], a1 = a[4 * q + 1], a2 = a[4 * q + 2], a3 = a[4 * q + 3];
        const float b0 = bb[4 * q], b1 = bb[4 * q + 1], b2 = bb[4 * q + 2], b3 = bb[4 * q + 3];
        oA[q] = (a0 * a1) * (a2 * a3);
        oB[q] = dir == 0 ? ((b0 * a1 + b1) * a2 + b2) * a3 + b3 : ((b3 * a2 + b2) * a1 + b1) * a0 + b0; }
    float h = hin, At = 1.0f; float cin[4];
#pragma unroll
    for (int s = 0; s < 4; ++s) { const int q = dir == 0 ? s : 3 - s;
        const float pA = __shfl_xor(oA[q], 32), pB = __shfl_xor(oB[q], 32);
        const float A1 = own_first ? oA[q] : pA, B1 = own_first ? oB[q] : pB, A2 = own_first ? pA : oA[q], B2 = own_first ? pB : oB[q];
        const float h1 = A1 * h + B1, h2 = A2 * h1 + B2;
        cin[q] = own_first ? h : h1; h = h2; At *= A1 * A2; }
#pragma unroll
    for (int q = 0; q < 4; ++q) { float x = cin[q];
        if (dir == 0) {
#pragma unroll
            for (int j = 0; j < 4; ++j) { x = a[4 * q + j] * x + bb[4 * q + j]; bb[4 * q + j] = x; }
        } else {
#pragma unroll
            for (int j = 3; j >= 0; --j) { x = a[4 * q + j] * x + bb[4 * q + j]; bb[4 * q + j] = x; }
        } }
    *Atot = At; return h;
}
__device__ __forceinline__ void lru_a_phase(Frame& F, int l) {
    relaunder(F);
    LAS bf16* ut = (LAS bf16*)F.lds;
    float* SM = WSP(float, WS_SUMM);
    constexpr int NUNIT = 512 + 2 * (NCHUNK - 512);
    int un = F.wg; UWin win;
    if (un < NUNIT) lru_issue_u(F, un < 512 ? un : 512 + ((un - 512) >> 1), win);
    for (; un < NUNIT; un += F.G) {
        const int cid = un < 512 ? un : 512 + ((un - 512) >> 1), nbsel = un < 512 ? -1 : ((un - 512) & 1);
        LruOps o; lru_load_ops<0>(F, l, nbsel < 0 ? 0 : nbsel, o);
        lru_finish_u(F, l, cid, win, ut);
        LDS_WAIT(); __syncthreads();
        if (un + F.G < NUNIT) { const int u2 = un + F.G; lru_issue_u(F, u2 < 512 ? u2 : 512 + ((u2 - 512) >> 1), win); }
#pragma unroll
        for (int nb = 0; nb < 2; ++nb) { const int ch = F.wave * 64 + nb * 32 + (F.lane & 31);
            if (nbsel >= 0 && nb != nbsel) continue;
            f32x16 a, bb; float A0, A1;
            lru_gates<0>(F, o, ut, 0, a, bb); lru_elem<0>(F, o, ut, nb, 0, a, bb); const float B0 = lru_scan<0>(F.lane, 0.0f, a, bb, &A0);
            lru_gates<0>(F, o, ut, 1, a, bb); MEMFENCE(); lru_load_ops<1>(F, l, nb, o); MEMFENCE();
            lru_elem<0>(F, o, ut, nb, 1, a, bb); const float B1 = lru_scan<0>(F.lane, B0, a, bb, &A1);
            if (F.lane < 32) { SM[((size_t)(cid * 2 + 0) * 2 + 0) * 512 + ch] = A0 * A1; SM[((size_t)(cid * 2 + 0) * 2 + 1) * 512 + ch] = B1; }
            lru_gates<1>(F, o, ut, 1, a, bb); lru_elem<1>(F, o, ut, nb, 1, a, bb); const float C1 = lru_scan<1>(F.lane, 0.0f, a, bb, &A1);
            lru_gates<1>(F, o, ut, 0, a, bb); if (nb == 0 && nbsel < 0) { MEMFENCE(); lru_load_ops<0>(F, l, 1, o); MEMFENCE(); }
            lru_elem<1>(F, o, ut, nb, 0, a, bb); const float C0 = lru_scan<1>(F.lane, C1, a, bb, &A0);
            if (F.lane < 32) { SM[((size_t)(cid * 2 + 1) * 2 + 0) * 512 + ch] = A0 * A1; SM[((size_t)(cid * 2 + 1) * 2 + 1) * 512 + ch] = C0; }
        }
        __syncthreads();
    }
}
__device__ __forceinline__ int carry_cid(int b, int dir, int st) { return dir == 0 ? (st < 4 ? 512 + 4 * b + st : 128 * b + st - 4) : (st < 4 ? 512 + 4 * b + 3 - st : 128 * b + 131 - st); }
__device__ __forceinline__ void s3_carries(Frame& F, int wv  ) {
    const int part = F.lane >> 3, seq = wv * 8 + (F.lane & 7), b = seq >> 10, dir = (seq >> 9) & 1, ch = seq & 511;
    const int s0 = part * 16 + (part < 4 ? part : 4), len = part < 4 ? 17 : 16;
    const float* __restrict__ SM = WSP(float, WS_SUMM); float* __restrict__ CR = WSP(float, WS_CARRY);
    float A[17], B[17];
#pragma unroll
    for (int j = 0; j < 17; ++j) { const int st = s0 + (j < len ? j : 0), cid = carry_cid(b, dir, st);
        A[j] = SM[((size_t)(cid * 2 + dir) * 2 + 0) * 512 + ch]; B[j] = SM[((size_t)(cid * 2 + dir) * 2 + 1) * 512 + ch]; }
    float At = 1.f, Bt = 0.f;
#pragma unroll
    for (int j = 0; j < 17; ++j) if (j < len) { Bt = A[j] * Bt + B[j]; At *= A[j]; }
#pragma unroll
    for (int d = 8; d < 64; d <<= 1) { const float pA = __shfl_up(At, d), pB = __shfl_up(Bt, d); if (F.lane >= d) { Bt = At * pB + Bt; At = At * pA; } }
    float h = __shfl_up(Bt, 8); if (part == 0) h = 0.f;
#pragma unroll
    for (int j = 0; j < 17; ++j) if (j < len) { const int cid = carry_cid(b, dir, s0 + j); CR[(size_t)(cid * 2 + dir) * 512 + ch] = h; h = A[j] * h + B[j]; }
}
__device__ __forceinline__ float gelu_tanh(float x) { const float u = x * x, t = x * __builtin_fmaf(u, -0.10294324f, -2.3022082f);
    return x * __builtin_amdgcn_rcpf(1.0f + __builtin_amdgcn_exp2f(t)); }
__device__ __forceinline__ void lru_b_issue_g(Frame& F, int cid, v4u (&gv)[8]) {
    const bf16* PX = WSP(bf16, WS_REGA); const int row0 = cid * 64;
#pragma unroll
    for (int i = 0; i < 8; ++i) { const int q = F.tid + NTHR * i, tok = q >> 6, cg = q & 63; gv[i] = *(const v4u*)(PX + (size_t)(row0 + tok) * PXC + 512 + cg * 8); }
}
__device__ __forceinline__ void lru_b_phase(Frame& F, int l, int nc) {
    relaunder(F);
    LAS bf16* ut = (LAS bf16*)F.lds; LAS bf16* gt = (LAS bf16*)(F.lds + UT_BYTES);
    const float* CR = WSP(float, WS_CARRY); bf16* Y = WSP(bf16, WS_Y);
    const int hh = F.lane >> 5, ln = F.lane & 31;
    int cid = F.wg; UWin win;
    if (cid < nc) lru_issue_u(F, cid, win);
    for (; cid < nc; cid += F.G) {
        const int row0 = cid * 64;
        v4u gv[8]; lru_b_issue_g(F, cid, gv);
        LruOps o; lru_load_ops<0>(F, l, 0, o);
        float cr0 = CR[(size_t)(cid * 2 + 0) * 512 + F.wave * 64 + ln], cr1 = CR[(size_t)(cid * 2 + 1) * 512 + F.wave * 64 + ln];
        lru_finish_u(F, l, cid, win, ut);
#pragma unroll
        for (int i = 0; i < 8; ++i) { const int q = F.tid + NTHR * i, tok = q >> 6, cg = q & 63; *(LAS v4u*)(gt + tok * UT_STRIDE + cg * 8) = gv[i]; }
        LDS_WAIT(); __syncthreads();
        if (cid + F.G < nc) lru_issue_u(F, cid + F.G, win);
#pragma unroll
        for (int nb = 0; nb < 2; ++nb) { const int ch = F.wave * 64 + nb * 32 + ln;
            f32x16 hs0, hs1, a, bb; float At;
            lru_gates<0>(F, o, ut, 0, a, bb); lru_elem<0>(F, o, ut, nb, 0, a, bb); const float hm0 = lru_scan<0>(F.lane, cr0, a, bb, &At); hs0 = bb;
            lru_gates<0>(F, o, ut, 1, a, bb); MEMFENCE(); lru_load_ops<1>(F, l, nb, o); MEMFENCE();
            lru_elem<0>(F, o, ut, nb, 1, a, bb); (void)lru_scan<0>(F.lane, hm0, a, bb, &At); hs1 = bb;
            lru_gates<1>(F, o, ut, 1, a, bb); lru_elem<1>(F, o, ut, nb, 1, a, bb); const float hm1 = lru_scan<1>(F.lane, cr1, a, bb, &At); hs1 += bb;
            lru_gates<1>(F, o, ut, 0, a, bb);
            if (nb == 0) { MEMFENCE(); lru_load_ops<0>(F, l, 1, o); cr0 = CR[(size_t)(cid * 2 + 0) * 512 + ch + 32]; cr1 = CR[(size_t)(cid * 2 + 1) * 512 + ch + 32]; MEMFENCE(); }
            lru_elem<1>(F, o, ut, nb, 0, a, bb); (void)lru_scan<1>(F.lane, hm1, a, bb, &At); hs0 += bb;
            LAS bf16* gb = gt + (4 * hh) * UT_STRIDE + ch;
#pragma unroll
            for (int r = 0; r < 16; ++r) { LAS bf16* p = gb + ((r & 3) + 8 * (r >> 2)) * UT_STRIDE;
                const float g = bf2f(*p); *p = (bf16)f2bf(hs0[r] * gelu_tanh(g)); }
#pragma unroll
            for (int r = 0; r < 16; ++r) { LAS bf16* p = gb + (32 + (r & 3) + 8 * (r >> 2)) * UT_STRIDE;
                const float g = bf2f(*p); *p = (bf16)f2bf(hs1[r] * gelu_tanh(g)); }
        }
        LDS_WAIT(); __syncthreads();
        {
            const int tok = F.tid >> 3, seg = F.tid & 7; const LAS bf16* p = gt + tok * UT_STRIDE + 64 * seg;
            u16x8 v[8]; float ss = 0.f;
#pragma unroll
            for (int j = 0; j < 8; ++j) { v[j] = *(const LAS u16x8*)(p + 8 * j);
#pragma unroll
                for (int e = 0; e < 8; ++e) { const float f = bf2f(v[j][e]); ss += f * f; } }
            ss += __shfl_xor(ss, 1); ss += __shfl_xor(ss, 2); ss += __shfl_xor(ss, 4);
            const float rstd = rsq_(ss * (1.0f / 512.0f) + EPS);
            const float* g = INP(I_GOUT) + l * 1024 + 64 * seg; bf16* op = Y + (size_t)(row0 + tok) * D + 64 * seg;
#pragma unroll
            for (int j = 0; j < 8; ++j) { const f32x4 g0 = *(const f32x4*)(g + 8 * j), g1 = *(const f32x4*)(g + 8 * j + 4);
                v4u w; w.x = pk2(bf2f(v[j][0]) * rstd * g0.x, bf2f(v[j][1]) * rstd * g0.y); w.y = pk2(bf2f(v[j][2]) * rstd * g0.z, bf2f(v[j][3]) * rstd * g0.w);
                w.z = pk2(bf2f(v[j][4]) * rstd * g1.x, bf2f(v[j][5]) * rstd * g1.y); w.w = pk2(bf2f(v[j][6]) * rstd * g1.z, bf2f(v[j][7]) * rstd * g1.w);
                *(v4u*)(op + 8 * j) = w; } }
        __syncthreads();
    }
}
struct ScWin { u16x8 pp[4], bv[2]; };
__device__ __forceinline__ void sc_issue(Frame& F, int hu, ScWin& w) {
    const bf16* PX = WSP(bf16, WS_REGA); const int cid = hu >> 1, row0 = hu * 32, c0 = 8 * (F.tid & 31), t0 = (F.tid >> 5) * 2; int lo, hi; lru_bounds(cid, lo, hi);
#pragma unroll
    for (int k = 0; k < 4; ++k) { const int r2 = row0 + t0 - 1 + k, rc = r2 < lo ? lo : (r2 >= hi ? hi - 1 : r2);
        w.pp[k] = *(const u16x8*)(PX + (size_t)rc * PXC + 1280 + c0); }
#pragma unroll
    for (int t = 0; t < 2; ++t) w.bv[t] = *(const u16x8*)(PX + (size_t)(row0 + t0 + t) * PXC + 1024 + c0);
}
__device__ __forceinline__ void sc_phase(Frame& F, int l, int nc, int wg0, int nwg) {
    relaunder(F);
    if (F.wg < wg0) return;
    bf16* Y = WSP(bf16, WS_Y);
    const int c0 = 8 * (F.tid & 31), t0 = (F.tid >> 5) * 2, nh = 2 * nc;
    f32x4 w[3][2], gg[2];
#pragma unroll
    for (int k = 0; k < 3; ++k) { w[k][0] = *(const f32x4*)(INP(I_SCW) + (l * 3 + k) * 256 + c0); w[k][1] = *(const f32x4*)(INP(I_SCW) + (l * 3 + k) * 256 + c0 + 4); }
    gg[0] = *(const f32x4*)(INP(I_GOUT) + l * 1024 + 512 + c0); gg[1] = *(const f32x4*)(INP(I_GOUT) + l * 1024 + 512 + c0 + 4);
    int hu = F.wg - wg0; ScWin cur;
    if (hu < nh) sc_issue(F, hu, cur);
    for (; hu < nh; hu += nwg) {
        ScWin nxt; const bool more = hu + nwg < nh;
        if (more) sc_issue(F, hu + nwg, nxt);
        const int row0 = hu * 32; int lo, hi; lru_bounds(hu >> 1, lo, hi);
        f32x4 p0[4], p1[4];
#pragma unroll
        for (int k = 0; k < 4; ++k) { const int r2 = row0 + t0 - 1 + k; const float ok = (r2 >= lo && r2 < hi) ? 1.0f : 0.0f;
            p0[k] = (f32x4){bf2f(cur.pp[k][0]), bf2f(cur.pp[k][1]), bf2f(cur.pp[k][2]), bf2f(cur.pp[k][3])} * ok;
            p1[k] = (f32x4){bf2f(cur.pp[k][4]), bf2f(cur.pp[k][5]), bf2f(cur.pp[k][6]), bf2f(cur.pp[k][7])} * ok; }
#pragma unroll
        for (int t = 0; t < 2; ++t) { const u16x8 bv = cur.bv[t];
            f32x4 a0 = (w[0][0] * p0[t] + w[1][0] * p0[t + 1] + w[2][0] * p0[t + 2]) * (f32x4){bf2f(bv[0]), bf2f(bv[1]), bf2f(bv[2]), bf2f(bv[3])};
            f32x4 a1 = (w[0][1] * p1[t] + w[1][1] * p1[t + 1] + w[2][1] * p1[t + 2]) * (f32x4){bf2f(bv[4]), bf2f(bv[5]), bf2f(bv[6]), bf2f(bv[7])};
            float ss = (a0.x * a0.x + a0.y * a0.y) + (a0.z * a0.z + a0.w * a0.w) + (a1.x * a1.x + a1.y * a1.y) + (a1.z * a1.z + a1.w * a1.w);
            ss += __shfl_xor(ss, 1); ss += __shfl_xor(ss, 2); ss += __shfl_xor(ss, 4); ss += __shfl_xor(ss, 8); ss += __shfl_xor(ss, 16);
            const float rstd = rsq_(ss * (1.0f / 256.0f) + EPS);
            a0 = a0 * rstd * gg[0]; a1 = a1 * rstd * gg[1];
            v4u wv; wv.x = pk2(a0.x, a0.y); wv.y = pk2(a0.z, a0.w); wv.z = pk2(a1.x, a1.y); wv.w = pk2(a1.z, a1.w);
            *(v4u*)(Y + (size_t)(row0 + t0 + t) * D + 512 + c0) = wv; }
        if (more) cur = nxt;
    }
}

__device__ __forceinline__ void s6_norm2_router(Frame& F, int l, int pair0, int npairs, int gw, int NGW) {
    LAS float* wP = (LAS float*)F.lds;
    for (int c = F.tid; c < 1024; c += NTHR) { const float* w = INP(I_WRT) + (size_t)l * 16384 + c * 16;
        const int h = c >> 9, ln = (c & 511) >> 3, q = (c >> 2) & 1, i = c & 3, base = (h * 2 + q) * 256 + 4 * ln + i;
        const f32x4 w0 = *(const f32x4*)w, w1 = *(const f32x4*)(w + 4), w2 = *(const f32x4*)(w + 8), w3 = *(const f32x4*)(w + 12);
        const float wv[16] = {w0.x, w0.y, w0.z, w0.w, w1.x, w1.y, w1.z, w1.w, w2.x, w2.y, w2.z, w2.w, w3.x, w3.y, w3.z, w3.w};
#pragma unroll
        for (int e = 0; e < 16; ++e) wP[e * 1024 + base] = wv[e]; }
    LDS_WAIT(); __syncthreads();
    const float* MS = WSP(float, WS_MODS) + (size_t)l * 5 * 6144; bf16* HX = HXP(); int* ENT = WSP(int, WS_ENT); const bf16* XB = XBP();
    const float* g2 = INP(I_GN2) + l * 1024;
    const bool up32 = (F.lane & 32) != 0, up16 = (F.lane & 16) != 0, up8 = (F.lane & 8) != 0, up4 = (F.lane & 4) != 0, up2 = (F.lane & 2) != 0;
    v4u ra_[2], rb_[2];
    if (pair0 + gw < npairs) { const bf16* xr = XB + (size_t)(2 * (pair0 + gw)) * D;
#pragma unroll
        for (int h = 0; h < 2; ++h) { ra_[h] = *(const v4u*)(xr + 8 * F.lane + 512 * h); rb_[h] = *(const v4u*)(xr + D + 8 * F.lane + 512 * h); } }
    for (int rp = pair0 + gw; rp < npairs; rp += NGW) {
        const int ra = 2 * rp; const bool more = rp + NGW < npairs;
        v4u na_[2], nb_[2];
        if (more) { const bf16* xr = XB + (size_t)(2 * (rp + NGW)) * D;
#pragma unroll
            for (int h = 0; h < 2; ++h) { na_[h] = *(const v4u*)(xr + 8 * F.lane + 512 * h); nb_[h] = *(const v4u*)(xr + D + 8 * F.lane + 512 * h); } }
        f32x4 va[4], vb[4];
#pragma unroll
        for (int h = 0; h < 2; ++h) {
            va[2 * h] = (f32x4){bf2f(ra_[h].x & 0xffffu), bf2f(ra_[h].x >> 16), bf2f(ra_[h].y & 0xffffu), bf2f(ra_[h].y >> 16)}; va[2 * h + 1] = (f32x4){bf2f(ra_[h].z & 0xffffu), bf2f(ra_[h].z >> 16), bf2f(ra_[h].w & 0xffffu), bf2f(ra_[h].w >> 16)};
            vb[2 * h] = (f32x4){bf2f(rb_[h].x & 0xffffu), bf2f(rb_[h].x >> 16), bf2f(rb_[h].y & 0xffffu), bf2f(rb_[h].y >> 16)}; vb[2 * h + 1] = (f32x4){bf2f(rb_[h].z & 0xffffu), bf2f(rb_[h].z >> 16), bf2f(rb_[h].w & 0xffffu), bf2f(rb_[h].w >> 16)}; }
        float sa = 0.f, sb = 0.f;
#pragma unroll
        for (int j = 0; j < 4; ++j) {
            sa += (va[j].x * va[j].x + va[j].y * va[j].y) + (va[j].z * va[j].z + va[j].w * va[j].w); sb += (vb[j].x * vb[j].x + vb[j].y * vb[j].y) + (vb[j].z * vb[j].z + vb[j].w * vb[j].w); }
        const float ra_std = rsq_(wave_sum_fast(sa) * (1.0f / D) + EPS), rb_std = rsq_(wave_sum_fast(sb) * (1.0f / D) + EPS);
        const float* m = MS + (size_t)row_set(ra) * 6144;
#pragma unroll
        for (int j = 0; j < 4; ++j) { const int c = ROWCOL(F.lane, j);
            const f32x4 gg = *(const f32x4*)(g2 + c), sh = *(const f32x4*)(m + 3 * 1024 + c), sc = *(const f32x4*)(m + 4 * 1024 + c) + 1.0f;
            va[j] = (va[j] * ra_std * gg) * sc + sh; vb[j] = (vb[j] * rb_std * gg) * sc + sh; }
        store_row8(HX + (size_t)ra * D, F.lane, va); store_row8(HX + (size_t)(ra + 1) * D, F.lane, vb);
        float lg[32];
#pragma unroll
        for (int e = 0; e < 16; ++e) { float a = 0.f, b = 0.f;
#pragma unroll
            for (int j = 0; j < 4; ++j) { const f32x4 w = *(const LAS f32x4*)(wP + e * 1024 + j * 256 + 4 * F.lane);
                a += (va[j].x * w.x + va[j].y * w.y) + (va[j].z * w.z + va[j].w * w.w); b += (vb[j].x * w.x + vb[j].y * w.y) + (vb[j].z * w.z + vb[j].w * w.w); }
            lg[e] = a; lg[16 + e] = b; }
#define RS_STEP(n, msk, up) _Pragma("unroll") for (int i = 0; i < (n) / 2; ++i) { const float keep = (up) ? lg[i + (n) / 2] : lg[i], send = (up) ? lg[i] : lg[i + (n) / 2]; lg[i] = keep + __shfl_xor(send, (msk)); }
        RS_STEP(32, 32, up32) RS_STEP(16, 16, up16) RS_STEP(8, 8, up8) RS_STEP(4, 4, up4) RS_STEP(2, 2, up2)
#undef RS_STEP
        float v = lg[0] + __shfl_xor(lg[0], 1);
        float mx = row_max16(v); mx = fmaxf(mx, __shfl_xor(mx, 16));
        const float ex = __expf(v - mx); float den = row_sum16(ex); den += __shfl_xor(den, 16);
        const float p = 2.0f * ex / den;
        if ((F.lane & 1) == 0) { const int row = ra + (F.lane >> 5), e = (F.lane >> 1) & 15;
            if (row < NLAT) WSP(float, WS_AFFL)[((size_t)((row >> 13) * 16 + e)) * SEQ + (row & (SEQ - 1))] = p;
            else { const int rc = row - NLAT; WSP(float, WS_AFFC)[((size_t)((rc >> 8) * 16 + e)) * CTXL + (rc & (CTXL - 1))] = p; }
            ENT[(size_t)row * 16 + e] = -1; }
        if (more) {
#pragma unroll
            for (int h = 0; h < 2; ++h) { ra_[h] = na_[h]; rb_[h] = nb_[h]; } }
    }
    __syncthreads();
}
__device__ __forceinline__ void s7_topk_problem(Frame& F, const float* aff, int n, int cap, int slab_base, int tokrow_base, int e) {
    LAS unsigned* keys = (LAS unsigned*)F.lds;
    LAS unsigned* hist = keys + 8192;
    LAS unsigned* wtot = hist + 256;
    LAS unsigned* ctl = wtot + 16;
    if (n == SEQ) {
        float kv[16];
#pragma unroll
        for (int i = 0; i < 16; ++i) kv[i] = aff[F.tid + NTHR * i];
#pragma unroll
        for (int i = 0; i < 16; ++i) keys[F.tid + NTHR * i] = __builtin_bit_cast(unsigned, kv[i]);
    } else for (int i = F.tid; i < n; i += NTHR) keys[i] = __builtin_bit_cast(unsigned, aff[i]);
    unsigned prefix = 0u, mask = 0u; int kk = cap;
    for (int pass = 0; pass < 4; ++pass) { const int shift = 24 - 8 * pass;
        if (F.tid < 256) hist[F.tid] = 0u;
        LDS_WAIT(); __syncthreads();
        for (int i = F.tid; i < n; i += NTHR) { const unsigned k = keys[i]; if ((k & mask) == prefix) atomicAdd((unsigned*)&hist[(k >> shift) & 255u], 1u); }
        LDS_WAIT(); __syncthreads();
        if (F.wave == 0) {
            const v4u c = *(const LAS v4u*)(hist + 4 * F.lane); const unsigned s4 = c.x + c.y + c.z + c.w; unsigned suf = s4;
#pragma unroll
            for (int d = 1; d < 64; d <<= 1) { const unsigned t = __shfl_down(suf, d); if (F.lane + d < 64) suf += t; }
            const unsigned above = suf - s4;
            if (above < (unsigned)kk && suf >= (unsigned)kk) { unsigned cum = above; int bin;
                if (cum + c.w >= (unsigned)kk) bin = 3; else { cum += c.w; if (cum + c.z >= (unsigned)kk) bin = 2; else { cum += c.z; if (cum + c.y >= (unsigned)kk) bin = 1; else { cum += c.y; bin = 0; } } }
                ctl[0] = (unsigned)(4 * F.lane + bin); ctl[1] = (unsigned)kk - cum; } }
        LDS_WAIT(); __syncthreads();
        prefix |= ctl[0] << shift; mask |= 0xFFu << shift; kk = (int)ctl[1];
        __syncthreads();
    }
    const unsigned T = prefix;
    const int per = (n + NTHR - 1) / NTHR, i0 = F.tid * per;
    unsigned ngt = 0u, neq = 0u;
    for (int i = i0; i < i0 + per && i < n; ++i) { const unsigned k = keys[i]; ngt += k > T; neq += k == T; }
    unsigned igt = ngt, ieq = neq;
#pragma unroll
    for (int d = 1; d < 64; d <<= 1) { const unsigned a = __shfl_up(igt, d), b = __shfl_up(ieq, d); if (F.lane >= d) { igt += a; ieq += b; } }
    if (F.lane == 63) { wtot[2 * F.wave] = igt; wtot[2 * F.wave + 1] = ieq; }
    LDS_WAIT(); __syncthreads();
    unsigned bgt = igt - ngt, beq = ieq - neq;
    for (int w = 0; w < F.wave; ++w) { bgt += wtot[2 * w]; beq += wtot[2 * w + 1]; }
    int* IDX = WSP(int, WS_IDX); float* GV = WSP(float, WS_GVAL); int* ENT = WSP(int, WS_ENT);
    for (int i = i0; i < i0 + per && i < n; ++i) { const unsigned k = keys[i];
        const bool sel = k > T || (k == T && (int)beq < kk);
        if (sel) { const int slot = (int)bgt + ((int)beq < kk ? (int)beq : kk); const int sr = slab_base + slot, tr = tokrow_base + i;
            IDX[sr] = tr; GV[sr] = __builtin_bit_cast(float, k); ENT[(size_t)tr * 16 + e] = sr; }
        bgt += k > T; beq += k == T; }
    __syncthreads();
}
__device__ __forceinline__ void s8_gather(Frame& F, bool do_ctx) {
    const int gw = F.wg * NWAVES + F.wave, NGW = F.G * NWAVES;
    const int* IDX = WSP(int, WS_IDX); const bf16* HX = HXP(); bf16* XE = WSP(bf16, WS_REGB);
    const int total = SLAB_L + (do_ctx ? NE * 128 : 0);
    for (int i = gw; i < total; i += NGW) {
        const int sr = i < SLAB_L ? i : SLAB_L + ((i - SLAB_L) >> 7) * 256 + ((i - SLAB_L) & 127);
        const int tr = IDX[sr];
        const v4u a = *(const v4u*)(HX + (size_t)tr * D + 8 * F.lane), b = *(const v4u*)(HX + (size_t)tr * D + 512 + 8 * F.lane);
        *(v4u*)(XE + (size_t)sr * D + 8 * F.lane) = a; *(v4u*)(XE + (size_t)sr * D + 512 + 8 * F.lane) = b; }
}
__device__ __forceinline__ void s11_finish_row(Frame& F, int l, int row, bf16* xr, f32x4 (&v)[4], const f32x4 (&acc)[4], bool last) {
    const float* MS = WSP(float, WS_MODS); const int s = row_set(row);
    const float* gate = MS + ((size_t)l * 5 + s) * 6144 + 5 * 1024;
#pragma unroll
    for (int j = 0; j < 4; ++j) v[j] += *(const f32x4*)(gate + ROWCOL(F.lane, j)) * acc[j];
    if (!last) {
        store_row8(xr, F.lane, v);
        const float* m = MS + ((size_t)(l + 1) * 5 + s) * 6144;
        norm_mod_store8(v, INP(I_GN1) + (l + 1) * 1024, m, m + 1024, HXP() + (size_t)row * D, F.lane);
    } else {
        float ss = 0.f;
#pragma unroll
        for (int j = 0; j < 4; ++j) ss += (v[j].x * v[j].x + v[j].y * v[j].y) + (v[j].z * v[j].z + v[j].w * v[j].w);
        const float rstd = rsq_(wave_sum_fast(ss) * (1.0f / D) + EPS);
#pragma unroll
        for (int j = 0; j < 4; ++j) *(f32x4*)(OUTP() + (size_t)row * D + ROWCOL(F.lane, j)) = v[j] * rstd * *(const f32x4*)(INP(I_GF) + ROWCOL(F.lane, j));
    }
}
__device__ __forceinline__ void s11_combine(Frame& F, int l, bool do_ctx, bool last) {
    const int gw = F.wg * NWAVES + F.wave, NGW = F.G * NWAVES;
    const bf16* YS = WSP(bf16, WS_REGB); const int* ENT = WSP(int, WS_ENT); bf16* XB = XBP();
    const int npairs = (do_ctx ? NROW : NLAT) / 2;
    v4u ra_[2], rb_[2]; int ent = -1;
    if (gw < npairs) { const bf16* xr = XB + (size_t)(2 * gw) * D;
#pragma unroll
        for (int h = 0; h < 2; ++h) { ra_[h] = *(const v4u*)(xr + 8 * F.lane + 512 * h); rb_[h] = *(const v4u*)(xr + D + 8 * F.lane + 512 * h); }
        ent = F.lane < 32 ? ENT[(size_t)(2 * gw) * 16 + F.lane] : -1; }
    for (int rp = gw; rp < npairs; rp += NGW) {
        const int ra = 2 * rp; bf16* xa = XB + (size_t)ra * D; bf16* xb = xa + D;
        f32x4 aa[4], ab[4]; v4u na_[2], nb_[2]; int nent = -1; const bool more = rp + NGW < npairs;
#pragma unroll
        for (int j = 0; j < 4; ++j) { aa[j] = (f32x4){0.f, 0.f, 0.f, 0.f}; ab[j] = (f32x4){0.f, 0.f, 0.f, 0.f}; }
        if (more) { const int rn = 2 * (rp + NGW); const bf16* xr = XB + (size_t)rn * D;
#pragma unroll
            for (int h = 0; h < 2; ++h) { na_[h] = *(const v4u*)(xr + 8 * F.lane + 512 * h); nb_[h] = *(const v4u*)(xr + D + 8 * F.lane + 512 * h); }
            nent = F.lane < 32 ? ENT[(size_t)rn * 16 + F.lane] : -1; }
        const unsigned long long bm = __ballot(ent >= 0);
        unsigned ma = (unsigned)bm & 0xffffu, mb = ((unsigned)bm >> 16) & 0xffffu;
        do {
            int sa[4], sb[4]; float wa[4], wb[4];
#pragma unroll
            for (int j = 0; j < 4; ++j) {
                if (ma) { const int e = __builtin_ctz(ma); ma &= ma - 1; sa[j] = __builtin_amdgcn_readlane(ent, e); wa[j] = 1.f; } else { sa[j] = 0; wa[j] = 0.f; }
                if (mb) { const int e = __builtin_ctz(mb); mb &= mb - 1; sb[j] = __builtin_amdgcn_readlane(ent, 16 + e); wb[j] = 1.f; } else { sb[j] = 0; wb[j] = 0.f; } }
            v4u ya[4][2], yb[4][2];
#pragma unroll
            for (int j = 0; j < 4; ++j)
#pragma unroll
                for (int h = 0; h < 2; ++h) { ya[j][h] = *(const v4u*)(YS + (size_t)sa[j] * D + 8 * F.lane + 512 * h); yb[j][h] = *(const v4u*)(YS + (size_t)sb[j] * D + 8 * F.lane + 512 * h); }
#pragma unroll
            for (int j = 0; j < 4; ++j)
#pragma unroll
                for (int h = 0; h < 2; ++h) {
                    aa[2 * h].x += wa[j] * bf2f(ya[j][h].x & 0xffffu); aa[2 * h].y += wa[j] * bf2f(ya[j][h].x >> 16); aa[2 * h].z += wa[j] * bf2f(ya[j][h].y & 0xffffu); aa[2 * h].w += wa[j] * bf2f(ya[j][h].y >> 16);
                    aa[2 * h + 1].x += wa[j] * bf2f(ya[j][h].z & 0xffffu); aa[2 * h + 1].y += wa[j] * bf2f(ya[j][h].z >> 16); aa[2 * h + 1].z += wa[j] * bf2f(ya[j][h].w & 0xffffu); aa[2 * h + 1].w += wa[j] * bf2f(ya[j][h].w >> 16);
                    ab[2 * h].x += wb[j] * bf2f(yb[j][h].x & 0xffffu); ab[2 * h].y += wb[j] * bf2f(yb[j][h].x >> 16); ab[2 * h].z += wb[j] * bf2f(yb[j][h].y & 0xffffu); ab[2 * h].w += wb[j] * bf2f(yb[j][h].y >> 16);
                    ab[2 * h + 1].x += wb[j] * bf2f(yb[j][h].z & 0xffffu); ab[2 * h + 1].y += wb[j] * bf2f(yb[j][h].z >> 16); ab[2 * h + 1].z += wb[j] * bf2f(yb[j][h].w & 0xffffu); ab[2 * h + 1].w += wb[j] * bf2f(yb[j][h].w >> 16); }
        } while (ma | mb);
        f32x4 va[4], vb[4];
#pragma unroll
        for (int h = 0; h < 2; ++h) {
            va[2 * h] = (f32x4){bf2f(ra_[h].x & 0xffffu), bf2f(ra_[h].x >> 16), bf2f(ra_[h].y & 0xffffu), bf2f(ra_[h].y >> 16)}; va[2 * h + 1] = (f32x4){bf2f(ra_[h].z & 0xffffu), bf2f(ra_[h].z >> 16), bf2f(ra_[h].w & 0xffffu), bf2f(ra_[h].w >> 16)};
            vb[2 * h] = (f32x4){bf2f(rb_[h].x & 0xffffu), bf2f(rb_[h].x >> 16), bf2f(rb_[h].y & 0xffffu), bf2f(rb_[h].y >> 16)}; vb[2 * h + 1] = (f32x4){bf2f(rb_[h].z & 0xffffu), bf2f(rb_[h].z >> 16), bf2f(rb_[h].w & 0xffffu), bf2f(rb_[h].w >> 16)}; }
        s11_finish_row(F, l, ra, xa, va, aa, last);
        s11_finish_row(F, l, ra + 1, xb, vb, ab, last);
        if (more) { ent = nent;
#pragma unroll
            for (int h = 0; h < 2; ++h) { ra_[h] = na_[h]; rb_[h] = nb_[h]; } }
    }
}

constexpr int N_PHASES = 26;
#define PH_IN(k) (lo <= (k) && (k) < hi)
#define PH_SEAM(k) do { if ((k) + 1 < hi) xcd_barrier(bar); } while (0)
#ifndef DUP_PHASE
#define DUP_PHASE (-1)
#endif
#ifndef DUP_N
#define DUP_N 1
#endif
#define PH_BEGIN(k) if (PH_IN(k)) { for (int rep_ = 0; rep_ < ((k) == DUP_PHASE ? DUP_N : 1); ++rep_) { if (rep_) xcd_barrier(bar); relaunder(F);
#define PH_END(k) } PH_SEAM(k); }
template <int l> __device__ __forceinline__ void layer_steps(Frame& F, const Args& args, const XcdBarrier& bar, const int lo, const int hi) {
    constexpr int P0 = l == 0 ? 3 : 15;
    constexpr bool last = l == 1, do_ctx = !last;
    PH_BEGIN(P0 + 0)
        pg8::Gemm g{(pg8::bf16_t*)HXP(), WSP(pg8::bf16_t, WS_WIN) + (size_t)l * INC * 1024, NROW, INC, D, nullptr};
        pg8::StaticOrder S; S.init(NROW, INC, F.G, F.wg);
        pg8::EpiInProj E{WSP(pg8::bf16_t, WS_REGA), PXC};
        pg8::gemm_phase<pg8::EpiInProj, pg8::StaticOrder, true, true>(F.lds, g, S, E);
        PH_END(P0 + 0)
    PH_BEGIN(P0 + 1)
        for (int u = F.wg; u < NB * 64; u += F.G) dft1_unit(F, u >> 6, u & 63);
        lru_a_phase(F, l);
        if (F.wg >= 32) filler(F, 1, -1);
        PH_END(P0 + 1)
    PH_BEGIN(P0 + 2)
        if (F.wg >= 192) s3_carries(F, (F.wg - 192) * NWAVES + F.wave);
        { LAS bf16* t2l = (LAS bf16*)(F.lds + 67584);
          const bf16* T2 = WSP(bf16, WS_T2M);
          for (int i = F.tid; i < 64 * 16; i += NTHR) { const int r = i >> 4, c = i & 15; *(LAS v4u*)(t2l + r * 136 + c * 8) = *(const v4u*)(T2 + r * 128 + c * 8); }
          LDS_WAIT(); __syncthreads();
          const int nu = NB * 128 + (do_ctx ? 16 : 0);
          for (int u = F.wg; u < nu; u += F.G) {
              if (u < NB * 128) { const int b = u >> 7, kp = u & 127;
                  dft2_unit(F, l, WSP(bf16, WS_T2M), 128, 0, 1, WSP(bf16, WS_T1) + (size_t)(b * 128 + kp) * 64 * 512, 512, 0, 0.001381067932004976f, b * SEQ + kp, 128, t2l);
              } else { const int b = (u - NB * 128) >> 2, mq = (u - NB * 128) & 3;
                  dft2_unit(F, l, WSP(bf16, WS_TCM), 512, 64 * mq, 4, WSP(bf16, WS_REGA) + (size_t)(NLAT + CTXL * b) * PXC + PX_Z, PXC, (size_t)64 * PXC, 0.0078125f, NLAT + CTXL * b + 64 * mq, 1, nullptr); } } }
        PH_END(P0 + 2)
    PH_BEGIN(P0 + 3)
        const int nc = do_ctx ? NCHUNK : 512;
        if (do_ctx) sc_phase(F, l, nc, 16, F.G - 16); else sc_phase(F, l, nc, 0, F.G);
        lru_b_phase(F, l, nc);
        if (do_ctx && F.wg >= 16) filler(F, 2, -1);
        PH_END(P0 + 3)
    PH_BEGIN(P0 + 4)
        pg8::Gemm g{WSP(pg8::bf16_t, WS_Y), WSP(pg8::bf16_t, WS_WOUT) + (size_t)l * 1024 * 1024, NLAT, D, D, nullptr};
        pg8::StaticOrder S; S.init(NLAT, D, F.G, F.wg);
        pg8::EpiResid E{INP(I_X), INP(I_CTX), (pg8::bf16_t*)XBP(), WSP(float, WS_MODS) + (size_t)l * 5 * 6144 + 2 * 1024, NLAT, l == 0};
        pg8::gemm_phase<pg8::EpiResid, pg8::StaticOrder, true, true>(F.lds, g, S, E);
        PH_END(P0 + 4)
    PH_BEGIN(P0 + 5)
        if (do_ctx) {
            int* IDX = WSP(int, WS_IDX); for (int i = F.wg * NTHR + F.tid; i < NE * 256; i += F.G * NTHR) IDX[SLAB_L + i] = NLAT;
            if (F.wg < 16) {
                pg8::Gemm g{WSP(pg8::bf16_t, WS_Y), WSP(pg8::bf16_t, WS_WOUT) + (size_t)l * 1024 * 1024, NROW, D, D, nullptr};
                pg8::CtxOrder S{F.wg};
                pg8::EpiResid E{INP(I_X), INP(I_CTX), (pg8::bf16_t*)XBP(), WSP(float, WS_MODS) + (size_t)l * 5 * 6144 + 2 * 1024, NLAT, l == 0};
                pg8::gemm_phase<pg8::EpiResid, pg8::CtxOrder, true, true>(F.lds, g, S, E);
                VM_WAIT(); __syncthreads();
                if (F.tid == 0) { unsigned* ctr = WSP(unsigned, WS_CTL) + 192 + 64 * l;
                    __builtin_amdgcn_fence(__ATOMIC_RELEASE, "agent"); VM_WAIT();
                    __hip_atomic_fetch_add(ctr, 1u, __ATOMIC_RELAXED, __HIP_MEMORY_SCOPE_AGENT);
                    unsigned sp = 0; while (__hip_atomic_load(ctr, __ATOMIC_RELAXED, __HIP_MEMORY_SCOPE_AGENT) < 16u && ++sp < (1u << 22)) __builtin_amdgcn_s_sleep(2);
                    __builtin_amdgcn_fence(__ATOMIC_ACQUIRE, "agent"); VM_WAIT(); }
                __syncthreads();
                relaunder(F);
                s6_norm2_router(F, l, NLAT / 2, NROW / 2, F.wg * NWAVES + F.wave, 16 * NWAVES);
            } else s6_norm2_router(F, l, 0, NLAT / 2, (F.wg - 16) * NWAVES + F.wave, (F.G - 16) * NWAVES);
        } else s6_norm2_router(F, l, 0, NLAT / 2, F.wg * NWAVES + F.wave, F.G * NWAVES);
        PH_END(P0 + 5)
    PH_BEGIN(P0 + 6)
        const int np = do_ctx ? 128 : 64;
        if (F.wg >= np) filler(F, 4, -1);
        for (int p = F.wg; p < np; p += F.G) {
            if (p < 64) { const int b = p >> 4, e = p & 15; s7_topk_problem(F, WSP(float, WS_AFFL) + (size_t)p * SEQ, SEQ, CAP_L, (b * 16 + e) * CAP_L, b * SEQ, e); }
            else { const int q = p - 64, b = q >> 4, e = q & 15; s7_topk_problem(F, WSP(float, WS_AFFC) + (size_t)q * CTXL, CTXL, CAP_C, SLAB_L + e * 256 + b * CAP_C, NLAT + b * CTXL, e); } }
        PH_END(P0 + 6)
    PH_BEGIN(P0 + 7) filler(F, 0, l); PH_END(P0 + 7)
    PH_BEGIN(P0 + 8)
        pg8::Gemm g{(pg8::bf16_t*)HXP(), WSP(pg8::bf16_t, WS_WGU + (size_t)l * WS_WEXP_L), SLAB_ROWS, NE * 2048, D, WSP(int, WS_IDX)};
        pg8::MoeOrder1 S{F.wg, do_ctx};
        pg8::EpiSwiGLU E{WSP(pg8::bf16_t, WS_REGA), D};
        pg8::gemm_phase<pg8::EpiSwiGLU, pg8::MoeOrder1, true, true, true>(F.lds, g, S, E);
        if (do_ctx && F.wg >= 128) filler(F, 5, -1);
        PH_END(P0 + 8)
    PH_BEGIN(P0 + 9)
        pg8::Gemm g{WSP(pg8::bf16_t, WS_REGA), WSP(pg8::bf16_t, WS_WD + (size_t)l * WS_WEXP_L), SLAB_ROWS, NE * 1024, D, nullptr};
        pg8::MoeOrder2 S{F.wg, do_ctx};
        pg8::EpiScaleBf16 E{WSP(pg8::bf16_t, WS_REGB), D, WSP(float, WS_GVAL)};
        pg8::gemm_phase<pg8::EpiScaleBf16, pg8::MoeOrder2, true, true>(F.lds, g, S, E);
        if (do_ctx && F.wg >= 64) filler(F, 4, -1);
        PH_END(P0 + 9)
    PH_BEGIN(P0 + 10) s11_combine(F, l, do_ctx, last); PH_END(P0 + 10)
}
__global__ void __launch_bounds__(NTHR, 2) fwd(Args args) {
    extern __shared__ __attribute__((aligned(16))) unsigned char lds_raw[];
    Frame F;
    F.lds = (LAS unsigned char*)lds_raw;
    F.tid = threadIdx.x; F.lane = F.tid & 63; F.wave = __builtin_amdgcn_readfirstlane(F.tid >> 6);
    F.G = gridDim.x; F.wg = blockIdx.x;
    volatile LAS unsigned* MISC = (volatile LAS unsigned*)(F.lds + MISC_OFF);
    if (F.tid < 64) MISC[F.tid] = 0u;
    if (F.tid == 0) { LAS unsigned long long* PT = (LAS unsigned long long*)(F.lds + PT_OFF);
#pragma unroll
        for (int i = 0; i < N_IN; ++i) PT[i] = (unsigned long long)args.in[i];
        PT[N_IN] = (unsigned long long)args.out; PT[N_IN + 1] = (unsigned long long)args.ws; }
    LDS_WAIT(); __syncthreads();
    const int lo = args.ph_lo, hi = args.ph_hi;
    unsigned* barw = (unsigned*)(args.ws + WS_CTL) + CW_BAR + args.bar_region * XCD_BAR_WORDS;
    XcdBarrier bar; bar.bar = barw; bar.x = 0; bar.st = MISC + 8;
    if (hi - lo > 1) bar = xcd_barrier_post(barw, MISC + 8);
    PH_BEGIN(0) p0_prep(F); PH_END(0)
    PH_BEGIN(1) p0b_mods(F); PH_END(1)
    PH_BEGIN(2) s0_norm1(F); PH_END(2)
    layer_steps<0>(F, args, bar, lo, hi);
    layer_steps<1>(F, args, bar, lo, hi);
}

extern "C" void kernel_launch(void* const* d_in, const int* in_sizes, int n_in, void* d_out, int out_size, void* d_ws, size_t ws_size, hipStream_t stream) {
    static int grid = 0;
    if (grid == 0) {
        if (n_in != N_IN || out_size != NLAT * D || ws_size < WS_END) { fprintf(stderr, "kernel_launch: unexpected shapes (n_in %d, out %d, ws %zu, need %zu)\n", n_in, out_size, ws_size, (size_t)WS_END); grid = -1; return; }
        int dev = 0, cus = 0, per_cu = 0;
        if (hipGetDevice(&dev) != hipSuccess || hipDeviceGetAttribute(&cus, hipDeviceAttributeMultiprocessorCount, dev) != hipSuccess) { grid = -1; return; }
        if (hipFuncSetAttribute((const void*)fwd, hipFuncAttributeMaxDynamicSharedMemorySize, LDS_BYTES) != hipSuccess) { fprintf(stderr, "kernel_launch: hipFuncSetAttribute failed\n"); grid = -1; return; }
        if (hipOccupancyMaxActiveBlocksPerMultiprocessor(&per_cu, (const void*)fwd, NTHR, LDS_BYTES) != hipSuccess || per_cu < 1) { fprintf(stderr, "kernel_launch: occupancy query says %d\n", per_cu); }
        (void)hipGetLastError();
        grid = cus;
        if (grid != 256) { fprintf(stderr, "kernel_launch: needs a 256-CU device (got %d)\n", grid); grid = -1; return; }
    }
    if (grid < 0) return;
    (void)hipMemsetAsync((char*)d_ws + WS_CTL, 0, CTL_ZERO_BYTES, stream);
    Args a{};
    for (int i = 0; i < N_IN; ++i) a.in[i] = (const float*)d_in[i];
    a.out = (float*)d_out; a.ws = (unsigned char*)d_ws;
#ifndef ONE_LAUNCH
#define ONE_LAUNCH 1
#endif
#ifndef PROBE_K
#define PROBE_K (-1)
#endif
#ifndef PROBE_N
#define PROBE_N 1
#endif
    if (PROBE_K >= 0) {
        a.ph_lo = 0; a.ph_hi = PROBE_K + 1; a.bar_region = 0; hipLaunchKernelGGL(fwd, dim3(grid), dim3(NTHR), LDS_BYTES, stream, a);
        for (int r = 1; r < PROBE_N; ++r) { a.ph_lo = PROBE_K; a.ph_hi = PROBE_K + 1; hipLaunchKernelGGL(fwd, dim3(grid), dim3(NTHR), LDS_BYTES, stream, a); }
        if (PROBE_K + 1 < N_PHASES) { a.ph_lo = PROBE_K + 1; a.ph_hi = N_PHASES; a.bar_region = 1; hipLaunchKernelGGL(fwd, dim3(grid), dim3(NTHR), LDS_BYTES, stream, a); }
    } else if (ONE_LAUNCH) { a.ph_lo = 0; a.ph_hi = N_PHASES; hipLaunchKernelGGL(fwd, dim3(grid), dim3(NTHR), LDS_BYTES, stream, a); }
    else for (int ph = 0; ph < N_PHASES; ++ph) { a.ph_lo = ph; a.ph_hi = ph + 1; hipLaunchKernelGGL(fwd, dim3(grid), dim3(NTHR), LDS_BYTES, stream, a); }
}
```

```cpp
#include <hip/hip_runtime.h>
#include <cstdio>
#include <cstdint>
#define LAS __attribute__((address_space(3)))
namespace pg8 {
#define PG8_LAS __attribute__((address_space(3)))
typedef unsigned short bf16_t;
typedef short bf16x8 __attribute__((ext_vector_type(8)));
typedef float f32x4 __attribute__((ext_vector_type(4)));
typedef unsigned u32x4 __attribute__((ext_vector_type(4)));
constexpr int BM = 256, BK = 64, HALF = 128, HTB = HALF * BK * 2  , STAGE_BYTES = 8 * HTB, NXCD = 8, WGM = 8;

__host__ __device__ __forceinline__ int lds_byte(int r, int c) { const int st = (r >> 4) * 2 + (c >> 5), rr = r & 15, cc = c & 31, ob = rr * 64 + cc * 2; return st * 1024 + (ob ^ (((ob >> 9) & 1) << 5)); }
__host__ __device__ __forceinline__ void stage_rc(int b, int& R, int& C) { const int st = b / 1024, sb = b % 1024, swz = sb ^ (((sb >> 9) & 1) << 5); R = (st >> 1) * 16 + swz / 64; C = (st & 1) * 32 + (swz % 64) / 2; }
__host__ __device__ __forceinline__ int perm32(int rho) { const int n = rho >> 4, i = rho & 15; return 8 * (i >> 2) + 4 * n + (i & 3); }

struct Unit { int pm, pn; };
struct Gemm { const bf16_t* A; const bf16_t* Bt; int M, N, K; const int* gidx; };

struct StaticOrder {
    int nM, nN, nwg, G, c;
    __host__ __device__ void init(int M, int N, int G_, int c_) { nM = M / BM; nN = N / BM; nwg = nM * nN; G = G_; c = c_; }
    __host__ __device__ bool next(int i, Unit& u) const {
        const long L = (long)i * G + c; if (L >= nwg) return false;
        int wgid = (int)L; { const int q = nwg / NXCD, r = nwg % NXCD, xcd = wgid % NXCD, off = wgid / NXCD; wgid = (xcd < r ? xcd * (q + 1) : r * (q + 1) + (xcd - r) * q) + off; }
        const int nig = WGM * nN, gid = wgid / nig, fm = gid * WGM, gsz = (nM - fm) < WGM ? (nM - fm) : WGM;
        u.pm = fm + ((wgid % nig) % gsz); u.pn = (wgid % nig) / gsz; return true;
    }
    __device__ __forceinline__ void a_ready(const Unit&) const {}
    __device__ __forceinline__ void done(const Unit&) const {}
};


__device__ __forceinline__ unsigned cvt_pk_bf16(float lo, float hi) { unsigned r; asm volatile("v_cvt_pk_bf16_f32 %0, %1, %2" : "=v"(r) : "v"(lo), "v"(hi)); return r; }

struct EpiBf16Plain {
    static constexpr bool PERM = true, AFTER_DRAIN = false;
    bf16_t* O; int ldc;
    __device__ __forceinline__ void operator()(const f32x4 (&acc)[2][2][4][2], const Unit& u, int wr, int wc, int fr, int fq) const {
        const int row0 = u.pm * BM + wr * 64 + fr; const int col0 = u.pn * BM + wc * 32 + 8 * fq;
#pragma unroll
        for (int ai = 0; ai < 2; ++ai)
#pragma unroll
            for (int m = 0; m < 4; ++m) { bf16_t* rowp = O + (size_t)(row0 + ai * HALF + m * 16) * ldc + col0;
#pragma unroll
                for (int bj = 0; bj < 2; ++bj) { const f32x4 v0 = acc[ai][bj][m][0], v1 = acc[ai][bj][m][1];
                    u32x4 w; w.x = cvt_pk_bf16(v0[0], v0[1]); w.y = cvt_pk_bf16(v0[2], v0[3]); w.z = cvt_pk_bf16(v1[0], v1[1]); w.w = cvt_pk_bf16(v1[2], v1[3]);
                    *(u32x4*)(rowp + bj * HALF) = w; } }
    }
};
struct EpiInProj {
    static constexpr bool PERM = true, AFTER_DRAIN = false;
    bf16_t* O; int ldc;
    __device__ __forceinline__ void operator()(const f32x4 (&acc)[2][2][4][2], const Unit& u, int wr, int wc, int fr, int fq) const {
        const int row0 = u.pm * BM + wr * 64 + fr;
        if (u.pn == 5 || u.pn == 6) { const int col0 = 1280 + (u.pn - 5) * HALF + wc * 32 + 8 * fq;
#pragma unroll
            for (int ai = 0; ai < 2; ++ai)
#pragma unroll
                for (int m = 0; m < 4; ++m) { const f32x4 v0 = acc[ai][0][m][0] * acc[ai][1][m][0], v1 = acc[ai][0][m][1] * acc[ai][1][m][1];
                    u32x4 w; w.x = cvt_pk_bf16(v0[0], v0[1]); w.y = cvt_pk_bf16(v0[2], v0[3]); w.z = cvt_pk_bf16(v1[0], v1[1]); w.w = cvt_pk_bf16(v1[2], v1[3]);
                    *(u32x4*)(O + (size_t)(row0 + ai * HALF + m * 16) * ldc + col0) = w; }
        } else { const int col0 = (u.pn < 5 ? u.pn : u.pn - 1) * BM + wc * 32 + 8 * fq;
#pragma unroll
            for (int ai = 0; ai < 2; ++ai)
#pragma unroll
                for (int m = 0; m < 4; ++m) { bf16_t* rowp = O + (size_t)(row0 + ai * HALF + m * 16) * ldc + col0;
#pragma unroll
                    for (int bj = 0; bj < 2; ++bj) { const f32x4 v0 = acc[ai][bj][m][0], v1 = acc[ai][bj][m][1];
                        u32x4 w; w.x = cvt_pk_bf16(v0[0], v0[1]); w.y = cvt_pk_bf16(v0[2], v0[3]); w.z = cvt_pk_bf16(v1[0], v1[1]); w.w = cvt_pk_bf16(v1[2], v1[3]);
                        *(u32x4*)(rowp + bj * HALF) = w; } }
        }
    }
};
struct EpiSwiGLU {
    static constexpr bool PERM = true, AFTER_DRAIN = false;
    bf16_t* H; int ldc;
    __device__ __forceinline__ void operator()(const f32x4 (&acc)[2][2][4][2], const Unit& u, int wr, int wc, int fr, int fq) const {
        const int row0 = u.pm * BM + wr * 64 + fr; const int col0 = (u.pn & 7) * HALF + wc * 32 + 8 * fq;
#pragma unroll
        for (int ai = 0; ai < 2; ++ai)
#pragma unroll
            for (int m = 0; m < 4; ++m) { bf16_t* rowp = H + (size_t)(row0 + ai * HALF + m * 16) * ldc + col0;
                float o[8];
#pragma unroll
                for (int n = 0; n < 2; ++n)
#pragma unroll
                    for (int i = 0; i < 4; ++i) { const float g = acc[ai][0][m][n][i], up = acc[ai][1][m][n][i];
                        o[n * 4 + i] = g * __builtin_amdgcn_rcpf(1.0f + __expf(-g)) * up; }
                u32x4 w; w.x = cvt_pk_bf16(o[0], o[1]); w.y = cvt_pk_bf16(o[2], o[3]); w.z = cvt_pk_bf16(o[4], o[5]); w.w = cvt_pk_bf16(o[6], o[7]);
                *(u32x4*)rowp = w; }
    }
};
struct EpiScaleBf16 {
    static constexpr bool PERM = true, AFTER_DRAIN = false;
    bf16_t* Y; int ldc; const float* gval;
    __device__ __forceinline__ void operator()(const f32x4 (&acc)[2][2][4][2], const Unit& u, int wr, int wc, int fr, int fq) const {
        const int row0 = u.pm * BM + wr * 64 + fr; const int col0 = (u.pn & 3) * BM + wc * 32 + 8 * fq;
#pragma unroll
        for (int ai = 0; ai < 2; ++ai)
#pragma unroll
            for (int m = 0; m < 4; ++m) { const int row = row0 + ai * HALF + m * 16; const float g = gval[row]; bf16_t* rowp = Y + (size_t)row * ldc + col0;
#pragma unroll
                for (int bj = 0; bj < 2; ++bj) { const f32x4 v0 = acc[ai][bj][m][0] * g, v1 = acc[ai][bj][m][1] * g;
                    u32x4 w; w.x = cvt_pk_bf16(v0[0], v0[1]); w.y = cvt_pk_bf16(v0[2], v0[3]); w.z = cvt_pk_bf16(v1[0], v1[1]); w.w = cvt_pk_bf16(v1[2], v1[3]);
                    *(u32x4*)(rowp + bj * HALF) = w; } }
    }
};
struct EpiResid {
    static constexpr bool PERM = true, AFTER_DRAIN = false;
    const float* xin_lat; const float* xin_ctx; bf16_t* xb; const float* gate  ; int nlat; bool in_f32;
    __device__ __forceinline__ void operator()(const f32x4 (&acc)[2][2][4][2], const Unit& u, int wr, int wc, int fr, int fq) const {
        const int trow = u.pm * BM; const bool isctx = trow >= nlat;
        const int s = isctx ? 4 : (trow >> 13);
        const float* xin = isctx ? xin_ctx - (size_t)nlat * 1024 : xin_lat;
        const float* gp = gate + (size_t)s * 6144;
        const int row0 = trow + wr * 64 + fr, col0 = u.pn * BM + wc * 32 + 8 * fq;
        f32x4 gv[2][2];
#pragma unroll
        for (int bj = 0; bj < 2; ++bj)
#pragma unroll
            for (int n = 0; n < 2; ++n) gv[bj][n] = *(const f32x4*)(gp + col0 + bj * HALF + 4 * n);
#pragma unroll
        for (int ai = 0; ai < 2; ++ai)
#pragma unroll
            for (int m = 0; m < 4; ++m) { const size_t off = (size_t)(row0 + ai * HALF + m * 16) * 1024 + col0;
#pragma unroll
                for (int bj = 0; bj < 2; ++bj) { f32x4 x0, x1;
                    if (in_f32) { x0 = *(const f32x4*)(xin + off + bj * HALF); x1 = *(const f32x4*)(xin + off + bj * HALF + 4); }
                    else { const u32x4 w = *(const u32x4*)(xb + off + bj * HALF);
                        x0 = (f32x4){__builtin_bit_cast(float, w.x << 16), __builtin_bit_cast(float, w.x & 0xffff0000u), __builtin_bit_cast(float, w.y << 16), __builtin_bit_cast(float, w.y & 0xffff0000u)};
                        x1 = (f32x4){__builtin_bit_cast(float, w.z << 16), __builtin_bit_cast(float, w.z & 0xffff0000u), __builtin_bit_cast(float, w.w << 16), __builtin_bit_cast(float, w.w & 0xffff0000u)}; }
                    x0 += gv[bj][0] * acc[ai][bj][m][0]; x1 += gv[bj][1] * acc[ai][bj][m][1];
                    u32x4 o; o.x = cvt_pk_bf16(x0[0], x0[1]); o.y = cvt_pk_bf16(x0[2], x0[3]); o.z = cvt_pk_bf16(x1[0], x1[1]); o.w = cvt_pk_bf16(x1[2], x1[3]);
                    *(u32x4*)(xb + off + bj * HALF) = o; } }
    }
};
struct MoeOrder1 {
    int c; bool ctx;
    __device__ __forceinline__ bool next(int i, Unit& u) const {
        if (i < 8) { const int P = i * 8 + (c & 7), j = c >> 3, e = P >> 2, b = P & 3; u.pm = (b * 16 + e) * 4 + (j >> 3); u.pn = e * 8 + (j & 7); return true; }
        if (i == 8 && ctx && c < 128) { const int e = c >> 3; u.pm = 256 + e; u.pn = e * 8 + (c & 7); return true; }
        return false;
    }
    __device__ __forceinline__ void a_ready(const Unit&) const {}
    __device__ __forceinline__ void done(const Unit&) const {}
};
struct CtxOrder {
    int c;
    __device__ __forceinline__ bool next(int i, Unit& u) const { if (i != 0 || c >= 16) return false; u.pm = 128 + (c >> 2); u.pn = c & 3; return true; }
    __device__ __forceinline__ void a_ready(const Unit&) const {}
    __device__ __forceinline__ void done(const Unit&) const {}
};
struct MoeOrder2 {
    int c; bool ctx;
    __device__ __forceinline__ bool next(int i, Unit& u) const {
        if (i < 4) { const int j = c >> 3, P = i * 16 + (c & 7) * 2 + (j >> 4), e = P >> 2, b = P & 3; u.pm = (b * 16 + e) * 4 + ((j >> 2) & 3); u.pn = e * 4 + (j & 3); return true; }
        if (i == 4 && ctx && c < 64) { const int e = c >> 2; u.pm = 256 + e; u.pn = e * 4 + (c & 3); return true; }
        return false;
    }
    __device__ __forceinline__ void a_ready(const Unit&) const {}
    __device__ __forceinline__ void done(const Unit&) const {}
};

template <class Epi, class Sched, bool ALIGN_EPI = false, bool SP2 = false, bool GATHER = false, int HALF_FROM_PM = (1 << 30)>
__device__ __forceinline__ void gemm_phase(PG8_LAS unsigned char* lds, const Gemm g, const Sched& S, const Epi& E) {
    const int tid = threadIdx.x, wid = __builtin_amdgcn_readfirstlane(tid >> 6), lane = tid & 63, wr = wid >> 2, wc = wid & 3, fr = lane & 15, fq = lane >> 4;
    const int K = g.K, nt = K / BK;
    unsigned voffA[2], voffB[2]; int rowA[2]; unsigned colA2[2];
#pragma unroll
    for (int i = 0; i < 2; ++i) { int R, C; stage_rc(tid * 16 + i * 8192, R, C); const int Rb = Epi::PERM ? ((R & ~31) + perm32(R & 31)) : R;
        voffA[i] = (unsigned)(R * K + C) * 2u; voffB[i] = (unsigned)(Rb * K + C) * 2u; rowA[i] = R; colA2[i] = (unsigned)C * 2u; }
    unsigned gA[2][2], gN[2][2], gS[2][2], gRaw[2][2];
#define PG8_VA(h) (GATHER ? gA[h] : voffA)
#define PG8_VS(h) (GATHER ? gS[h] : voffA)
#define PG8_IDX_ISSUE(u) do { _Pragma("unroll") for (int _h = 0; _h < 2; ++_h) _Pragma("unroll") for (int _i = 0; _i < 2; ++_i) { const int* _p = g.gidx + (u).pm * BM + _h * HALF + rowA[_i]; \
        asm volatile("global_load_dword %0, %1, off" : "=v"(gRaw[_h][_i]) : "v"(_p) : "memory"); } } while (0)
#define PG8_IDX_TAKE(dst) do { _Pragma("unroll") for (int _h = 0; _h < 2; ++_h) _Pragma("unroll") for (int _i = 0; _i < 2; ++_i) { asm volatile("" : "+v"(gRaw[_h][_i])); dst[_h][_i] = gRaw[_h][_i] * (unsigned)(K * 2) + colA2[_i]; } } while (0)
    const size_t kstep = (size_t)(BK * 2);
    const size_t hstep = (size_t)HALF * K * 2;
    const size_t hstepA = GATHER ? 0 : hstep;
    const size_t tstep = 2 * hstep;
    const unsigned ldsw = (unsigned)wid * 1024u;
    const int aoff = lds_byte(wr * 64 + fr, fq * 8), boff = lds_byte(wc * 32 + fr, fq * 8);
#define PG8_SA(b, h) (((b) * 2 + (h)) * HTB)
#define PG8_SB(b, h) ((4 + (b) * 2 + (h)) * HTB)
#define PG8_STAGE(bufoff, gbase, voff) do { _Pragma("unroll") for (int _i = 0; _i < 2; ++_i) \
        __builtin_amdgcn_global_load_lds((const unsigned*)((const char*)(gbase) + (voff)[_i]), (PG8_LAS unsigned*)(lds + (bufoff) + ldsw + _i * 8192), 16, 0, 0); } while (0)
#define PG8_LDA(dst, b, h) do { _Pragma("unroll") for (int m = 0; m < 4; ++m) _Pragma("unroll") for (int k = 0; k < 2; ++k) dst[m][k] = *(const PG8_LAS bf16x8*)(lds + PG8_SA(b, h) + aoff + m * 2048 + k * 1024); } while (0)
#define PG8_LDB(dst, b, h) do { _Pragma("unroll") for (int n = 0; n < 2; ++n) _Pragma("unroll") for (int k = 0; k < 2; ++k) dst[n][k] = *(const PG8_LAS bf16x8*)(lds + PG8_SB(b, h) + boff + n * 2048 + k * 1024); } while (0)
#define PG8_MMA(ai, bj, At, Bt) do { __builtin_amdgcn_s_setprio(1); _Pragma("unroll") for (int m = 0; m < 4; ++m) _Pragma("unroll") for (int n = 0; n < 2; ++n) _Pragma("unroll") for (int k = 0; k < 2; ++k) \
        acc[ai][bj][m][n] = __builtin_amdgcn_mfma_f32_16x16x32_bf16(Bt[n][k], At[m][k], acc[ai][bj][m][n], 0, 0, 0); __builtin_amdgcn_s_setprio(0); } while (0)
#define PG8_WAIT_V(n) asm volatile("s_waitcnt vmcnt(" #n ")" ::: "memory")
#define PG8_WAIT_L(n) asm volatile("s_waitcnt lgkmcnt(" #n ")" ::: "memory")
#define PG8_BAR __builtin_amdgcn_s_barrier()
#define PG8_SCHED __builtin_amdgcn_sched_barrier(0)
    Unit cur, nxt; int ui = 0;
    if (!S.next(0, cur)) return;
    f32x4 acc[2][2][4][2];
#pragma unroll
    for (int a = 0; a < 2; ++a)
#pragma unroll
        for (int b = 0; b < 2; ++b)
#pragma unroll
            for (int m = 0; m < 4; ++m)
#pragma unroll
                for (int n = 0; n < 2; ++n) acc[a][b][m][n] = (f32x4){0.f, 0.f, 0.f, 0.f};
    bf16x8 At[4][2], B0[2][2], B1[2][2];
    const char* cA = (const char*)g.A + (GATHER ? (size_t)0 : (size_t)cur.pm * tstep); const char* cB = (const char*)g.Bt + (size_t)cur.pn * tstep;
    S.a_ready(cur);
    if constexpr (GATHER) { PG8_IDX_ISSUE(cur); asm volatile("s_waitcnt vmcnt(0)" ::: "memory"); PG8_IDX_TAKE(gA); }
    if constexpr (SP2) {
        PG8_STAGE(PG8_SB(0, 0), cB, voffB); PG8_STAGE(PG8_SB(0, 1), cB + hstep, voffB); PG8_STAGE(PG8_SA(0, 0), cA, PG8_VA(0)); PG8_STAGE(PG8_SA(0, 1), cA + hstepA, PG8_VA(1));
        if (wr == 1) PG8_BAR;
        PG8_WAIT_V(2); PG8_BAR;
        PG8_STAGE(PG8_SB(1, 0), cB + kstep, voffB); PG8_STAGE(PG8_SA(1, 0), cA + kstep, PG8_VA(0)); PG8_STAGE(PG8_SB(1, 1), cB + hstep + kstep, voffB);
        PG8_WAIT_V(6); PG8_BAR;
    } else {
        PG8_STAGE(PG8_SB(0, 0), cB, voffB); PG8_STAGE(PG8_SA(0, 0), cA, PG8_VA(0)); PG8_STAGE(PG8_SB(0, 1), cB + hstep, voffB); PG8_STAGE(PG8_SA(0, 1), cA + hstepA, PG8_VA(1));
        if (wr == 1) PG8_BAR;
        PG8_WAIT_V(4); PG8_BAR;
        PG8_STAGE(PG8_SB(1, 0), cB + kstep, voffB); PG8_STAGE(PG8_SA(1, 0), cA + kstep, PG8_VA(0)); PG8_STAGE(PG8_SB(1, 1), cB + hstep + kstep, voffB);
        PG8_WAIT_V(6); PG8_BAR;
    }
    for (;;) {
        const bool has_next = S.next(ui + 1, nxt);
        const char* nA = (has_next && !GATHER) ? (const char*)g.A + (size_t)nxt.pm * tstep : cA; const char* nB = has_next ? (const char*)g.Bt + (size_t)nxt.pn * tstep : cB;
        if constexpr (GATHER) { if (has_next) PG8_IDX_ISSUE(nxt); }
        for (int t = 0; t < nt; t += 2) {
            const bool last = (t == nt - 2);
            const char* a1 = cA + (size_t)(t + 1) * kstep;
            const char* a2 = last ? nA : cA + (size_t)(t + 2) * kstep; const char* b2 = last ? nB : cB + (size_t)(t + 2) * kstep;
            const char* a3 = a2 + kstep; const char* b3 = b2 + kstep;
            if (last && has_next) S.a_ready(nxt);
            if constexpr (GATHER) { if (last) { if (has_next) PG8_IDX_TAKE(gN); else { _Pragma("unroll") for (int _h = 0; _h < 2; ++_h) _Pragma("unroll") for (int _i = 0; _i < 2; ++_i) gN[_h][_i] = gA[_h][_i]; } }
                _Pragma("unroll") for (int _h = 0; _h < 2; ++_h) _Pragma("unroll") for (int _i = 0; _i < 2; ++_i) gS[_h][_i] = last ? gN[_h][_i] : gA[_h][_i]; }
            if constexpr (SP2) {
            PG8_LDB(B0, 0, 0); PG8_LDB(B1, 0, 1); PG8_SCHED; PG8_LDA(At, 0, 0); PG8_STAGE(PG8_SA(1, 1), a1 + hstepA, PG8_VA(1));
            PG8_WAIT_V(8); PG8_WAIT_L(0); PG8_BAR; PG8_MMA(0, 0, At, B0); PG8_MMA(0, 1, At, B1); PG8_BAR; PG8_SCHED;
            PG8_LDA(At, 0, 1); PG8_STAGE(PG8_SB(0, 0), b2, voffB); PG8_STAGE(PG8_SB(0, 1), b2 + hstep, voffB); PG8_STAGE(PG8_SA(0, 0), a2, PG8_VS(0));
            PG8_WAIT_V(8); PG8_WAIT_L(0); PG8_BAR; if (HALF_FROM_PM == (1 << 30) || cur.pm < HALF_FROM_PM) { PG8_MMA(1, 0, At, B0); PG8_MMA(1, 1, At, B1); } PG8_BAR; PG8_SCHED;
            PG8_LDB(B0, 1, 0); PG8_LDB(B1, 1, 1); PG8_SCHED; PG8_LDA(At, 1, 0); PG8_STAGE(PG8_SA(0, 1), a2 + hstepA, PG8_VS(1));
            PG8_WAIT_V(8); PG8_WAIT_L(0); PG8_BAR; PG8_MMA(0, 0, At, B0); PG8_MMA(0, 1, At, B1); PG8_BAR; PG8_SCHED;
            PG8_LDA(At, 1, 1); PG8_STAGE(PG8_SB(1, 0), b3, voffB); PG8_STAGE(PG8_SB(1, 1), b3 + hstep, voffB); PG8_STAGE(PG8_SA(1, 0), a3, PG8_VS(0));
            PG8_WAIT_V(8); PG8_WAIT_L(0); PG8_BAR; if (HALF_FROM_PM == (1 << 30) || cur.pm < HALF_FROM_PM) { PG8_MMA(1, 0, At, B0); PG8_MMA(1, 1, At, B1); } PG8_BAR; PG8_SCHED;
            } else {
            PG8_LDB(B0, 0, 0); PG8_SCHED; PG8_LDA(At, 0, 0); PG8_STAGE(PG8_SA(1, 1), a1 + hstepA, PG8_VA(1));
            PG8_WAIT_L(8); PG8_BAR; PG8_WAIT_L(0); PG8_MMA(0, 0, At, B0); PG8_BAR; PG8_SCHED;
            PG8_LDB(B1, 0, 1); PG8_STAGE(PG8_SB(0, 0), b2, voffB);
            PG8_BAR; PG8_WAIT_L(0); PG8_MMA(0, 1, At, B1); PG8_BAR;
            PG8_LDA(At, 0, 1); PG8_STAGE(PG8_SA(0, 0), a2, PG8_VS(0));
            PG8_BAR; PG8_WAIT_L(0); PG8_MMA(1, 0, At, B0); PG8_BAR; PG8_SCHED;
            PG8_STAGE(PG8_SB(0, 1), b2 + hstep, voffB);
            PG8_WAIT_V(6); PG8_BAR; PG8_MMA(1, 1, At, B1); PG8_BAR;
            PG8_LDB(B0, 1, 0); PG8_SCHED; PG8_LDA(At, 1, 0); PG8_STAGE(PG8_SA(0, 1), a2 + hstepA, PG8_VS(1));
            PG8_WAIT_L(8); PG8_BAR; PG8_WAIT_L(0); PG8_MMA(0, 0, At, B0); PG8_BAR; PG8_SCHED;
            PG8_LDB(B1, 1, 1); PG8_STAGE(PG8_SB(1, 0), b3, voffB);
            PG8_BAR; PG8_WAIT_L(0); PG8_MMA(0, 1, At, B1); PG8_BAR;
            PG8_LDA(At, 1, 1); PG8_STAGE(PG8_SA(1, 0), a3, PG8_VS(0));
            PG8_BAR; PG8_WAIT_L(0); PG8_MMA(1, 0, At, B0); PG8_BAR; PG8_SCHED;
            PG8_STAGE(PG8_SB(1, 1), b3 + hstep, voffB);
            PG8_WAIT_V(6); PG8_BAR; PG8_MMA(1, 1, At, B1); PG8_BAR;
            }
        }
        if constexpr (ALIGN_EPI) { if (wr == 0) PG8_BAR; }
        if constexpr (!Epi::AFTER_DRAIN) { E(acc, cur, wr, wc, fr, fq); S.done(cur); }
        if (!has_next) break;
#pragma unroll
        for (int a = 0; a < 2; ++a)
#pragma unroll
            for (int b = 0; b < 2; ++b)
#pragma unroll
                for (int m = 0; m < 4; ++m)
#pragma unroll
                    for (int n = 0; n < 2; ++n) acc[a][b][m][n] = (f32x4){0.f, 0.f, 0.f, 0.f};
        cur = nxt; cA = nA; cB = nB; ++ui;
        if constexpr (GATHER) { _Pragma("unroll") for (int _h = 0; _h < 2; ++_h) _Pragma("unroll") for (int _i = 0; _i < 2; ++_i) gA[_h][_i] = gN[_h][_i]; }
        if constexpr (ALIGN_EPI) { if (wr == 1) PG8_BAR; }
    }
    PG8_WAIT_V(0);
    if constexpr (!ALIGN_EPI) { if (wr == 0) PG8_BAR; }
    PG8_BAR;
    if constexpr (Epi::AFTER_DRAIN) { E.fused(acc, cur, wr, wc, fr, fq, lds, wid, lane); S.done(cur); }
#undef PG8_SA
#undef PG8_VA
#undef PG8_VS
#undef PG8_IDX_ISSUE
#undef PG8_IDX_TAKE
#undef PG8_SB
#undef PG8_STAGE
#undef PG8_LDA
#undef PG8_LDB
#undef PG8_MMA
#undef PG8_WAIT_V
#undef PG8_WAIT_L
#undef PG8_BAR
#undef PG8_SCHED
}
}
#define XB_TMO      128
#define XB_XCNT(j)  (256  + 64 * (j))
#define XB_XSUB(j)  (1280 + 64 * (j))
#define XB_XGEN(j)  (2304 + 64 * (j))
#define XB_TOP      3328
#define XB_TOPGEN   3392
#define XCD_BAR_WORDS 3456
#define XB_SPIN_CAP (1u << 18)

__device__ __forceinline__ unsigned xb_ld(unsigned* p)              { return __hip_atomic_load(p, __ATOMIC_RELAXED, __HIP_MEMORY_SCOPE_AGENT); }
__device__ __forceinline__ unsigned xb_add(unsigned* p, unsigned v) { return __hip_atomic_fetch_add(p, v, __ATOMIC_RELAXED, __HIP_MEMORY_SCOPE_AGENT); }
__device__ __forceinline__ unsigned xb_xcc_id() { return (unsigned)__builtin_amdgcn_s_getreg((3 << 11) | 20) & 0xFu; }
#define XB_SPIN(cond, bar) do { unsigned _sp = 0; while (cond) { __builtin_amdgcn_s_sleep(1); \
    if ((++_sp & 255u) == 0u) { if (xb_ld(&(bar)[XB_TMO])) break; if (_sp > XB_SPIN_CAP) { atomicAdd(&(bar)[XB_TMO], 1u); break; } } } } while (0)

struct XcdBarrier {
    unsigned* bar; unsigned x;
    volatile LAS unsigned* st;
};

__device__ __forceinline__ XcdBarrier xcd_barrier_post(unsigned* bar, volatile LAS unsigned* st) {
    XcdBarrier b; b.bar = bar; b.x = xb_xcc_id(); b.st = st;
    if (threadIdx.x == 0) (void)xb_add(&bar[XB_XCNT(b.x)], 1u);
    return b;
}
__device__ __forceinline__ void xcd_barrier_complete(unsigned* bar, unsigned x, unsigned& nloc, unsigned& nx) {
    const unsigned G = gridDim.x * gridDim.y * gridDim.z;
    unsigned sum, cnt, mine, sp = 0u;
    for (;;) {
        sum = 0u; cnt = 0u; mine = 0u;
#pragma unroll
        for (unsigned j = 0; j < 16; ++j) { const unsigned c = xb_ld(&bar[XB_XCNT(j)]); sum += c; cnt += (c > 0u) ? 1u : 0u; mine = (j == x) ? c : mine; }
        if (sum == G) break;
        __builtin_amdgcn_s_sleep(1);
        if ((++sp & 255u) == 0u) { if (xb_ld(&bar[XB_TMO])) break; if (sp > XB_SPIN_CAP) { atomicAdd(&bar[XB_TMO], 1u); break; } }
    }
    nloc = mine > 0u ? mine : 1u; nx = cnt > 0u ? cnt : 1u;
}

__device__ __forceinline__ void xcd_barrier(const XcdBarrier& b) {
    asm volatile("s_waitcnt vmcnt(0)" ::: "memory");
    __syncthreads();
    if (threadIdx.x == 0) {
        unsigned* bar = b.bar;
        __builtin_amdgcn_s_waitcnt(0);
        unsigned nloc = b.st[0], nx = b.st[1];
        if (nloc == 0u) { xcd_barrier_complete(bar, b.x, nloc, nx); b.st[0] = nloc; b.st[1] = nx; }
        const unsigned old = xb_add(&bar[XB_XSUB(b.x)], 1u);
        const unsigned gen = old / nloc;
        if (old + 1u == (gen + 1u) * nloc) {
            __builtin_amdgcn_fence(__ATOMIC_RELEASE, "agent");
            asm volatile("s_waitcnt vmcnt(0)" ::: "memory");
            const unsigned og = xb_add(&bar[XB_TOP], 1u);
            const unsigned tg = og / nx;
            if (og + 1u == (tg + 1u) * nx) xb_add(&bar[XB_TOPGEN], 1u);
            else XB_SPIN(xb_ld(&bar[XB_TOPGEN]) == tg, bar);
            __builtin_amdgcn_fence(__ATOMIC_ACQUIRE, "agent");
            xb_add(&bar[XB_XGEN(b.x)], 1u);
            asm volatile("s_waitcnt vmcnt(0)" ::: "memory");
        } else {
            XB_SPIN(xb_ld(&bar[XB_XGEN(b.x)]) == gen, bar);
            __builtin_amdgcn_fence(__ATOMIC_ACQUIRE, "agent");
            asm volatile("s_waitcnt vmcnt(0)" ::: "memory");
        }
    }
    __syncthreads();
}

typedef unsigned short bf16;
typedef unsigned v4u __attribute__((ext_vector_type(4)));
typedef unsigned v2u __attribute__((ext_vector_type(2)));
typedef float f32x4 __attribute__((ext_vector_type(4)));
typedef float f32x16 __attribute__((ext_vector_type(16)));
typedef short bf16x8 __attribute__((ext_vector_type(8)));
typedef unsigned short u16x8 __attribute__((ext_vector_type(8)));
#define LDS_WAIT() asm volatile("s_waitcnt lgkmcnt(0)" ::: "memory")
#define VM_WAIT() asm volatile("s_waitcnt vmcnt(0)" ::: "memory")

constexpr int NWAVES = 8, NTHR = 512;
constexpr int D = 1024, NB = 4, SEQ = 8192, CTXL = 256, NLAT = NB * SEQ, NCTX = NB * CTXL, NROW = NLAT + NCTX;
constexpr int INC = 2304;
constexpr int PXC = 2048;
constexpr int PX_Z = 1536;
constexpr int NE = 16, CAP_L = 1024, CAP_C = 32;
constexpr int SLAB_L = NB * NE * CAP_L;
constexpr int SLAB_ROWS = SLAB_L + NE * 256;
constexpr int NCHUNK = NROW / 64;
constexpr float EPS = 1e-6f;

enum { I_X = 0, I_C, I_CTX, I_CCTX, I_WADA, I_BADA, I_GN1, I_WIN, I_LCW, I_LCB, I_LWR, I_LBR, I_LWI, I_LBI, I_LAM, I_SCW, I_GOUT, I_WOUT, I_GN2, I_WRT, I_WG, I_WU, I_WD, I_GF, N_IN };

constexpr size_t MiB = 1u << 20;
constexpr size_t WS_CTL = 0, CTL_ZERO_BYTES = 64 * 1024;
constexpr size_t WS_MODP_OLD = 1 * MiB;
constexpr size_t WS_MODS = WS_MODP_OLD + 2 * MiB;
constexpr size_t WS_SP8 = WS_MODS + 256 * 1024;
constexpr size_t WS_TW = WS_SP8 + 8 * 1024;
constexpr size_t WS_C128 = WS_TW + 64 * 1024;
constexpr size_t WS_S128 = WS_C128 + 32 * 1024;
constexpr size_t WS_T2M = WS_S128 + 32 * 1024;
constexpr size_t WS_TCM = WS_T2M + 16 * 1024;
constexpr size_t WS_WGL = WS_TCM + 256 * 1024;
constexpr size_t WS_WIN = 5 * MiB;
constexpr size_t WS_WOUT = WS_WIN + 9 * MiB;
constexpr size_t WS_WGU = WS_WOUT + 4 * MiB;
constexpr size_t WS_WD = WS_WGU + 64 * MiB;
constexpr size_t WS_WEXP_L = 96 * MiB;
constexpr size_t WS_XB = WS_WGU + 2 * WS_WEXP_L;
constexpr size_t WS_HX = WS_XB;
constexpr size_t WS_REGA = WS_HX + 66 * MiB;
constexpr size_t WS_REGB = WS_REGA + 149 * MiB;
constexpr size_t WS_T1 = WS_REGB, WS_Y = WS_REGB + 32 * MiB;
constexpr size_t WS_MODP = WS_REGB;
constexpr size_t WS_CTXX = WS_REGB + 136 * MiB;
constexpr size_t WS_AFFL = WS_CTXX + 4 * MiB;
constexpr size_t WS_AFFC = WS_AFFL + 2 * MiB;
constexpr size_t WS_ENT = WS_AFFC + 1 * MiB;
constexpr size_t WS_IDX = WS_ENT + 3 * MiB;
constexpr size_t WS_GVAL = WS_IDX + 1 * MiB;
constexpr size_t WS_SUMM = WS_GVAL + 1 * MiB;
constexpr size_t WS_CARRY = WS_SUMM + 5 * MiB;
constexpr size_t WS_END = WS_CARRY + 3 * MiB;
static_assert(WS_WGL + 2 * 8 * 256 * 64 * 2 <= WS_WIN, "ws map");
static_assert((size_t)NROW * INC * 2 <= 149 * MiB && (size_t)SLAB_ROWS * 1024 * 2 <= 136 * MiB && 32 * MiB + (size_t)NROW * 1024 * 2 <= 136 * MiB, "ws map");

constexpr int CW_BAR = 1024;

constexpr int LDS_BYTES = 147456;
constexpr int RING_BYTES = 135168;
constexpr int MISC_OFF = RING_BYTES;

__device__ __forceinline__ unsigned f2bf(float f) { unsigned u = __builtin_bit_cast(unsigned, f); return (u + 0x7fffu + ((u >> 16) & 1u)) >> 16; }
__device__ __forceinline__ unsigned pk2(float lo, float hi) { unsigned r; asm volatile("v_cvt_pk_bf16_f32 %0, %1, %2" : "=v"(r) : "v"(lo), "v"(hi)); return r; }
__device__ __forceinline__ float bf2f(unsigned h) { return __builtin_bit_cast(float, h << 16); }
__device__ __forceinline__ float sigmoidf_(float x) { return __builtin_amdgcn_rcpf(1.0f + __builtin_amdgcn_exp2f(-1.4426950408889634f * x)); }
__device__ __forceinline__ float rsq_(float x) { return __builtin_amdgcn_rsqf(x); }
__device__ __forceinline__ float wave_sum(float v) {
#pragma unroll
    for (int o = 1; o < 64; o <<= 1) v += __shfl_xor(v, o);
    return v;
}

struct Args { const float* in[N_IN]; float* out; unsigned char* ws; int ph_lo, ph_hi, bar_region, pad_; };
template <int CTRL> __device__ __forceinline__ float dpp_(float v) { return __builtin_bit_cast(float, __builtin_amdgcn_update_dpp(0, __builtin_bit_cast(int, v), CTRL, 0xf, 0xf, false)); }
__device__ __forceinline__ float row_sum16(float v) { v += dpp_<0xB1>(v); v += dpp_<0x4E>(v); v += dpp_<0x141>(v); v += dpp_<0x140>(v); return v; }
__device__ __forceinline__ float row_max16(float v) { v = fmaxf(v, dpp_<0xB1>(v)); v = fmaxf(v, dpp_<0x4E>(v)); v = fmaxf(v, dpp_<0x141>(v)); v = fmaxf(v, dpp_<0x140>(v)); return v; }
__device__ __forceinline__ float wave_sum_fast(float v) { v = row_sum16(v);
    const int i = __builtin_bit_cast(int, v);
    return (__builtin_bit_cast(float, __builtin_amdgcn_readlane(i, 0)) + __builtin_bit_cast(float, __builtin_amdgcn_readlane(i, 16))) + (__builtin_bit_cast(float, __builtin_amdgcn_readlane(i, 32)) + __builtin_bit_cast(float, __builtin_amdgcn_readlane(i, 48))); }
struct Frame {
    LAS unsigned char* lds;
    int tid, lane, wave, wg, G;
};
constexpr int PT_OFF = 135168 + 256;
__device__ __forceinline__ unsigned long long ptab_(LAS unsigned char* lds, int i) { const unsigned long long v = ((const LAS unsigned long long*)(lds + PT_OFF))[i];
    const unsigned lo = __builtin_amdgcn_readfirstlane((unsigned)v), hi = __builtin_amdgcn_readfirstlane((unsigned)(v >> 32)); return ((unsigned long long)hi << 32) | lo; }
#define GAS __attribute__((address_space(1)))
template <class T> __device__ __forceinline__ T* as_global_(unsigned long long v) { return (T*)(GAS T*)v; }
#define INP(i) as_global_<const float>(ptab_(F.lds, (i)))
#define OUTP() as_global_<float>(ptab_(F.lds, N_IN))
#define HXP() as_global_<bf16>(ptab_(F.lds, N_IN))
#define XBP() WSP(bf16, WS_XB)
__device__ __forceinline__ void relaunder(Frame& F) { int t_ = threadIdx.x; asm volatile("" : "+v"(t_)); F.tid = t_; F.lane = t_ & 63; F.wave = __builtin_amdgcn_readfirstlane(t_ >> 6); }
#define WSP(T, off) as_global_<T>(ptab_(F.lds, N_IN + 1) + (off))

__device__ __forceinline__ void transpose_item(const float* __restrict__ W, int ldw, int k0, int n0, bf16* __restrict__ WT, int ldk, int drow0, LAS float* scr, int lane) {
#pragma unroll 8
    for (int i = 0; i < 32; ++i) { const int kk = 2 * i + (lane >> 5); scr[kk * 33 + (lane & 31)] = W[(size_t)(k0 + kk) * ldw + n0 + (lane & 31)]; }
    LDS_WAIT(); asm volatile("" ::: "memory");
    const int c = lane & 7;
#pragma unroll
    for (int j = 0; j < 4; ++j) { const int n = (lane >> 3) + 8 * j; const LAS float* s = scr + (8 * c) * 33 + n;
        v4u o; o.x = pk2(s[0 * 33], s[1 * 33]); o.y = pk2(s[2 * 33], s[3 * 33]); o.z = pk2(s[4 * 33], s[5 * 33]); o.w = pk2(s[6 * 33], s[7 * 33]);
        *(v4u*)(WT + (size_t)(drow0 + n) * ldk + k0 + 8 * c) = o; }
    LDS_WAIT(); asm volatile("" ::: "memory");
}
__device__ __forceinline__ void transpose_item64(const float* __restrict__ W, int ldw, int k0, int n0, bf16* __restrict__ WT, int ldk, int drow0, LAS float* scr, int lane) {
    const int q = lane & 15, kr = lane >> 4;
    f32x4 v[16];
#pragma unroll
    for (int i = 0; i < 16; ++i) v[i] = __builtin_nontemporal_load((const f32x4*)(W + (size_t)(k0 + 4 * i + kr) * ldw + n0 + 4 * q));
#pragma unroll
    for (int i = 0; i < 16; ++i) { LAS float* d = scr + (4 * i + kr) * 65 + 4 * q; d[0] = v[i].x; d[1] = v[i].y; d[2] = v[i].z; d[3] = v[i].w; }
    LDS_WAIT(); asm volatile("" ::: "memory");
    const int c = lane & 7;
#pragma unroll
    for (int j = 0; j < 8; ++j) { const int n = (lane >> 3) + 8 * j; const LAS float* s = scr + (8 * c) * 65 + n;
        v4u o; o.x = pk2(s[0 * 65], s[1 * 65]); o.y = pk2(s[2 * 65], s[3 * 65]); o.z = pk2(s[4 * 65], s[5 * 65]); o.w = pk2(s[6 * 65], s[7 * 65]);
        *(v4u*)(WT + (size_t)(drow0 + n) * ldk + k0 + 8 * c) = o; }
    LDS_WAIT(); asm volatile("" ::: "memory");
}
constexpr int N_EXP_ITEMS = 3 * 16 * 256;
constexpr int CW_FILL = 64;
__device__ __forceinline__ void convert_item(Frame& F, int l, int it) {
    LAS float* scr = (LAS float*)(F.lds + F.wave * 16640);
    bf16* WGU = WSP(bf16, WS_WGU + (size_t)l * WS_WEXP_L); bf16* WD = WSP(bf16, WS_WD + (size_t)l * WS_WEXP_L);
    const int mat = it / (16 * 256), r = it % (16 * 256), e = r >> 8, t = r & 255, kb = t >> 4, nb = t & 15, k0 = kb * 64, n0 = nb * 64;
    const size_t eoff = ((size_t)l * 16 + e) * 1024 * 1024;
    if (mat == 0)      transpose_item64(INP(I_WG) + eoff, 1024, k0, n0, WGU + (size_t)e * 2048 * 1024, 1024, (n0 >> 7) * 256 + (n0 & 127), scr, F.lane);
    else if (mat == 1) transpose_item64(INP(I_WU) + eoff, 1024, k0, n0, WGU + (size_t)e * 2048 * 1024, 1024, (n0 >> 7) * 256 + 128 + (n0 & 127), scr, F.lane);
    else               transpose_item64(INP(I_WD) + eoff, 1024, k0, n0, WD + (size_t)e * 1024 * 1024, 1024, n0, scr, F.lane);
}
__device__ __forceinline__ void filler(Frame& F, int budget, int only_l) {
    volatile LAS unsigned* MISC = (volatile LAS unsigned*)(F.lds + MISC_OFF);
    unsigned* ctr = WSP(unsigned, WS_CTL) + CW_FILL;
    int l = only_l >= 0 ? only_l : 0;
    for (int g = 0; only_l >= 0 || g < budget; ++g) {
        __syncthreads();
        if (F.tid == 0) { unsigned base = __hip_atomic_fetch_add(ctr + 64 * l, 8u, __ATOMIC_RELAXED, __HIP_MEMORY_SCOPE_AGENT);
            if (base >= (unsigned)N_EXP_ITEMS && only_l < 0 && l == 0) { base = __hip_atomic_fetch_add(ctr + 64, 8u, __ATOMIC_RELAXED, __HIP_MEMORY_SCOPE_AGENT) | 0x80000000u; }
            MISC[20] = base; }
        LDS_WAIT(); __syncthreads();
        unsigned base = MISC[20]; int ll = l;
        if (base & 0x80000000u) { base &= 0x7fffffffu; ll = 1; l = 1; }
        if (base >= (unsigned)N_EXP_ITEMS) break;
        convert_item(F, ll, (int)base + F.wave);
    }
    __syncthreads();
}
__device__ __forceinline__ void p0_prep(Frame& F) {
    const int gw = F.wg * NWAVES + F.wave, NGW = F.G * NWAVES;
    LAS float* sil = (LAS float*)(F.lds + 8 * 8448);
    for (int i = F.tid; i < 5 * 1024; i += NTHR) { const int s = i >> 10, k = i & 1023; const float cv = s < 4 ? INP(I_C)[s * 1024 + k] : INP(I_CCTX)[k]; sil[i] = cv * sigmoidf_(cv); }
    LAS float* cst = (LAS float*)(F.lds + 8 * 8448 + 5 * 1024 * 4);
    if (F.tid < 64) { cst[F.tid] = cospif((float)F.tid / 32.0f); cst[64 + F.tid] = sinpif((float)F.tid / 32.0f); }
    LDS_WAIT(); __syncthreads();
    constexpr int N_ADA = 16 * 24, N_FOLD = 256, N_IN_ITEMS = 16 * 56, N_OUT_ITEMS = 16 * 32, N_LRU = 32;
    constexpr int PER_L = N_ADA + N_FOLD + N_IN_ITEMS + N_OUT_ITEMS + N_LRU;
    LAS float* scr = (LAS float*)(F.lds + F.wave * 8448);
    for (int it = gw; it < 2 * PER_L; it += NGW) {
        const int l = it & 1; int r = it >> 1;
        if (r < N_ADA) {
            const int kq = r / 24, cb = r % 24, j0 = cb * 256 + 4 * F.lane;
            const float* W = INP(I_WADA) + (size_t)l * 1024 * 6144 + j0;
            f32x4 acc[5];
#pragma unroll
            for (int s = 0; s < 5; ++s) acc[s] = (f32x4){0.f, 0.f, 0.f, 0.f};
            for (int kb = 0; kb < 4; ++kb) { f32x4 w[16];
#pragma unroll
                for (int i = 0; i < 16; ++i) w[i] = __builtin_nontemporal_load((const f32x4*)(W + (size_t)(kq * 64 + kb * 16 + i) * 6144));
#pragma unroll
                for (int i = 0; i < 16; ++i)
#pragma unroll
                    for (int s = 0; s < 5; ++s) acc[s] += w[i] * sil[s * 1024 + kq * 64 + kb * 16 + i]; }
            float* MP = WSP(float, WS_MODP);
#pragma unroll
            for (int s = 0; s < 5; ++s) *(f32x4*)(MP + ((size_t)(kq * 2 + l) * 5 + s) * 6144 + j0) = acc[s];
            continue; }
        r -= N_ADA;
        if (r < N_FOLD) {
            const int kb = r >> 4, g = (r >> 2) & 3, mq = r & 3, k = kb * 64 + F.lane;
            const float* Wr = INP(I_WIN) + (size_t)l * 1024 * 2048 + (size_t)k * 2048 + 1792 + 64 * g;
            float wrow[64];
#pragma unroll
            for (int c4 = 0; c4 < 16; ++c4) { const f32x4 t = *(const f32x4*)(Wr + 4 * c4); wrow[4 * c4] = t.x; wrow[4 * c4 + 1] = t.y; wrow[4 * c4 + 2] = t.z; wrow[4 * c4 + 3] = t.w; }
            bf16* WT = WSP(bf16, WS_WIN) + (size_t)l * INC * 1024;
            for (int m = 16 * mq; m < 16 * mq + 16; ++m) { float re = 0.f, im = 0.f;
#pragma unroll
                for (int c = 0; c < 64; ++c) { const int a = (m * c) & 63; re += wrow[c] * cst[a]; im -= wrow[c] * cst[64 + a]; }
                WT[(size_t)(1792 + 64 * g + m) * 1024 + k] = (bf16)f2bf(re);
                WT[(size_t)(2048 + 64 * g + m) * 1024 + k] = (bf16)f2bf(im); }
            continue; }
        r -= N_FOLD;
        if (r < N_IN_ITEMS) {
            const int kb = r / 56, nb = r % 56;
            const int n0 = nb * 32, j = n0 < 1536 ? n0 - 1280 : n0 - 1536;
            const int drow = n0 < 1280 ? n0 : 1280 + (j >> 7) * 256 + (n0 < 1536 ? 0 : 128) + (j & 127);
            transpose_item(INP(I_WIN) + (size_t)l * 1024 * 2048, 2048, kb * 64, n0, WSP(bf16, WS_WIN) + (size_t)l * INC * 1024, 1024, drow, scr, F.lane); continue; }
        r -= N_IN_ITEMS;
        if (r < N_OUT_ITEMS) { const int kb = r >> 5, nb = r & 31;
            transpose_item(INP(I_WOUT) + (size_t)l * 1024 * 1024, 1024, kb * 64, nb * 32, WSP(bf16, WS_WOUT) + (size_t)l * 1024 * 1024, 1024, nb * 32, scr, F.lane); continue; }
        r -= N_OUT_ITEMS;
        {
            const int dir = r >> 4, gate = (r >> 3) & 1, h = r & 7;
            const float* W = INP(gate ? I_LWI : I_LWR) + ((size_t)(l * 2 + dir) * 8 + h) * 4096;
            bf16* WT = WSP(bf16, WS_WGL) + ((size_t)l * 8 + h) * 256 * 64 + (size_t)(dir * 2 + gate) * 64 * 64;
            for (int i = 0; i < 64; ++i) WT[F.lane * 64 + i] = (bf16)f2bf(W[i * 64 + F.lane]);
        }
    }
    const int gt = F.wg * NTHR + F.tid, NGT = F.G * NTHR;
    float* TW = WSP(float, WS_TW); bf16* C128 = WSP(bf16, WS_C128); bf16* S128 = WSP(bf16, WS_S128); bf16* T2M = WSP(bf16, WS_T2M); bf16* TCM = WSP(bf16, WS_TCM); float* SP8 = WSP(float, WS_SP8);
    for (int i = gt; i < 8192; i += NGT) { TW[2 * i] = cospif((float)i / 4096.0f); TW[2 * i + 1] = sinpif((float)i / 4096.0f); }
    for (int i = gt; i < 128 * 128; i += NGT) { const int k = i >> 7, n = i & 127, a = (k * n) & 127; C128[i] = (bf16)f2bf(cospif((float)a / 64.0f)); S128[i] = (bf16)f2bf(sinpif((float)a / 64.0f)); }
    for (int i = gt; i < 64 * 128; i += NGT) { const int k = i >> 7, nq = (i & 127) >> 1, ri = i & 1, a = (k * nq) & 63; T2M[i] = (bf16)f2bf(ri ? sinpif((float)a / 32.0f) : cospif((float)a / 32.0f)); }
    for (int i = gt; i < 256 * 512; i += NGT) { const int k = i >> 9, n = (i & 511) >> 1, ri = i & 1, a = (k * n) & 255; TCM[i] = (bf16)f2bf(ri ? sinpif((float)a / 128.0f) : cospif((float)a / 128.0f)); }
    for (int i = gt; i < 2048; i += NGT) { const float lam = INP(I_LAM)[i]; SP8[i] = 8.0f * log1pf(expf(-lam)); }
}
__device__ __forceinline__ void p0b_mods(Frame& F) {
    const int gt = F.wg * NTHR + F.tid, NGT = F.G * NTHR;
    const float* MP = WSP(float, WS_MODP); float* MS = WSP(float, WS_MODS);
    for (int i = gt; i < 2 * 5 * 6144; i += NGT) { const int l = i / (5 * 6144), r = i % (5 * 6144), s = r / 6144, j = r % 6144;
        float a = INP(I_BADA)[l * 6144 + j];
#pragma unroll
        for (int kq = 0; kq < 16; ++kq) a += MP[((size_t)(kq * 2 + l) * 5 + s) * 6144 + j];
        MS[i] = a; }
}

__device__ __forceinline__ int row_set(int row) { return row < NLAT ? (row >> 13) : 4; }
__device__ __forceinline__ void norm_mod_store(const f32x4 (&v)[4], const float* g, const float* shift, const float* scale, bf16* orow, int lane) {
    float ss = 0.f;
#pragma unroll
    for (int j = 0; j < 4; ++j) ss += (v[j].x * v[j].x + v[j].y * v[j].y) + (v[j].z * v[j].z + v[j].w * v[j].w);
    const float rstd = rsq_(wave_sum_fast(ss) * (1.0f / D) + EPS);
    unsigned long long* o8 = (unsigned long long*)orow + lane;
#pragma unroll
    for (int j = 0; j < 4; ++j) { const int c = 4 * lane + 256 * j;
        const f32x4 gg = *(const f32x4*)(g + c), sh = *(const f32x4*)(shift + c), sc = *(const f32x4*)(scale + c);
        const f32x4 o = (v[j] * rstd * gg) * (sc + 1.0f) + sh;
        o8[64 * j] = (unsigned long long)pk2(o.x, o.y) | ((unsigned long long)pk2(o.z, o.w) << 32); }
}
#define ROWCOL(lane, j) (8 * (lane) + 512 * ((j) >> 1) + 4 * ((j) & 1))
__device__ __forceinline__ void norm_mod_store8(const f32x4 (&v)[4], const float* g, const float* shift, const float* scale, bf16* orow, int lane) {
    float ss = 0.f;
#pragma unroll
    for (int j = 0; j < 4; ++j) ss += (v[j].x * v[j].x + v[j].y * v[j].y) + (v[j].z * v[j].z + v[j].w * v[j].w);
    const float rstd = rsq_(wave_sum_fast(ss) * (1.0f / D) + EPS);
#pragma unroll
    for (int h = 0; h < 2; ++h) { const int c = 8 * lane + 512 * h; f32x4 o[2];
#pragma unroll
        for (int q = 0; q < 2; ++q) { const f32x4 gg = *(const f32x4*)(g + c + 4 * q), sh = *(const f32x4*)(shift + c + 4 * q), sc = *(const f32x4*)(scale + c + 4 * q);
            o[q] = (v[2 * h + q] * rstd * gg) * (sc + 1.0f) + sh; }
        v4u w; w.x = pk2(o[0].x, o[0].y); w.y = pk2(o[0].z, o[0].w); w.z = pk2(o[1].x, o[1].y); w.w = pk2(o[1].z, o[1].w);
        *(v4u*)(orow + c) = w; }
}
__device__ __forceinline__ void load_row8(const bf16* row, int lane, f32x4 (&v)[4]) {
#pragma unroll
    for (int h = 0; h < 2; ++h) { const v4u w = *(const v4u*)(row + 8 * lane + 512 * h);
        v[2 * h] = (f32x4){bf2f(w.x & 0xffffu), bf2f(w.x >> 16), bf2f(w.y & 0xffffu), bf2f(w.y >> 16)}; v[2 * h + 1] = (f32x4){bf2f(w.z & 0xffffu), bf2f(w.z >> 16), bf2f(w.w & 0xffffu), bf2f(w.w >> 16)}; }
}
__device__ __forceinline__ void store_row8(bf16* row, int lane, const f32x4 (&v)[4]) {
#pragma unroll
    for (int h = 0; h < 2; ++h) { v4u w; w.x = pk2(v[2 * h].x, v[2 * h].y); w.y = pk2(v[2 * h].z, v[2 * h].w); w.z = pk2(v[2 * h + 1].x, v[2 * h + 1].y); w.w = pk2(v[2 * h + 1].z, v[2 * h + 1].w);
        *(v4u*)(row + 8 * lane + 512 * h) = w; }
}
__device__ __forceinline__ void s0_norm1(Frame& F) {
    const int gw = F.wg * NWAVES + F.wave, NGW = F.G * NWAVES;
    const float* MS = WSP(float, WS_MODS); bf16* HX = HXP();
    const int npairs = NROW / 2;
    f32x4 va[4], vb[4];
    if (gw < npairs) { const int ra = 2 * gw; const float* xr = ra < NLAT ? INP(I_X) + (size_t)ra * D : INP(I_CTX) + (size_t)(ra - NLAT) * D;
#pragma unroll
        for (int j = 0; j < 4; ++j) { va[j] = *(const f32x4*)(xr + 4 * F.lane + 256 * j); vb[j] = *(const f32x4*)(xr + D + 4 * F.lane + 256 * j); } }
    for (int rp = gw; rp < npairs; rp += NGW) {
        const int ra = 2 * rp; f32x4 na[4], nb[4]; const bool more = rp + NGW < npairs;
        if (more) { const int rn = 2 * (rp + NGW); const float* xr = rn < NLAT ? INP(I_X) + (size_t)rn * D : INP(I_CTX) + (size_t)(rn - NLAT) * D;
#pragma unroll
            for (int j = 0; j < 4; ++j) { na[j] = *(const f32x4*)(xr + 4 * F.lane + 256 * j); nb[j] = *(const f32x4*)(xr + D + 4 * F.lane + 256 * j); } }
        const float* m = MS + (size_t)row_set(ra) * 6144;
        norm_mod_store(va, INP(I_GN1), m, m + 1024, HX + (size_t)ra * D, F.lane);
        norm_mod_store(vb, INP(I_GN1), m, m + 1024, HX + (size_t)(ra + 1) * D, F.lane);
        if (more) {
#pragma unroll
            for (int j = 0; j < 4; ++j) { va[j] = na[j]; vb[j] = nb[j]; } }
    }
}

#define MFMA32(a, b, c) __builtin_amdgcn_mfma_f32_32x32x16_bf16((a), (b), (c), 0, 0, 0)
__device__ __forceinline__ bf16x8 ldsB_frag(const LAS bf16* t, int stride, int k0, int col, int lane) {
    const LAS bf16* p = t + (k0 + 8 * (lane >> 5)) * stride + col; bf16x8 r;
#pragma unroll
    for (int j = 0; j < 8; ++j) r[j] = (short)p[j * stride];
    return r;
}
__device__ __forceinline__ bf16x8 neg_frag(bf16x8 a) { v4u u = __builtin_bit_cast(v4u, a); u ^= 0x80008000u; return __builtin_bit_cast(bf16x8, u); }
__device__ __forceinline__ int rowmap(int r, int hh) { return (r & 3) + 8 * (r >> 2) + 4 * hh; }

constexpr int D1_STRIDE = 520;
__device__ __forceinline__ void dft1_unit(Frame& F, int b, int nq) {
    relaunder(F);
    LAS bf16* tile = (LAS bf16*)F.lds;
    const bf16* PX = WSP(bf16, WS_REGA);
#pragma unroll 4
    for (int i = 0; i < 16; ++i) { const int q = F.tid + NTHR * i, row = q >> 6, ch = q & 63;
        const v4u v = *(const v4u*)(PX + (size_t)(b * SEQ + 64 * row + nq) * PXC + PX_Z + ch * 8);
        *(LAS v4u*)(tile + row * D1_STRIDE + ch * 8) = v; }
    LDS_WAIT(); __syncthreads();
    const bf16* C128 = WSP(bf16, WS_C128); const bf16* S128 = WSP(bf16, WS_S128);
    const int hh = F.lane >> 5, ln = F.lane & 31, cw = 32 * F.wave + ln;
    f32x16 are[4], aim[4];
#pragma unroll
    for (int mb = 0; mb < 4; ++mb)
#pragma unroll
        for (int r = 0; r < 16; ++r) { are[mb][r] = 0.f; aim[mb][r] = 0.f; }
    for (int ks = 0; ks < 8; ++ks) {
        const bf16x8 xre = ldsB_frag(tile, D1_STRIDE, 16 * ks, cw, F.lane), xim = ldsB_frag(tile, D1_STRIDE, 16 * ks, 256 + cw, F.lane);
#pragma unroll
        for (int mb = 0; mb < 4; ++mb) {
            const bf16x8 cf = *(const bf16x8*)(C128 + (32 * mb + ln) * 128 + 16 * ks + 8 * hh), sf = *(const bf16x8*)(S128 + (32 * mb + ln) * 128 + 16 * ks + 8 * hh);
            are[mb] = MFMA32(cf, xre, are[mb]); are[mb] = MFMA32(sf, xim, are[mb]);
            aim[mb] = MFMA32(cf, xim, aim[mb]); aim[mb] = MFMA32(neg_frag(sf), xre, aim[mb]);
        }
    }
    const float* TW = WSP(float, WS_TW); bf16* T1 = WSP(bf16, WS_T1);
#pragma unroll
    for (int mb = 0; mb < 4; ++mb)
#pragma unroll
        for (int r = 0; r < 16; ++r) { const int kp = 32 * mb + rowmap(r, hh); const int a = (kp * nq) & 8191; const float c = TW[2 * a], s = TW[2 * a + 1];
            const float re = are[mb][r], im = aim[mb][r];
            bf16* o = T1 + ((size_t)((b * 128 + kp) * 64 + nq) * 2) * 256 + cw;
            o[0] = (bf16)f2bf(re * c + im * s); o[256] = (bf16)f2bf(im * c - re * s); }
    __syncthreads();
}
constexpr int D2_STRIDE = 264;
__device__ __forceinline__ void dft2_unit(Frame& F, int l, const bf16* Amat, int lda, int m0, int nchunks, const bf16* dbase, size_t tokstride, size_t chunkstride, float scale, int orow0, int ostride, const LAS bf16* Alds) {
    relaunder(F);
    LAS bf16* tile = (LAS bf16*)F.lds;
    const int hh = F.lane >> 5, ln = F.lane & 31, cw = 32 * F.wave + ln;
    f32x16 acc[2];
#pragma unroll
    for (int mb = 0; mb < 2; ++mb)
#pragma unroll
        for (int r = 0; r < 16; ++r) acc[mb][r] = 0.f;
    for (int ck = 0; ck < nchunks; ++ck) {
        const bf16* dsrc = dbase + (size_t)ck * chunkstride;
        { v4u dv[8];
#pragma unroll
          for (int i = 0; i < 8; ++i) { const int q = F.tid + NTHR * i, krow = q >> 5, ch = q & 31;
              dv[i] = *(const v4u*)(dsrc + (size_t)(krow >> 1) * tokstride + (krow & 1) * 256 + ch * 8); }
#pragma unroll
          for (int i = 0; i < 8; ++i) { const int q = F.tid + NTHR * i, krow = q >> 5, ch = q & 31; *(LAS v4u*)(tile + krow * D2_STRIDE + ch * 8) = dv[i]; } }
        LDS_WAIT(); __syncthreads();
        for (int ks = 0; ks < 8; ++ks) {
            const bf16x8 xf = ldsB_frag(tile, D2_STRIDE, 16 * ks, cw, F.lane);
#pragma unroll
            for (int mb = 0; mb < 2; ++mb) { const bf16x8 af = Alds ? *(const LAS bf16x8*)(Alds + (32 * mb + ln) * 136 + 16 * ks + 8 * hh) : *(const bf16x8*)(Amat + (size_t)(m0 + 32 * mb + ln) * lda + ck * 128 + 16 * ks + 8 * hh);
                acc[mb] = MFMA32(af, xf, acc[mb]); }
        }
        __syncthreads();
    }
    LAS float* yt = (LAS float*)F.lds;
#pragma unroll
    for (int mb = 0; mb < 2; ++mb)
#pragma unroll
        for (int r = 0; r < 16; ++r) yt[(32 * mb + rowmap(r, hh)) * 260 + cw] = acc[mb][r] * scale;
    LDS_WAIT(); __syncthreads();
    { const int m = F.tid >> 3, seg = F.tid & 7; const LAS float* p = yt + m * 260 + 32 * seg;
        f32x4 v[8]; float ss = 0.f;
#pragma unroll
        for (int j = 0; j < 8; ++j) { v[j] = *(const LAS f32x4*)(p + 4 * j); ss += (v[j].x * v[j].x + v[j].y * v[j].y) + (v[j].z * v[j].z + v[j].w * v[j].w); }
        ss += __shfl_xor(ss, 1); ss += __shfl_xor(ss, 2); ss += __shfl_xor(ss, 4);
        const float rstd = rsq_(ss * (1.0f / 256.0f) + EPS);
        const float* g = INP(I_GOUT) + l * 1024 + 768 + 32 * seg;
        bf16* o = WSP(bf16, WS_Y) + (size_t)(orow0 + m * ostride) * D + 768 + 32 * seg;
#pragma unroll
        for (int j = 0; j < 4; ++j) { const f32x4 g0 = *(const f32x4*)(g + 8 * j), g1 = *(const f32x4*)(g + 8 * j + 4); const f32x4 a = v[2 * j] * rstd * g0, c = v[2 * j + 1] * rstd * g1;
            v4u w; w.x = pk2(a.x, a.y); w.y = pk2(a.z, a.w); w.z = pk2(c.x, c.y); w.w = pk2(c.z, c.w); *(v4u*)(o + 8 * j) = w; } }
    __syncthreads();
}

constexpr int UT_STRIDE = 520;
constexpr int UT_BYTES = 64 * UT_STRIDE * 2;
struct UWin { u16x8 rows[11]; };
__device__ __forceinline__ void lru_bounds(int cid, int& lo, int& hi) { if (cid < 512) { lo = cid * 64; hi = lo + 64; } else { lo = NLAT + ((cid - 512) >> 2) * CTXL; hi = lo + CTXL; } }
__device__ __forceinline__ void lru_issue_u(Frame& F, int cid, UWin& w) {
    const bf16* PX = WSP(bf16, WS_REGA);
    const int row0 = cid * 64; int lo, hi; lru_bounds(cid, lo, hi);
    const int ch0 = (F.tid & 63) * 8, t0 = (F.tid >> 6) * 8;
#pragma unroll
    for (int k = 0; k < 11; ++k) { const int rr = row0 + t0 - 1 + k, rc = rr < lo ? lo : (rr >= hi ? hi - 1 : rr);
        w.rows[k] = *(const u16x8*)(PX + (size_t)rc * PXC + ch0); }
}
__device__ __forceinline__ void lru_finish_u(Frame& F, int l, int cid, UWin& win, LAS bf16* ut) {
    const int row0 = cid * 64; int lo, hi; lru_bounds(cid, lo, hi);
    const int ch0 = (F.tid & 63) * 8, t0 = (F.tid >> 6) * 8;
    f32x4 w[4][2], bias[2];
#pragma unroll
    for (int k = 0; k < 4; ++k) { w[k][0] = *(const f32x4*)(INP(I_LCW) + (l * 4 + k) * 512 + ch0); w[k][1] = *(const f32x4*)(INP(I_LCW) + (l * 4 + k) * 512 + ch0 + 4); }
    bias[0] = *(const f32x4*)(INP(I_LCB) + l * 512 + ch0); bias[1] = *(const f32x4*)(INP(I_LCB) + l * 512 + ch0 + 4);
#pragma unroll
    for (int k = 0; k < 11; ++k) { const int rr = row0 + t0 - 1 + k; if (rr < lo || rr >= hi) win.rows[k] = (u16x8){0, 0, 0, 0, 0, 0, 0, 0}; }
#pragma unroll
    for (int t = 0; t < 8; ++t) { f32x4 a0 = bias[0], a1 = bias[1];
#pragma unroll
        for (int k = 0; k < 4; ++k) { const u16x8 v = win.rows[t + k];
            a0 += w[k][0] * (f32x4){bf2f(v[0]), bf2f(v[1]), bf2f(v[2]), bf2f(v[3])}; a1 += w[k][1] * (f32x4){bf2f(v[4]), bf2f(v[5]), bf2f(v[6]), bf2f(v[7])}; }
        v4u o; o.x = pk2(a0.x, a0.y); o.y = pk2(a0.z, a0.w); o.z = pk2(a1.x, a1.y); o.w = pk2(a1.z, a1.w);
        *(LAS v4u*)(ut + (t0 + t) * UT_STRIDE + ch0) = o; }
}
struct LruOps { bf16x8 fr[2][4], fi[2][4]; float b_r[2], b_i[2], sp[2]; };
template <int dir> __device__ __forceinline__ void lru_load_ops(Frame& F, int l, int nb, LruOps& o) {
    const int hd = F.wave, hh = F.lane >> 5, ln = F.lane & 31, ch = hd * 64 + nb * 32 + ln;
    const bf16* WG = WSP(bf16, WS_WGL) + ((size_t)l * 8 + hd) * 256 * 64;
#pragma unroll
    for (int ks = 0; ks < 4; ++ks) {
        o.fr[dir][ks] = *(const bf16x8*)(WG + (size_t)((dir * 2 + 0) * 64 + nb * 32 + ln) * 64 + 16 * ks + 8 * hh);
        o.fi[dir][ks] = *(const bf16x8*)(WG + (size_t)((dir * 2 + 1) * 64 + nb * 32 + ln) * 64 + 16 * ks + 8 * hh); }
    o.b_r[dir] = -1.4426950408889634f * INP(I_LBR)[(l * 2 + dir) * 512 + ch]; o.b_i[dir] = -1.4426950408889634f * INP(I_LBI)[(l * 2 + dir) * 512 + ch]; o.sp[dir] = -1.4426950408889634f * WSP(float, WS_SP8)[(l * 2 + dir) * 512 + ch];
}
template <int dir> __device__ __forceinline__ void lru_gates(Frame& F, const LruOps& o, const LAS bf16* ut, int mb, f32x16& a, f32x16& bb) {
    const int hd = F.wave, hh = F.lane >> 5, ln = F.lane & 31;
#pragma unroll
    for (int r = 0; r < 16; ++r) { a[r] = 0.f; bb[r] = 0.f; }
#pragma unroll
    for (int ks = 0; ks < 4; ++ks) {
        const bf16x8 af = *(const LAS bf16x8*)(ut + (32 * mb + ln) * UT_STRIDE + hd * 64 + 16 * ks + 8 * hh);
        a = MFMA32(af, o.fr[dir][ks], a); bb = MFMA32(af, o.fi[dir][ks], bb);
    }
}
template <int dir> __device__ __forceinline__ void lru_elem(Frame& F, const LruOps& o, const LAS bf16* ut, int nb, int mb, f32x16& a, f32x16& bb) {
    const int hd = F.wave, hh = F.lane >> 5, ln = F.lane & 31, ch = hd * 64 + nb * 32 + ln;
    const float nb_r = o.b_r[dir], nb_i = o.b_i[dir], spl = o.sp[dir];
    const LAS bf16* ub = ut + (32 * mb + 4 * hh) * UT_STRIDE + ch;
#pragma unroll
    for (int r = 0; r < 16; ++r) {
        const float rr = __builtin_amdgcn_rcpf(1.0f + __builtin_amdgcn_exp2f(__builtin_fmaf(a[r], -1.4426950408889634f, nb_r)));
        const float ii = __builtin_amdgcn_rcpf(1.0f + __builtin_amdgcn_exp2f(__builtin_fmaf(bb[r], -1.4426950408889634f, nb_i)));
        const float av = __builtin_amdgcn_exp2f(rr * spl), mult = __builtin_amdgcn_sqrtf(__builtin_fmaf(-av, av, 1.0f));
        const float uv = bf2f(ub[((r & 3) + 8 * (r >> 2)) * UT_STRIDE]);
        a[r] = av; bb[r] = (mult * ii) * uv; }
}
#define MEMFENCE() asm volatile("" ::: "memory")
template <int dir> __device__ __forceinline__ float lru_scan(int lane, float hin, const f32x16& a, f32x16& bb, float* Atot) {
    const bool hi = (lane >> 5) != 0;
    const bool own_first = dir == 0 ? !hi : hi;
    float oA[4], oB[4];
#pragma unroll
    for (int q = 0; q < 4; ++q) {
        const float a0 = a[4 * q], a1 = a[4 * q + 1], a2 = a[4 * q + 2], a3 = a[4 * q + 3];
        const float b0 = bb[4 * q], b1 = bb[4 * q + 1], b2 = bb[4 * q + 2], b3 = bb[4 * q + 3];
        oA[q] = (a0 * a1) * (a2 * a3);
        oB[q] = dir == 0 ? ((b0 * a1 + b1) * a2 + b2) * a3 + b3 : ((b3 * a2 + b2) * a1 + b1) * a0 + b0; }
    float h = hin, At = 1.0f; float cin[4];
#pragma unroll
    for (int s = 0; s < 4; ++s) { const int q = dir == 0 ? s : 3 - s;
        const float pA = __shfl_xor(oA[q], 32), pB = __shfl_xor(oB[q], 32);
        const float A1 = own_first ? oA[q] : pA, B1 = own_first ? oB[q] : pB, A2 = own_first ? pA : oA[q], B2 = own_first ? pB : oB[q];
        const float h1 = A1 * h + B1, h2 = A2 * h1 + B2;
        cin[q] = own_first ? h : h1; h = h2; At *= A1 * A2; }
#pragma unroll
    for (int q = 0; q < 4; ++q) { float x = cin[q];
        if (dir == 0) {
#pragma unroll
            for (int j = 0; j < 4; ++j) { x = a[4 * q + j] * x + bb[4 * q + j]; bb[4 * q + j] = x; }
        } else {
#pragma unroll
            for (int j = 3; j >= 0; --j) { x = a[4 * q + j] * x + bb[4 * q + j]; bb[4 * q + j] = x; }
        } }
    *Atot = At; return h;
}
__device__ __forceinline__ void lru_a_phase(Frame& F, int l) {
    relaunder(F);
    LAS bf16* ut = (LAS bf16*)F.lds;
    float* SM = WSP(float, WS_SUMM);
    constexpr int NUNIT = 512 + 2 * (NCHUNK - 512);
    int un = F.wg; UWin win;
    if (un < NUNIT) lru_issue_u(F, un < 512 ? un : 512 + ((un - 512) >> 1), win);
    for (; un < NUNIT; un += F.G) {
        const int cid = un < 512 ? un : 512 + ((un - 512) >> 1), nbsel = un < 512 ? -1 : ((un - 512) & 1);
        LruOps o; lru_load_ops<0>(F, l, nbsel < 0 ? 0 : nbsel, o);
        lru_finish_u(F, l, cid, win, ut);
        LDS_WAIT(); __syncthreads();
        if (un + F.G < NUNIT) { const int u2 = un + F.G; lru_issue_u(F, u2 < 512 ? u2 : 512 + ((u2 - 512) >> 1), win); }
#pragma unroll
        for (int nb = 0; nb < 2; ++nb) { const int ch = F.wave * 64 + nb * 32 + (F.lane & 31);
            if (nbsel >= 0 && nb != nbsel) continue;
            f32x16 a, bb; float A0, A1;
            lru_gates<0>(F, o, ut, 0, a, bb); lru_elem<0>(F, o, ut, nb, 0, a, bb); const float B0 = lru_scan<0>(F.lane, 0.0f, a, bb, &A0);
            lru_gates<0>(F, o, ut, 1, a, bb); MEMFENCE(); lru_load_ops<1>(F, l, nb, o); MEMFENCE();
            lru_elem<0>(F, o, ut, nb, 1, a, bb); const float B1 = lru_scan<0>(F.lane, B0, a, bb, &A1);
            if (F.lane < 32) { SM[((size_t)(cid * 2 + 0) * 2 + 0) * 512 + ch] = A0 * A1; SM[((size_t)(cid * 2 + 0) * 2 + 1) * 512 + ch] = B1; }
            lru_gates<1>(F, o, ut, 1, a, bb); lru_elem<1>(F, o, ut, nb, 1, a, bb); const float C1 = lru_scan<1>(F.lane, 0.0f, a, bb, &A1);
            lru_gates<1>(F, o, ut, 0, a, bb); if (nb == 0 && nbsel < 0) { MEMFENCE(); lru_load_ops<0>(F, l, 1, o); MEMFENCE(); }
            lru_elem<1>(F, o, ut, nb, 0, a, bb); const float C0 = lru_scan<1>(F.lane, C1, a, bb, &A0);
            if (F.lane < 32) { SM[((size_t)(cid * 2 + 1) * 2 + 0) * 512 + ch] = A0 * A1; SM[((size_t)(cid * 2 + 1) * 2 + 1) * 512 + ch] = C0; }
        }
        __syncthreads();
    }
}
__device__ __forceinline__ int carry_cid(int b, int dir, int st) { return dir == 0 ? (st < 4 ? 512 + 4 * b + st : 128 * b + st - 4) : (st < 4 ? 512 + 4 * b + 3 - st : 128 * b + 131 - st); }
__device__ __forceinline__ void s3_carries(Frame& F, int wv  ) {
    const int part = F.lane >> 3, seq = wv * 8 + (F.lane & 7), b = seq >> 10, dir = (seq >> 9) & 1, ch = seq & 511;
    const int s0 = part * 16 + (part < 4 ? part : 4), len = part < 4 ? 17 : 16;
    const float* __restrict__ SM = WSP(float, WS_SUMM); float* __restrict__ CR = WSP(float, WS_CARRY);
    float A[17], B[17];
#pragma unroll
    for (int j = 0; j < 17; ++j) { const int st = s0 + (j < len ? j : 0), cid = carry_cid(b, dir, st);
        A[j] = SM[((size_t)(cid * 2 + dir) * 2 + 0) * 512 + ch]; B[j] = SM[((size_t)(cid * 2 + dir) * 2 + 1) * 512 + ch]; }
    float At = 1.f, Bt = 0.f;
#pragma unroll
    for (int j = 0; j < 17; ++j) if (j < len) { Bt = A[j] * Bt + B[j]; At *= A[j]; }
#pragma unroll
    for (int d = 8; d < 64; d <<= 1) { const float pA = __shfl_up(At, d), pB = __shfl_up(Bt, d); if (F.lane >= d) { Bt = At * pB + Bt; At = At * pA; } }
    float h = __shfl_up(Bt, 8); if (part == 0) h = 0.f;
#pragma unroll
    for (int j = 0; j < 17; ++j) if (j < len) { const int cid = carry_cid(b, dir, s0 + j); CR[(size_t)(cid * 2 + dir) * 512 + ch] = h; h = A[j] * h + B[j]; }
}
__device__ __forceinline__ float gelu_tanh(float x) { const float u = x * x, t = x * __builtin_fmaf(u, -0.10294324f, -2.3022082f);
    return x * __builtin_amdgcn_rcpf(1.0f + __builtin_amdgcn_exp2f(t)); }
__device__ __forceinline__ void lru_b_issue_g(Frame& F, int cid, v4u (&gv)[8]) {
    const bf16* PX = WSP(bf16, WS_REGA); const int row0 = cid * 64;
#pragma unroll
    for (int i = 0; i < 8; ++i) { const int q = F.tid + NTHR * i, tok = q >> 6, cg = q & 63; gv[i] = *(const v4u*)(PX + (size_t)(row0 + tok) * PXC + 512 + cg * 8); }
}
__device__ __forceinline__ void lru_b_phase(Frame& F, int l, int nc) {
    relaunder(F);
    LAS bf16* ut = (LAS bf16*)F.lds; LAS bf16* gt = (LAS bf16*)(F.lds + UT_BYTES);
    const float* CR = WSP(float, WS_CARRY); bf16* Y = WSP(bf16, WS_Y);
    const int hh = F.lane >> 5, ln = F.lane & 31;
    int cid = F.wg; UWin win;
    if (cid < nc) lru_issue_u(F, cid, win);
    for (; cid < nc; cid += F.G) {
        const int row0 = cid * 64;
        v4u gv[8]; lru_b_issue_g(F, cid, gv);
        LruOps o; lru_load_ops<0>(F, l, 0, o);
        float cr0 = CR[(size_t)(cid * 2 + 0) * 512 + F.wave * 64 + ln], cr1 = CR[(size_t)(cid * 2 + 1) * 512 + F.wave * 64 + ln];
        lru_finish_u(F, l, cid, win, ut);
#pragma unroll
        for (int i = 0; i < 8; ++i) { const int q = F.tid + NTHR * i, tok = q >> 6, cg = q & 63; *(LAS v4u*)(gt + tok * UT_STRIDE + cg * 8) = gv[i]; }
        LDS_WAIT(); __syncthreads();
        if (cid + F.G < nc) lru_issue_u(F, cid + F.G, win);
#pragma unroll
        for (int nb = 0; nb < 2; ++nb) { const int ch = F.wave * 64 + nb * 32 + ln;
            f32x16 hs0, hs1, a, bb; float At;
            lru_gates<0>(F, o, ut, 0, a, bb); lru_elem<0>(F, o, ut, nb, 0, a, bb); const float hm0 = lru_scan<0>(F.lane, cr0, a, bb, &At); hs0 = bb;
            lru_gates<0>(F, o, ut, 1, a, bb); MEMFENCE(); lru_load_ops<1>(F, l, nb, o); MEMFENCE();
            lru_elem<0>(F, o, ut, nb, 1, a, bb); (void)lru_scan<0>(F.lane, hm0, a, bb, &At); hs1 = bb;
            lru_gates<1>(F, o, ut, 1, a, bb); lru_elem<1>(F, o, ut, nb, 1, a, bb); const float hm1 = lru_scan<1>(F.lane, cr1, a, bb, &At); hs1 += bb;
            lru_gates<1>(F, o, ut, 0, a, bb);
            if (nb == 0) { MEMFENCE(); lru_load_ops<0>(F, l, 1, o); cr0 = CR[(size_t)(cid * 2 + 0) * 512 + ch + 32]; cr1 = CR[(size_t)(cid * 2 + 1) * 512 + ch + 32]; MEMFENCE(); }
            lru_elem<1>(F, o, ut, nb, 0, a, bb); (void)lru_scan<1>(F.lane, hm1, a, bb, &At); hs0 += bb;
            LAS bf16* gb = gt + (4 * hh) * UT_STRIDE + ch;
#pragma unroll
            for (int r = 0; r < 16; ++r) { LAS bf16* p = gb + ((r & 3) + 8 * (r >> 2)) * UT_STRIDE;
                const float g = bf2f(*p); *p = (bf16)f2bf(hs0[r] * gelu_tanh(g)); }
#pragma unroll
            for (int r = 0; r < 16; ++r) { LAS bf16* p = gb + (32 + (r & 3) + 8 * (r >> 2)) * UT_STRIDE;
                const float g = bf2f(*p); *p = (bf16)f2bf(hs1[r] * gelu_tanh(g)); }
        }
        LDS_WAIT(); __syncthreads();
        {
            const int tok = F.tid >> 3, seg = F.tid & 7; const LAS bf16* p = gt + tok * UT_STRIDE + 64 * seg;
            u16x8 v[8]; float ss = 0.f;
#pragma unroll
            for (int j = 0; j < 8; ++j) { v[j] = *(const LAS u16x8*)(p + 8 * j);
#pragma unroll
                for (int e = 0; e < 8; ++e) { const float f = bf2f(v[j][e]); ss += f * f; } }
            ss += __shfl_xor(ss, 1); ss += __shfl_xor(ss, 2); ss += __shfl_xor(ss, 4);
            const float rstd = rsq_(ss * (1.0f / 512.0f) + EPS);
            const float* g = INP(I_GOUT) + l * 1024 + 64 * seg; bf16* op = Y + (size_t)(row0 + tok) * D + 64 * seg;
#pragma unroll
            for (int j = 0; j < 8; ++j) { const f32x4 g0 = *(const f32x4*)(g + 8 * j), g1 = *(const f32x4*)(g + 8 * j + 4);
                v4u w; w.x = pk2(bf2f(v[j][0]) * rstd * g0.x, bf2f(v[j][1]) * rstd * g0.y); w.y = pk2(bf2f(v[j][2]) * rstd * g0.z, bf2f(v[j][3]) * rstd * g0.w);
                w.z = pk2(bf2f(v[j][4]) * rstd * g1.x, bf2f(v[j][5]) * rstd * g1.y); w.w = pk2(bf2f(v[j][6]) * rstd * g1.z, bf2f(v[j][7]) * rstd * g1.w);
                *(v4u*)(op + 8 * j) = w; } }
        __syncthreads();
    }
}
struct ScWin { u16x8 pp[4], bv[2]; };
__device__ __forceinline__ void sc_issue(Frame& F, int hu, ScWin& w) {
    const bf16* PX = WSP(bf16, WS_REGA); const int cid = hu >> 1, row0 = hu * 32, c0 = 8 * (F.tid & 31), t0 = (F.tid >> 5) * 2; int lo, hi; lru_bounds(cid, lo, hi);
#pragma unroll
    for (int k = 0; k < 4; ++k) { const int r2 = row0 + t0 - 1 + k, rc = r2 < lo ? lo : (r2 >= hi ? hi - 1 : r2);
        w.pp[k] = *(const u16x8*)(PX + (size_t)rc * PXC + 1280 + c0); }
#pragma unroll
    for (int t = 0; t < 2; ++t) w.bv[t] = *(const u16x8*)(PX + (size_t)(row0 + t0 + t) * PXC + 1024 + c0);
}
__device__ __forceinline__ void sc_phase(Frame& F, int l, int nc, int wg0, int nwg) {
    relaunder(F);
    if (F.wg < wg0) return;
    bf16* Y = WSP(bf16, WS_Y);
    const int c0 = 8 * (F.tid & 31), t0 = (F.tid >> 5) * 2, nh = 2 * nc;
    f32x4 w[3][2], gg[2];
#pragma unroll
    for (int k = 0; k < 3; ++k) { w[k][0] = *(const f32x4*)(INP(I_SCW) + (l * 3 + k) * 256 + c0); w[k][1] = *(const f32x4*)(INP(I_SCW) + (l * 3 + k) * 256 + c0 + 4); }
    gg[0] = *(const f32x4*)(INP(I_GOUT) + l * 1024 + 512 + c0); gg[1] = *(const f32x4*)(INP(I_GOUT) + l * 1024 + 512 + c0 + 4);
    int hu = F.wg - wg0; ScWin cur;
    if (hu < nh) sc_issue(F, hu, cur);
    for (; hu < nh; hu += nwg) {
        ScWin nxt; const bool more = hu + nwg < nh;
        if (more) sc_issue(F, hu + nwg, nxt);
        const int row0 = hu * 32; int lo, hi; lru_bounds(hu >> 1, lo, hi);
        f32x4 p0[4], p1[4];
#pragma unroll
        for (int k = 0; k < 4; ++k) { const int r2 = row0 + t0 - 1 + k; const float ok = (r2 >= lo && r2 < hi) ? 1.0f : 0.0f;
            p0[k] = (f32x4){bf2f(cur.pp[k][0]), bf2f(cur.pp[k][1]), bf2f(cur.pp[k][2]), bf2f(cur.pp[k][3])} * ok;
            p1[k] = (f32x4){bf2f(cur.pp[k][4]), bf2f(cur.pp[k][5]), bf2f(cur.pp[k][6]), bf2f(cur.pp[k][7])} * ok; }
#pragma unroll
        for (int t = 0; t < 2; ++t) { const u16x8 bv = cur.bv[t];
            f32x4 a0 = (w[0][0] * p0[t] + w[1][0] * p0[t + 1] + w[2][0] * p0[t + 2]) * (f32x4){bf2f(bv[0]), bf2f(bv[1]), bf2f(bv[2]), bf2f(bv[3])};
            f32x4 a1 = (w[0][1] * p1[t] + w[1][1] * p1[t + 1] + w[2][1] * p1[t + 2]) * (f32x4){bf2f(bv[4]), bf2f(bv[5]), bf2f(bv[6]), bf2f(bv[7])};
            float ss = (a0.x * a0.x + a0.y * a0.y) + (a0.z * a0.z + a0.w * a0.w) + (a1.x * a1.x + a1.y * a1.y) + (a1.z * a1.z + a1.w * a1.w);
            ss += __shfl_xor(ss, 1); ss += __shfl_xor(ss, 2); ss += __shfl_xor(ss, 4); ss += __shfl_xor(ss, 8); ss += __shfl_xor(ss, 16);
            const float rstd = rsq_(ss * (1.0f / 256.0f) + EPS);
            a0 = a0 * rstd * gg[0]; a1 = a1 * rstd * gg[1];
            v4u wv; wv.x = pk2(a0.x, a0.y); wv.y = pk2(a0.z, a0.w); wv.z = pk2(a1.x, a1.y); wv.w = pk2(a1.z, a1.w);
            *(v4u*)(Y + (size_t)(row0 + t0 + t) * D + 512 + c0) = wv; }
        if (more) cur = nxt;
    }
}

__device__ __forceinline__ void s6_norm2_router(Frame& F, int l, int pair0, int npairs, int gw, int NGW) {
    LAS float* wP = (LAS float*)F.lds;
    for (int c = F.tid; c < 1024; c += NTHR) { const float* w = INP(I_WRT) + (size_t)l * 16384 + c * 16;
        const int h = c >> 9, ln = (c & 511) >> 3, q = (c >> 2) & 1, i = c & 3, base = (h * 2 + q) * 256 + 4 * ln + i;
        const f32x4 w0 = *(const f32x4*)w, w1 = *(const f32x4*)(w + 4), w2 = *(const f32x4*)(w + 8), w3 = *(const f32x4*)(w + 12);
        const float wv[16] = {w0.x, w0.y, w0.z, w0.w, w1.x, w1.y, w1.z, w1.w, w2.x, w2.y, w2.z, w2.w, w3.x, w3.y, w3.z, w3.w};
#pragma unroll
        for (int e = 0; e < 16; ++e) wP[e * 1024 + base] = wv[e]; }
    LDS_WAIT(); __syncthreads();
    const float* MS = WSP(float, WS_MODS) + (size_t)l * 5 * 6144; bf16* HX = HXP(); int* ENT = WSP(int, WS_ENT); const bf16* XB = XBP();
    const float* g2 = INP(I_GN2) + l * 1024;
    const bool up32 = (F.lane & 32) != 0, up16 = (F.lane & 16) != 0, up8 = (F.lane & 8) != 0, up4 = (F.lane & 4) != 0, up2 = (F.lane & 2) != 0;
    v4u ra_[2], rb_[2];
    if (pair0 + gw < npairs) { const bf16* xr = XB + (size_t)(2 * (pair0 + gw)) * D;
#pragma unroll
        for (int h = 0; h < 2; ++h) { ra_[h] = *(const v4u*)(xr + 8 * F.lane + 512 * h); rb_[h] = *(const v4u*)(xr + D + 8 * F.lane + 512 * h); } }
    for (int rp = pair0 + gw; rp < npairs; rp += NGW) {
        const int ra = 2 * rp; const bool more = rp + NGW < npairs;
        v4u na_[2], nb_[2];
        if (more) { const bf16* xr = XB + (size_t)(2 * (rp + NGW)) * D;
#pragma unroll
            for (int h = 0; h < 2; ++h) { na_[h] = *(const v4u*)(xr + 8 * F.lane + 512 * h); nb_[h] = *(const v4u*)(xr + D + 8 * F.lane + 512 * h); } }
        f32x4 va[4], vb[4];
#pragma unroll
        for (int h = 0; h < 2; ++h) {
            va[2 * h] = (f32x4){bf2f(ra_[h].x & 0xffffu), bf2f(ra_[h].x >> 16), bf2f(ra_[h].y & 0xffffu), bf2f(ra_[h].y >> 16)}; va[2 * h + 1] = (f32x4){bf2f(ra_[h].z & 0xffffu), bf2f(ra_[h].z >> 16), bf2f(ra_[h].w & 0xffffu), bf2f(ra_[h].w >> 16)};
            vb[2 * h] = (f32x4){bf2f(rb_[h].x & 0xffffu), bf2f(rb_[h].x >> 16), bf2f(rb_[h].y & 0xffffu), bf2f(rb_[h].y >> 16)}; vb[2 * h + 1] = (f32x4){bf2f(rb_[h].z & 0xffffu), bf2f(rb_[h].z >> 16), bf2f(rb_[h].w & 0xffffu), bf2f(rb_[h].w >> 16)}; }
        float sa = 0.f, sb = 0.f;
#pragma unroll
        for (int j = 0; j < 4; ++j) {
            sa += (va[j].x * va[j].x + va[j].y * va[j].y) + (va[j].z * va[j].z + va[j].w * va[j].w); sb += (vb[j].x * vb[j].x + vb[j].y * vb[j].y) + (vb[j].z * vb[j].z + vb[j].w * vb[j].w); }
        const float ra_std = rsq_(wave_sum_fast(sa) * (1.0f / D) + EPS), rb_std = rsq_(wave_sum_fast(sb) * (1.0f / D) + EPS);
        const float* m = MS + (size_t)row_set(ra) * 6144;
#pragma unroll
        for (int j = 0; j < 4; ++j) { const int c = ROWCOL(F.lane, j);
            const f32x4 gg = *(const f32x4*)(g2 + c), sh = *(const f32x4*)(m + 3 * 1024 + c), sc = *(const f32x4*)(m + 4 * 1024 + c) + 1.0f;
            va[j] = (va[j] * ra_std * gg) * sc + sh; vb[j] = (vb[j] * rb_std * gg) * sc + sh; }
        store_row8(HX + (size_t)ra * D, F.lane, va); store_row8(HX + (size_t)(ra + 1) * D, F.lane, vb);
        float lg[32];
#pragma unroll
        for (int e = 0; e < 16; ++e) { float a = 0.f, b = 0.f;
#pragma unroll
            for (int j = 0; j < 4; ++j) { const f32x4 w = *(const LAS f32x4*)(wP + e * 1024 + j * 256 + 4 * F.lane);
                a += (va[j].x * w.x + va[j].y * w.y) + (va[j].z * w.z + va[j].w * w.w); b += (vb[j].x * w.x + vb[j].y * w.y) + (vb[j].z * w.z + vb[j].w * w.w); }
            lg[e] = a; lg[16 + e] = b; }
#define RS_STEP(n, msk, up) _Pragma("unroll") for (int i = 0; i < (n) / 2; ++i) { const float keep = (up) ? lg[i + (n) / 2] : lg[i], send = (up) ? lg[i] : lg[i + (n) / 2]; lg[i] = keep + __shfl_xor(send, (msk)); }
        RS_STEP(32, 32, up32) RS_STEP(16, 16, up16) RS_STEP(8, 8, up8) RS_STEP(4, 4, up4) RS_STEP(2, 2, up2)
#undef RS_STEP
        float v = lg[0] + __shfl_xor(lg[0], 1);
        float mx = row_max16(v); mx = fmaxf(mx, __shfl_xor(mx, 16));
        const float ex = __expf(v - mx); float den = row_sum16(ex); den += __shfl_xor(den, 16);
        const float p = 2.0f * ex / den;
        if ((F.lane & 1) == 0) { const int row = ra + (F.lane >> 5), e = (F.lane >> 1) & 15;
            if (row < NLAT) WSP(float, WS_AFFL)[((size_t)((row >> 13) * 16 + e)) * SEQ + (row & (SEQ - 1))] = p;
            else { const int rc = row - NLAT; WSP(float, WS_AFFC)[((size_t)((rc >> 8) * 16 + e)) * CTXL + (rc & (CTXL - 1))] = p; }
            ENT[(size_t)row * 16 + e] = -1; }
        if (more) {
#pragma unroll
            for (int h = 0; h < 2; ++h) { ra_[h] = na_[h]; rb_[h] = nb_[h]; } }
    }
    __syncthreads();
}
__device__ __forceinline__ void s7_topk_problem(Frame& F, const float* aff, int n, int cap, int slab_base, int tokrow_base, int e) {
    LAS unsigned* keys = (LAS unsigned*)F.lds;
    LAS unsigned* hist = keys + 8192;
    LAS unsigned* wtot = hist + 256;
    LAS unsigned* ctl = wtot + 16;
    if (n == SEQ) {
        float kv[16];
#pragma unroll
        for (int i = 0; i < 16; ++i) kv[i] = aff[F.tid + NTHR * i];
#pragma unroll
        for (int i = 0; i < 16; ++i) keys[F.tid + NTHR * i] = __builtin_bit_cast(unsigned, kv[i]);
    } else for (int i = F.tid; i < n; i += NTHR) keys[i] = __builtin_bit_cast(unsigned, aff[i]);
    unsigned prefix = 0u, mask = 0u; int kk = cap;
    for (int pass = 0; pass < 4; ++pass) { const int shift = 24 - 8 * pass;
        if (F.tid < 256) hist[F.tid] = 0u;
        LDS_WAIT(); __syncthreads();
        for (int i = F.tid; i < n; i += NTHR) { const unsigned k = keys[i]; if ((k & mask) == prefix) atomicAdd((unsigned*)&hist[(k >> shift) & 255u], 1u); }
        LDS_WAIT(); __syncthreads();
        if (F.wave == 0) {
            const v4u c = *(const LAS v4u*)(hist + 4 * F.lane); const unsigned s4 = c.x + c.y + c.z + c.w; unsigned suf = s4;
#pragma unroll
            for (int d = 1; d < 64; d <<= 1) { const unsigned t = __shfl_down(suf, d); if (F.lane + d < 64) suf += t; }
            const unsigned above = suf - s4;
            if (above < (unsigned)kk && suf >= (unsigned)kk) { unsigned cum = above; int bin;
                if (cum + c.w >= (unsigned)kk) bin = 3; else { cum += c.w; if (cum + c.z >= (unsigned)kk) bin = 2; else { cum += c.z; if (cum + c.y >= (unsigned)kk) bin = 1; else { cum += c.y; bin = 0; } } }
                ctl[0] = (unsigned)(4 * F.lane + bin); ctl[1] = (unsigned)kk - cum; } }
        LDS_WAIT(); __syncthreads();
        prefix |= ctl[0] << shift; mask |= 0xFFu << shift; kk = (int)ctl[1];
        __syncthreads();
    }
    const unsigned T = prefix;
    const int per = (n + NTHR - 1) / NTHR, i0 = F.tid * per;
    unsigned ngt = 0u, neq = 0u;
    for (int i = i0; i < i0 + per && i < n; ++i) { const unsigned k = keys[i]; ngt += k > T; neq += k == T; }
    unsigned igt = ngt, ieq = neq;
#pragma unroll
    for (int d = 1; d < 64; d <<= 1) { const unsigned a = __shfl_up(igt, d), b = __shfl_up(ieq, d); if (F.lane >= d) { igt += a; ieq += b; } }
    if (F.lane == 63) { wtot[2 * F.wave] = igt; wtot[2 * F.wave + 1] = ieq; }
    LDS_WAIT(); __syncthreads();
    unsigned bgt = igt - ngt, beq = ieq - neq;
    for (int w = 0; w < F.wave; ++w) { bgt += wtot[2 * w]; beq += wtot[2 * w + 1]; }
    int* IDX = WSP(int, WS_IDX); float* GV = WSP(float, WS_GVAL); int* ENT = WSP(int, WS_ENT);
    for (int i = i0; i < i0 + per && i < n; ++i) { const unsigned k = keys[i];
        const bool sel = k > T || (k == T && (int)beq < kk);
        if (sel) { const int slot = (int)bgt + ((int)beq < kk ? (int)beq : kk); const int sr = slab_base + slot, tr = tokrow_base + i;
            IDX[sr] = tr; GV[sr] = __builtin_bit_cast(float, k); ENT[(size_t)tr * 16 + e] = sr; }
        bgt += k > T; beq += k == T; }
    __syncthreads();
}
__device__ __forceinline__ void s8_gather(Frame& F, bool do_ctx) {
    const int gw = F.wg * NWAVES + F.wave, NGW = F.G * NWAVES;
    const int* IDX = WSP(int, WS_IDX); const bf16* HX = HXP(); bf16* XE = WSP(bf16, WS_REGB);
    const int total = SLAB_L + (do_ctx ? NE * 128 : 0);
    for (int i = gw; i < total; i += NGW) {
        const int sr = i < SLAB_L ? i : SLAB_L + ((i - SLAB_L) >> 7) * 256 + ((i - SLAB_L) & 127);
        const int tr = IDX[sr];
        const v4u a = *(const v4u*)(HX + (size_t)tr * D + 8 * F.lane), b = *(const v4u*)(HX + (size_t)tr * D + 512 + 8 * F.lane);
        *(v4u*)(XE + (size_t)sr * D + 8 * F.lane) = a; *(v4u*)(XE + (size_t)sr * D + 512 + 8 * F.lane) = b; }
}
__device__ __forceinline__ void s11_finish_row(Frame& F, int l, int row, bf16* xr, f32x4 (&v)[4], const f32x4 (&acc)[4], bool last) {
    const float* MS = WSP(float, WS_MODS); const int s = row_set(row);
    const float* gate = MS + ((size_t)l * 5 + s) * 6144 + 5 * 1024;
#pragma unroll
    for (int j = 0; j < 4; ++j) v[j] += *(const f32x4*)(gate + ROWCOL(F.lane, j)) * acc[j];
    if (!last) {
        store_row8(xr, F.lane, v);
        const float* m = MS + ((size_t)(l + 1) * 5 + s) * 6144;
        norm_mod_store8(v, INP(I_GN1) + (l + 1) * 1024, m, m + 1024, HXP() + (size_t)row * D, F.lane);
    } else {
        float ss = 0.f;
#pragma unroll
        for (int j = 0; j < 4; ++j) ss += (v[j].x * v[j].x + v[j].y * v[j].y) + (v[j].z * v[j].z + v[j].w * v[j].w);
        const float rstd = rsq_(wave_sum_fast(ss) * (1.0f / D) + EPS);
#pragma unroll
        for (int j = 0; j < 4; ++j) *(f32x4*)(OUTP() + (size_t)row * D + ROWCOL(F.lane, j)) = v[j] * rstd * *(const f32x4*)(INP(I_GF) + ROWCOL(F.lane, j));
    }
}
__device__ __forceinline__ void s11_combine(Frame& F, int l, bool do_ctx, bool last) {
    const int gw = F.wg * NWAVES + F.wave, NGW = F.G * NWAVES;
    const bf16* YS = WSP(bf16, WS_REGB); const int* ENT = WSP(int, WS_ENT); bf16* XB = XBP();
    const int npairs = (do_ctx ? NROW : NLAT) / 2;
    v4u ra_[2], rb_[2]; int ent = -1;
    if (gw < npairs) { const bf16* xr = XB + (size_t)(2 * gw) * D;
#pragma unroll
        for (int h = 0; h < 2; ++h) { ra_[h] = *(const v4u*)(xr + 8 * F.lane + 512 * h); rb_[h] = *(const v4u*)(xr + D + 8 * F.lane + 512 * h); }
        ent = F.lane < 32 ? ENT[(size_t)(2 * gw) * 16 + F.lane] : -1; }
    for (int rp = gw; rp < npairs; rp += NGW) {
        const int ra = 2 * rp; bf16* xa = XB + (size_t)ra * D; bf16* xb = xa + D;
        f32x4 aa[4], ab[4]; v4u na_[2], nb_[2]; int nent = -1; const bool more = rp + NGW < npairs;
#pragma unroll
        for (int j = 0; j < 4; ++j) { aa[j] = (f32x4){0.f, 0.f, 0.f, 0.f}; ab[j] = (f32x4){0.f, 0.f, 0.f, 0.f}; }
        if (more) { const int rn = 2 * (rp + NGW); const bf16* xr = XB + (size_t)rn * D;
#pragma unroll
            for (int h = 0; h < 2; ++h) { na_[h] = *(const v4u*)(xr + 8 * F.lane + 512 * h); nb_[h] = *(const v4u*)(xr + D + 8 * F.lane + 512 * h); }
            nent = F.lane < 32 ? ENT[(size_t)rn * 16 + F.lane] : -1; }
        const unsigned long long bm = __ballot(ent >= 0);
        unsigned ma = (unsigned)bm & 0xffffu, mb = ((unsigned)bm >> 16) & 0xffffu;
        do {
            int sa[4], sb[4]; float wa[4], wb[4];
#pragma unroll
            for (int j = 0; j < 4; ++j) {
                if (ma) { const int e = __builtin_ctz(ma); ma &= ma - 1; sa[j] = __builtin_amdgcn_readlane(ent, e); wa[j] = 1.f; } else { sa[j] = 0; wa[j] = 0.f; }
                if (mb) { const int e = __builtin_ctz(mb); mb &= mb - 1; sb[j] = __builtin_amdgcn_readlane(ent, 16 + e); wb[j] = 1.f; } else { sb[j] = 0; wb[j] = 0.f; } }
            v4u ya[4][2], yb[4][2];
#pragma unroll
            for (int j = 0; j < 4; ++j)
#pragma unroll
                for (int h = 0; h < 2; ++h) { ya[j][h] = *(const v4u*)(YS + (size_t)sa[j] * D + 8 * F.lane + 512 * h); yb[j][h] = *(const v4u*)(YS + (size_t)sb[j] * D + 8 * F.lane + 512 * h); }
#pragma unroll
            for (int j = 0; j < 4; ++j)
#pragma unroll
                for (int h = 0; h < 2; ++h) {
                    aa[2 * h].x += wa[j] * bf2f(ya[j][h].x & 0xffffu); aa[2 * h].y += wa[j] * bf2f(ya[j][h].x >> 16); aa[2 * h].z += wa[j] * bf2f(ya[j][h].y & 0xffffu); aa[2 * h].w += wa[j] * bf2f(ya[j][h].y >> 16);
                    aa[2 * h + 1].x += wa[j] * bf2f(ya[j][h].z & 0xffffu); aa[2 * h + 1].y += wa[j] * bf2f(ya[j][h].z >> 16); aa[2 * h + 1].z += wa[j] * bf2f(ya[j][h].w & 0xffffu); aa[2 * h + 1].w += wa[j] * bf2f(ya[j][h].w >> 16);
                    ab[2 * h].x += wb[j] * bf2f(yb[j][h].x & 0xffffu); ab[2 * h].y += wb[j] * bf2f(yb[j][h].x >> 16); ab[2 * h].z += wb[j] * bf2f(yb[j][h].y & 0xffffu); ab[2 * h].w += wb[j] * bf2f(yb[j][h].y >> 16);
                    ab[2 * h + 1].x += wb[j] * bf2f(yb[j][h].z & 0xffffu); ab[2 * h + 1].y += wb[j] * bf2f(yb[j][h].z >> 16); ab[2 * h + 1].z += wb[j] * bf2f(yb[j][h].w & 0xffffu); ab[2 * h + 1].w += wb[j] * bf2f(yb[j][h].w >> 16); }
        } while (ma | mb);
        f32x4 va[4], vb[4];
#pragma unroll
        for (int h = 0; h < 2; ++h) {
            va[2 * h] = (f32x4){bf2f(ra_[h].x & 0xffffu), bf2f(ra_[h].x >> 16), bf2f(ra_[h].y & 0xffffu), bf2f(ra_[h].y >> 16)}; va[2 * h + 1] = (f32x4){bf2f(ra_[h].z & 0xffffu), bf2f(ra_[h].z >> 16), bf2f(ra_[h].w & 0xffffu), bf2f(ra_[h].w >> 16)};
            vb[2 * h] = (f32x4){bf2f(rb_[h].x & 0xffffu), bf2f(rb_[h].x >> 16), bf2f(rb_[h].y & 0xffffu), bf2f(rb_[h].y >> 16)}; vb[2 * h + 1] = (f32x4){bf2f(rb_[h].z & 0xffffu), bf2f(rb_[h].z >> 16), bf2f(rb_[h].w & 0xffffu), bf2f(rb_[h].w >> 16)}; }
        s11_finish_row(F, l, ra, xa, va, aa, last);
        s11_finish_row(F, l, ra + 1, xb, vb, ab, last);
        if (more) { ent = nent;
#pragma unroll
            for (int h = 0; h < 2; ++h) { ra_[h] = na_[h]; rb_[h] = nb_[h]; } }
    }
}

constexpr int N_PHASES = 26;
#define PH_IN(k) (lo <= (k) && (k) < hi)
#define PH_SEAM(k) do { if ((k) + 1 < hi) xcd_barrier(bar); } while (0)
#ifndef DUP_PHASE
#define DUP_PHASE (-1)
#endif
#ifndef DUP_N
#define DUP_N 1
#endif
#define PH_BEGIN(k) if (PH_IN(k)) { for (int rep_ = 0; rep_ < ((k) == DUP_PHASE ? DUP_N : 1); ++rep_) { if (rep_) xcd_barrier(bar); relaunder(F);
#define PH_END(k) } PH_SEAM(k); }
template <int l> __device__ __forceinline__ void layer_steps(Frame& F, const Args& args, const XcdBarrier& bar, const int lo, const int hi) {
    constexpr int P0 = l == 0 ? 3 : 15;
    constexpr bool last = l == 1, do_ctx = !last;
    PH_BEGIN(P0 + 0)
        pg8::Gemm g{(pg8::bf16_t*)HXP(), WSP(pg8::bf16_t, WS_WIN) + (size_t)l * INC * 1024, NROW, INC, D, nullptr};
        pg8::StaticOrder S; S.init(NROW, INC, F.G, F.wg);
        pg8::EpiInProj E{WSP(pg8::bf16_t, WS_REGA), PXC};
        pg8::gemm_phase<pg8::EpiInProj, pg8::StaticOrder, true, true>(F.lds, g, S, E);
        PH_END(P0 + 0)
    PH_BEGIN(P0 + 1)
        for (int u = F.wg; u < NB * 64; u += F.G) dft1_unit(F, u >> 6, u & 63);
        lru_a_phase(F, l);
        if (F.wg >= 32) filler(F, 1, -1);
        PH_END(P0 + 1)
    PH_BEGIN(P0 + 2)
        if (F.wg >= 192) s3_carries(F, (F.wg - 192) * NWAVES + F.wave);
        { LAS bf16* t2l = (LAS bf16*)(F.lds + 67584);
          const bf16* T2 = WSP(bf16, WS_T2M);
          for (int i = F.tid; i < 64 * 16; i += NTHR) { const int r = i >> 4, c = i & 15; *(LAS v4u*)(t2l + r * 136 + c * 8) = *(const v4u*)(T2 + r * 128 + c * 8); }
          LDS_WAIT(); __syncthreads();
          if (do_ctx && F.wg < 16) { const int b = F.wg >> 2, mq = F.wg & 3;
              dft2_unit(F, l, WSP(bf16, WS_TCM), 512, 64 * mq, 4, WSP(bf16, WS_REGA) + (size_t)(NLAT + CTXL * b) * PXC + PX_Z, PXC, (size_t)64 * PXC, 0.0078125f, NLAT + CTXL * b + 64 * mq, 1, nullptr);
          } else { const int w0 = do_ctx ? 16 : 0, nw = F.G - w0;
              for (int u = F.wg - w0; u < NB * 128; u += nw) { const int b = u >> 7, kp = u & 127;
                  dft2_unit(F, l, WSP(bf16, WS_T2M), 128, 0, 1, WSP(bf16, WS_T1) + (size_t)(b * 128 + kp) * 64 * 512, 512, 0, 0.001381067932004976f, b * SEQ + kp, 128, t2l); } } }
        PH_END(P0 + 2)
    PH_BEGIN(P0 + 3)
        const int nc = do_ctx ? NCHUNK : 512;
        if (do_ctx) sc_phase(F, l, nc, 16, F.G - 16); else sc_phase(F, l, nc, 0, F.G);
        lru_b_phase(F, l, nc);
        if (do_ctx && F.wg >= 16) filler(F, 2, -1);
        PH_END(P0 + 3)
    PH_BEGIN(P0 + 4)
        pg8::Gemm g{WSP(pg8::bf16_t, WS_Y), WSP(pg8::bf16_t, WS_WOUT) + (size_t)l * 1024 * 1024, NLAT, D, D, nullptr};
        pg8::StaticOrder S; S.init(NLAT, D, F.G, F.wg);
        pg8::EpiResid E{INP(I_X), INP(I_CTX), (pg8::bf16_t*)XBP(), WSP(float, WS_MODS) + (size_t)l * 5 * 6144 + 2 * 1024, NLAT, l == 0};
        pg8::gemm_phase<pg8::EpiResid, pg8::StaticOrder, true, true>(F.lds, g, S, E);
        PH_END(P0 + 4)
    PH_BEGIN(P0 + 5)
        if (do_ctx) {
            int* IDX = WSP(int, WS_IDX); for (int i = F.wg * NTHR + F.tid; i < NE * 256; i += F.G * NTHR) IDX[SLAB_L + i] = NLAT;
            if (F.wg < 16) {
                pg8::Gemm g{WSP(pg8::bf16_t, WS_Y), WSP(pg8::bf16_t, WS_WOUT) + (size_t)l * 1024 * 1024, NROW, D, D, nullptr};
                pg8::CtxOrder S{F.wg};
                pg8::EpiResid E{INP(I_X), INP(I_CTX), (pg8::bf16_t*)XBP(), WSP(float, WS_MODS) + (size_t)l * 5 * 6144 + 2 * 1024, NLAT, l == 0};
                pg8::gemm_phase<pg8::EpiResid, pg8::CtxOrder, true, true>(F.lds, g, S, E);
                VM_WAIT(); __syncthreads();
                if (F.tid == 0) { unsigned* ctr = WSP(unsigned, WS_CTL) + 192 + 64 * l;
                    __builtin_amdgcn_fence(__ATOMIC_RELEASE, "agent"); VM_WAIT();
                    __hip_atomic_fetch_add(ctr, 1u, __ATOMIC_RELAXED, __HIP_MEMORY_SCOPE_AGENT);
                    unsigned sp = 0; while (__hip_atomic_load(ctr, __ATOMIC_RELAXED, __HIP_MEMORY_SCOPE_AGENT) < 16u && ++sp < (1u << 22)) __builtin_amdgcn_s_sleep(2);
                    __builtin_amdgcn_fence(__ATOMIC_ACQUIRE, "agent"); VM_WAIT(); }
                __syncthreads();
                relaunder(F);
                s6_norm2_router(F, l, NLAT / 2, NROW / 2, F.wg * NWAVES + F.wave, 16 * NWAVES);
            } else s6_norm2_router(F, l, 0, NLAT / 2, (F.wg - 16) * NWAVES + F.wave, (F.G - 16) * NWAVES);
        } else s6_norm2_router(F, l, 0, NLAT / 2, F.wg * NWAVES + F.wave, F.G * NWAVES);
        PH_END(P0 + 5)
    PH_BEGIN(P0 + 6)
        const int np = do_ctx ? 128 : 64;
        if (F.wg >= np) filler(F, 4, -1);
        for (int p = F.wg; p < np; p += F.G) {
            if (p < 64) { const int b = p >> 4, e = p & 15; s7_topk_problem(F, WSP(float, WS_AFFL) + (size_t)p * SEQ, SEQ, CAP_L, (b * 16 + e) * CAP_L, b * SEQ, e); }
            else { const int q = p - 64, b = q >> 4, e = q & 15; s7_topk_problem(F, WSP(float, WS_AFFC) + (size_t)q * CTXL, CTXL, CAP_C, SLAB_L + e * 256 + b * CAP_C, NLAT + b * CTXL, e); } }
        filler(F, 0, l);
        PH_END(P0 + 6)
    PH_BEGIN(P0 + 8)
        pg8::Gemm g{(pg8::bf16_t*)HXP(), WSP(pg8::bf16_t, WS_WGU + (size_t)l * WS_WEXP_L), SLAB_ROWS, NE * 2048, D, WSP(int, WS_IDX)};
        pg8::MoeOrder1 S{F.wg, do_ctx};
        pg8::EpiSwiGLU E{WSP(pg8::bf16_t, WS_REGA), D};
        pg8::gemm_phase<pg8::EpiSwiGLU, pg8::MoeOrder1, true, true, true>(F.lds, g, S, E);
        if (do_ctx && F.wg >= 128) filler(F, 5, -1);
        PH_END(P0 + 8)
    PH_BEGIN(P0 + 9)
        pg8::Gemm g{WSP(pg8::bf16_t, WS_REGA), WSP(pg8::bf16_t, WS_WD + (size_t)l * WS_WEXP_L), SLAB_ROWS, NE * 1024, D, nullptr};
        pg8::MoeOrder2 S{F.wg, do_ctx};
        pg8::EpiScaleBf16 E{WSP(pg8::bf16_t, WS_REGB), D, WSP(float, WS_GVAL)};
        pg8::gemm_phase<pg8::EpiScaleBf16, pg8::MoeOrder2, true, true>(F.lds, g, S, E);
        if (do_ctx && F.wg >= 64) filler(F, 4, -1);
        PH_END(P0 + 9)
    PH_BEGIN(P0 + 10) s11_combine(F, l, do_ctx, last); PH_END(P0 + 10)
}
__global__ void __launch_bounds__(NTHR, 2) fwd(Args args) {
    extern __shared__ __attribute__((aligned(16))) unsigned char lds_raw[];
    Frame F;
    F.lds = (LAS unsigned char*)lds_raw;
    F.tid = threadIdx.x; F.lane = F.tid & 63; F.wave = __builtin_amdgcn_readfirstlane(F.tid >> 6);
    F.G = gridDim.x; F.wg = blockIdx.x;
    volatile LAS unsigned* MISC = (volatile LAS unsigned*)(F.lds + MISC_OFF);
    if (F.tid < 64) MISC[F.tid] = 0u;
    if (F.tid == 0) { LAS unsigned long long* PT = (LAS unsigned long long*)(F.lds + PT_OFF);
#pragma unroll
        for (int i = 0; i < N_IN; ++i) PT[i] = (unsigned long long)args.in[i];
        PT[N_IN] = (unsigned long long)args.out; PT[N_IN + 1] = (unsigned long long)args.ws; }
    LDS_WAIT(); __syncthreads();
    const int lo = args.ph_lo, hi = args.ph_hi;
    unsigned* barw = (unsigned*)(args.ws + WS_CTL) + CW_BAR + args.bar_region * XCD_BAR_WORDS;
    XcdBarrier bar; bar.bar = barw; bar.x = 0; bar.st = MISC + 8;
    if (hi - lo > 1) bar = xcd_barrier_post(barw, MISC + 8);
    PH_BEGIN(0) p0_prep(F); PH_END(0)
    PH_BEGIN(1) p0b_mods(F); PH_END(1)
    PH_BEGIN(2) s0_norm1(F); PH_END(2)
    layer_steps<0>(F, args, bar, lo, hi);
    layer_steps<1>(F, args, bar, lo, hi);
}

extern "C" void kernel_launch(void* const* d_in, const int* in_sizes, int n_in, void* d_out, int out_size, void* d_ws, size_t ws_size, hipStream_t stream) {
    static int grid = 0;
    if (grid == 0) {
        if (n_in != N_IN || out_size != NLAT * D || ws_size < WS_END) { fprintf(stderr, "kernel_launch: unexpected shapes (n_in %d, out %d, ws %zu, need %zu)\n", n_in, out_size, ws_size, (size_t)WS_END); grid = -1; return; }
        int dev = 0, cus = 0, per_cu = 0;
        if (hipGetDevice(&dev) != hipSuccess || hipDeviceGetAttribute(&cus, hipDeviceAttributeMultiprocessorCount, dev) != hipSuccess) { grid = -1; return; }
        if (hipFuncSetAttribute((const void*)fwd, hipFuncAttributeMaxDynamicSharedMemorySize, LDS_BYTES) != hipSuccess) { fprintf(stderr, "kernel_launch: hipFuncSetAttribute failed\n"); grid = -1; return; }
        if (hipOccupancyMaxActiveBlocksPerMultiprocessor(&per_cu, (const void*)fwd, NTHR, LDS_BYTES) != hipSuccess || per_cu < 1) { fprintf(stderr, "kernel_launch: occupancy query says %d\n", per_cu); }
        (void)hipGetLastError();
        grid = cus;
        if (grid != 256) { fprintf(stderr, "kernel_launch: needs a 256-CU device (got %d)\n", grid); grid = -1; return; }
    }
    if (grid < 0) return;
    (void)hipMemsetAsync((char*)d_ws + WS_CTL, 0, CTL_ZERO_BYTES, stream);
    Args a{};
    for (int i = 0; i < N_IN; ++i) a.in[i] = (const float*)d_in[i];
    a.out = (float*)d_out; a.ws = (unsigned char*)d_ws;
#ifndef ONE_LAUNCH
#define ONE_LAUNCH 1
#endif
#ifndef PROBE_K
#define PROBE_K (-1)
#endif
#ifndef PROBE_N
#define PROBE_N 1
#endif
    if (PROBE_K >= 0) {
        a.ph_lo = 0; a.ph_hi = PROBE_K + 1; a.bar_region = 0; hipLaunchKernelGGL(fwd, dim3(grid), dim3(NTHR), LDS_BYTES, stream, a);
        for (int r = 1; r < PROBE_N; ++r) { a.ph_lo = PROBE_K; a.ph_hi = PROBE_K + 1; hipLaunchKernelGGL(fwd, dim3(grid), dim3(NTHR), LDS_BYTES, stream, a); }
        if (PROBE_K + 1 < N_PHASES) { a.ph_lo = PROBE_K + 1; a.ph_hi = N_PHASES; a.bar_region = 1; hipLaunchKernelGGL(fwd, dim3(grid), dim3(NTHR), LDS_BYTES, stream, a); }
    } else if (ONE_LAUNCH) { a.ph_lo = 0; a.ph_hi = N_PHASES; hipLaunchKernelGGL(fwd, dim3(grid), dim3(NTHR), LDS_BYTES, stream, a); }
    else for (int ph = 0; ph < N_PHASES; ++ph) { a.ph_lo = ph; a.ph_hi = ph + 1; hipLaunchKernelGGL(fwd, dim3(grid), dim3(NTHR), LDS_BYTES, stream, a); }
}
```

```cpp
#include <hip/hip_runtime.h>
#include <cstdio>
#include <cstdint>
#define LAS __attribute__((address_space(3)))
namespace pg8 {
#define PG8_LAS __attribute__((address_space(3)))
typedef unsigned short bf16_t;
typedef short bf16x8 __attribute__((ext_vector_type(8)));
typedef float f32x4 __attribute__((ext_vector_type(4)));
typedef unsigned u32x4 __attribute__((ext_vector_type(4)));
constexpr int BM = 256, BK = 64, HALF = 128, HTB = HALF * BK * 2  , STAGE_BYTES = 8 * HTB, NXCD = 8, WGM = 8;

__host__ __device__ __forceinline__ int lds_byte(int r, int c) { const int st = (r >> 4) * 2 + (c >> 5), rr = r & 15, cc = c & 31, ob = rr * 64 + cc * 2; return st * 1024 + (ob ^ (((ob >> 9) & 1) << 5)); }
__host__ __device__ __forceinline__ void stage_rc(int b, int& R, int& C) { const int st = b / 1024, sb = b % 1024, swz = sb ^ (((sb >> 9) & 1) << 5); R = (st >> 1) * 16 + swz / 64; C = (st & 1) * 32 + (swz % 64) / 2; }
__host__ __device__ __forceinline__ int perm32(int rho) { const int n = rho >> 4, i = rho & 15; return 8 * (i >> 2) + 4 * n + (i & 3); }

struct Unit { int pm, pn; };
struct Gemm { const bf16_t* A; const bf16_t* Bt; int M, N, K; const int* gidx; };

struct StaticOrder {
    int nM, nN, nwg, G, c;
    __host__ __device__ void init(int M, int N, int G_, int c_) { nM = M / BM; nN = N / BM; nwg = nM * nN; G = G_; c = c_; }
    __host__ __device__ bool next(int i, Unit& u) const {
        const long L = (long)i * G + c; if (L >= nwg) return false;
        int wgid = (int)L; { const int q = nwg / NXCD, r = nwg % NXCD, xcd = wgid % NXCD, off = wgid / NXCD; wgid = (xcd < r ? xcd * (q + 1) : r * (q + 1) + (xcd - r) * q) + off; }
        const int nig = WGM * nN, gid = wgid / nig, fm = gid * WGM, gsz = (nM - fm) < WGM ? (nM - fm) : WGM;
        u.pm = fm + ((wgid % nig) % gsz); u.pn = (wgid % nig) / gsz; return true;
    }
    __device__ __forceinline__ void a_ready(const Unit&) const {}
    __device__ __forceinline__ void done(const Unit&) const {}
};


__device__ __forceinline__ unsigned cvt_pk_bf16(float lo, float hi) { unsigned r; asm volatile("v_cvt_pk_bf16_f32 %0, %1, %2" : "=v"(r) : "v"(lo), "v"(hi)); return r; }

struct EpiBf16Plain {
    static constexpr bool PERM = true, AFTER_DRAIN = false;
    bf16_t* O; int ldc;
    __device__ __forceinline__ void operator()(const f32x4 (&acc)[2][2][4][2], const Unit& u, int wr, int wc, int fr, int fq) const {
        const int row0 = u.pm * BM + wr * 64 + fr; const int col0 = u.pn * BM + wc * 32 + 8 * fq;
#pragma unroll
        for (int ai = 0; ai < 2; ++ai)
#pragma unroll
            for (int m = 0; m < 4; ++m) { bf16_t* rowp = O + (size_t)(row0 + ai * HALF + m * 16) * ldc + col0;
#pragma unroll
                for (int bj = 0; bj < 2; ++bj) { const f32x4 v0 = acc[ai][bj][m][0], v1 = acc[ai][bj][m][1];
                    u32x4 w; w.x = cvt_pk_bf16(v0[0], v0[1]); w.y = cvt_pk_bf16(v0[2], v0[3]); w.z = cvt_pk_bf16(v1[0], v1[1]); w.w = cvt_pk_bf16(v1[2], v1[3]);
                    *(u32x4*)(rowp + bj * HALF) = w; } }
    }
};
struct EpiInProj {
    static constexpr bool PERM = true, AFTER_DRAIN = false;
    bf16_t* O; int ldc;
    __device__ __forceinline__ void operator()(const f32x4 (&acc)[2][2][4][2], const Unit& u, int wr, int wc, int fr, int fq) const {
        const int row0 = u.pm * BM + wr * 64 + fr;
        if (u.pn == 5 || u.pn == 6) { const int col0 = 1280 + (u.pn - 5) * HALF + wc * 32 + 8 * fq;
#pragma unroll
            for (int ai = 0; ai < 2; ++ai)
#pragma unroll
                for (int m = 0; m < 4; ++m) { const f32x4 v0 = acc[ai][0][m][0] * acc[ai][1][m][0], v1 = acc[ai][0][m][1] * acc[ai][1][m][1];
                    u32x4 w; w.x = cvt_pk_bf16(v0[0], v0[1]); w.y = cvt_pk_bf16(v0[2], v0[3]); w.z = cvt_pk_bf16(v1[0], v1[1]); w.w = cvt_pk_bf16(v1[2], v1[3]);
                    *(u32x4*)(O + (size_t)(row0 + ai * HALF + m * 16) * ldc + col0) = w; }
        } else { const int col0 = (u.pn < 5 ? u.pn : u.pn - 1) * BM + wc * 32 + 8 * fq;
#pragma unroll
            for (int ai = 0; ai < 2; ++ai)
#pragma unroll
                for (int m = 0; m < 4; ++m) { bf16_t* rowp = O + (size_t)(row0 + ai * HALF + m * 16) * ldc + col0;
#pragma unroll
                    for (int bj = 0; bj < 2; ++bj) { const f32x4 v0 = acc[ai][bj][m][0], v1 = acc[ai][bj][m][1];
                        u32x4 w; w.x = cvt_pk_bf16(v0[0], v0[1]); w.y = cvt_pk_bf16(v0[2], v0[3]); w.z = cvt_pk_bf16(v1[0], v1[1]); w.w = cvt_pk_bf16(v1[2], v1[3]);
                        *(u32x4*)(rowp + bj * HALF) = w; } }
        }
    }
};
struct EpiSwiGLU {
    static constexpr bool PERM = true, AFTER_DRAIN = false;
    bf16_t* H; int ldc;
    __device__ __forceinline__ void operator()(const f32x4 (&acc)[2][2][4][2], const Unit& u, int wr, int wc, int fr, int fq) const {
        const int row0 = u.pm * BM + wr * 64 + fr; const int col0 = (u.pn & 7) * HALF + wc * 32 + 8 * fq;
#pragma unroll
        for (int ai = 0; ai < 2; ++ai)
#pragma unroll
            for (int m = 0; m < 4; ++m) { bf16_t* rowp = H + (size_t)(row0 + ai * HALF + m * 16) * ldc + col0;
                float o[8];
#pragma unroll
                for (int n = 0; n < 2; ++n)
#pragma unroll
                    for (int i = 0; i < 4; ++i) { const float g = acc[ai][0][m][n][i], up = acc[ai][1][m][n][i];
                        o[n * 4 + i] = g * __builtin_amdgcn_rcpf(1.0f + __expf(-g)) * up; }
                u32x4 w; w.x = cvt_pk_bf16(o[0], o[1]); w.y = cvt_pk_bf16(o[2], o[3]); w.z = cvt_pk_bf16(o[4], o[5]); w.w = cvt_pk_bf16(o[6], o[7]);
                *(u32x4*)rowp = w; }
    }
};
struct EpiScaleBf16 {
    static constexpr bool PERM = true, AFTER_DRAIN = false;
    bf16_t* Y; int ldc; const float* gval;
    __device__ __forceinline__ void operator()(const f32x4 (&acc)[2][2][4][2], const Unit& u, int wr, int wc, int fr, int fq) const {
        const int row0 = u.pm * BM + wr * 64 + fr; const int col0 = (u.pn & 3) * BM + wc * 32 + 8 * fq;
#pragma unroll
        for (int ai = 0; ai < 2; ++ai)
#pragma unroll
            for (int m = 0; m < 4; ++m) { const int row = row0 + ai * HALF + m * 16; const float g = gval[row]; bf16_t* rowp = Y + (size_t)row * ldc + col0;
#pragma unroll
                for (int bj = 0; bj < 2; ++bj) { const f32x4 v0 = acc[ai][bj][m][0] * g, v1 = acc[ai][bj][m][1] * g;
                    u32x4 w; w.x = cvt_pk_bf16(v0[0], v0[1]); w.y = cvt_pk_bf16(v0[2], v0[3]); w.z = cvt_pk_bf16(v1[0], v1[1]); w.w = cvt_pk_bf16(v1[2], v1[3]);
                    *(u32x4*)(rowp + bj * HALF) = w; } }
    }
};
struct EpiResid {
    static constexpr bool PERM = true, AFTER_DRAIN = false;
    const float* xin_lat; const float* xin_ctx; bf16_t* xb; const float* gate  ; int nlat; bool in_f32;
    __device__ __forceinline__ void operator()(const f32x4 (&acc)[2][2][4][2], const Unit& u, int wr, int wc, int fr, int fq) const {
        const int trow = u.pm * BM; const bool isctx = trow >= nlat;
        const int s = isctx ? 4 : (trow >> 13);
        const float* xin = isctx ? xin_ctx - (size_t)nlat * 1024 : xin_lat;
        const float* gp = gate + (size_t)s * 6144;
        const int row0 = trow + wr * 64 + fr, col0 = u.pn * BM + wc * 32 + 8 * fq;
        f32x4 gv[2][2];
#pragma unroll
        for (int bj = 0; bj < 2; ++bj)
#pragma unroll
            for (int n = 0; n < 2; ++n) gv[bj][n] = *(const f32x4*)(gp + col0 + bj * HALF + 4 * n);
#pragma unroll
        for (int ai = 0; ai < 2; ++ai)
#pragma unroll
            for (int m = 0; m < 4; ++m) { const size_t off = (size_t)(row0 + ai * HALF + m * 16) * 1024 + col0;
#pragma unroll
                for (int bj = 0; bj < 2; ++bj) { f32x4 x0, x1;
                    if (in_f32) { x0 = *(const f32x4*)(xin + off + bj * HALF); x1 = *(const f32x4*)(xin + off + bj * HALF + 4); }
                    else { const u32x4 w = *(const u32x4*)(xb + off + bj * HALF);
                        x0 = (f32x4){__builtin_bit_cast(float, w.x << 16), __builtin_bit_cast(float, w.x & 0xffff0000u), __builtin_bit_cast(float, w.y << 16), __builtin_bit_cast(float, w.y & 0xffff0000u)};
                        x1 = (f32x4){__builtin_bit_cast(float, w.z << 16), __builtin_bit_cast(float, w.z & 0xffff0000u), __builtin_bit_cast(float, w.w << 16), __builtin_bit_cast(float, w.w & 0xffff0000u)}; }
                    x0 += gv[bj][0] * acc[ai][bj][m][0]; x1 += gv[bj][1] * acc[ai][bj][m][1];
                    u32x4 o; o.x = cvt_pk_bf16(x0[0], x0[1]); o.y = cvt_pk_bf16(x0[2], x0[3]); o.z = cvt_pk_bf16(x1[0], x1[1]); o.w = cvt_pk_bf16(x1[2], x1[3]);
                    *(u32x4*)(xb + off + bj * HALF) = o; } }
    }
};
struct MoeOrder1 {
    int c; bool ctx;
    __device__ __forceinline__ bool next(int i, Unit& u) const {
        if (i < 8) { const int P = i * 8 + (c & 7), j = c >> 3, e = P >> 2, b = P & 3; u.pm = (b * 16 + e) * 4 + (j >> 3); u.pn = e * 8 + (j & 7); return true; }
        if (i == 8 && ctx && c < 128) { const int e = c >> 3; u.pm = 256 + e; u.pn = e * 8 + (c & 7); return true; }
        return false;
    }
    __device__ __forceinline__ void a_ready(const Unit&) const {}
    __device__ __forceinline__ void done(const Unit&) const {}
};
struct CtxOrder {
    int c;
    __device__ __forceinline__ bool next(int i, Unit& u) const { if (i != 0 || c >= 16) return false; u.pm = 128 + (c >> 2); u.pn = c & 3; return true; }
    __device__ __forceinline__ void a_ready(const Unit&) const {}
    __device__ __forceinline__ void done(const Unit&) const {}
};
struct MoeOrder2 {
    int c; bool ctx;
    __device__ __forceinline__ bool next(int i, Unit& u) const {
        if (i < 4) { const int j = c >> 3, P = i * 16 + (c & 7) * 2 + (j >> 4), e = P >> 2, b = P & 3; u.pm = (b * 16 + e) * 4 + ((j >> 2) & 3); u.pn = e * 4 + (j & 3); return true; }
        if (i == 4 && ctx && c < 64) { const int e = c >> 2; u.pm = 256 + e; u.pn = e * 4 + (c & 3); return true; }
        return false;
    }
    __device__ __forceinline__ void a_ready(const Unit&) const {}
    __device__ __forceinline__ void done(const Unit&) const {}
};

template <class Epi, class Sched, bool ALIGN_EPI = false, bool SP2 = false, bool GATHER = false, int HALF_FROM_PM = (1 << 30)>
__device__ __forceinline__ void gemm_phase(PG8_LAS unsigned char* lds, const Gemm g, const Sched& S, const Epi& E) {
    const int tid = threadIdx.x, wid = __builtin_amdgcn_readfirstlane(tid >> 6), lane = tid & 63, wr = wid >> 2, wc = wid & 3, fr = lane & 15, fq = lane >> 4;
    const int K = g.K, nt = K / BK;
    unsigned voffA[2], voffB[2]; int rowA[2]; unsigned colA2[2];
#pragma unroll
    for (int i = 0; i < 2; ++i) { int R, C; stage_rc(tid * 16 + i * 8192, R, C); const int Rb = Epi::PERM ? ((R & ~31) + perm32(R & 31)) : R;
        voffA[i] = (unsigned)(R * K + C) * 2u; voffB[i] = (unsigned)(Rb * K + C) * 2u; rowA[i] = R; colA2[i] = (unsigned)C * 2u; }
    unsigned gA[2][2], gN[2][2], gS[2][2], gRaw[2][2];
#define PG8_VA(h) (GATHER ? gA[h] : voffA)
#define PG8_VS(h) (GATHER ? gS[h] : voffA)
#define PG8_IDX_ISSUE(u) do { _Pragma("unroll") for (int _h = 0; _h < 2; ++_h) _Pragma("unroll") for (int _i = 0; _i < 2; ++_i) { const int* _p = g.gidx + (u).pm * BM + _h * HALF + rowA[_i]; \
        asm volatile("global_load_dword %0, %1, off" : "=v"(gRaw[_h][_i]) : "v"(_p) : "memory"); } } while (0)
#define PG8_IDX_TAKE(dst) do { _Pragma("unroll") for (int _h = 0; _h < 2; ++_h) _Pragma("unroll") for (int _i = 0; _i < 2; ++_i) { asm volatile("" : "+v"(gRaw[_h][_i])); dst[_h][_i] = gRaw[_h][_i] * (unsigned)(K * 2) + colA2[_i]; } } while (0)
    const size_t kstep = (size_t)(BK * 2);
    const size_t hstep = (size_t)HALF * K * 2;
    const size_t hstepA = GATHER ? 0 : hstep;
    const size_t tstep = 2 * hstep;
    const unsigned ldsw = (unsigned)wid * 1024u;
    const int aoff = lds_byte(wr * 64 + fr, fq * 8), boff = lds_byte(wc * 32 + fr, fq * 8);
#define PG8_SA(b, h) (((b) * 2 + (h)) * HTB)
#define PG8_SB(b, h) ((4 + (b) * 2 + (h)) * HTB)
#define PG8_STAGE(bufoff, gbase, voff) do { _Pragma("unroll") for (int _i = 0; _i < 2; ++_i) \
        __builtin_amdgcn_global_load_lds((const unsigned*)((const char*)(gbase) + (voff)[_i]), (PG8_LAS unsigned*)(lds + (bufoff) + ldsw + _i * 8192), 16, 0, 0); } while (0)
#define PG8_LDA(dst, b, h) do { _Pragma("unroll") for (int m = 0; m < 4; ++m) _Pragma("unroll") for (int k = 0; k < 2; ++k) dst[m][k] = *(const PG8_LAS bf16x8*)(lds + PG8_SA(b, h) + aoff + m * 2048 + k * 1024); } while (0)
#define PG8_LDB(dst, b, h) do { _Pragma("unroll") for (int n = 0; n < 2; ++n) _Pragma("unroll") for (int k = 0; k < 2; ++k) dst[n][k] = *(const PG8_LAS bf16x8*)(lds + PG8_SB(b, h) + boff + n * 2048 + k * 1024); } while (0)
#define PG8_MMA(ai, bj, At, Bt) do { __builtin_amdgcn_s_setprio(1); _Pragma("unroll") for (int m = 0; m < 4; ++m) _Pragma("unroll") for (int n = 0; n < 2; ++n) _Pragma("unroll") for (int k = 0; k < 2; ++k) \
        acc[ai][bj][m][n] = __builtin_amdgcn_mfma_f32_16x16x32_bf16(Bt[n][k], At[m][k], acc[ai][bj][m][n], 0, 0, 0); __builtin_amdgcn_s_setprio(0); } while (0)
#define PG8_WAIT_V(n) asm volatile("s_waitcnt vmcnt(" #n ")" ::: "memory")
#define PG8_WAIT_L(n) asm volatile("s_waitcnt lgkmcnt(" #n ")" ::: "memory")
#define PG8_BAR __builtin_amdgcn_s_barrier()
#define PG8_SCHED __builtin_amdgcn_sched_barrier(0)
    Unit cur, nxt; int ui = 0;
    if (!S.next(0, cur)) return;
    f32x4 acc[2][2][4][2];
#pragma unroll
    for (int a = 0; a < 2; ++a)
#pragma unroll
        for (int b = 0; b < 2; ++b)
#pragma unroll
            for (int m = 0; m < 4; ++m)
#pragma unroll
                for (int n = 0; n < 2; ++n) acc[a][b][m][n] = (f32x4){0.f, 0.f, 0.f, 0.f};
    bf16x8 At[4][2], B0[2][2], B1[2][2];
    const char* cA = (const char*)g.A + (GATHER ? (size_t)0 : (size_t)cur.pm * tstep); const char* cB = (const char*)g.Bt + (size_t)cur.pn * tstep;
    S.a_ready(cur);
    if constexpr (GATHER) { PG8_IDX_ISSUE(cur); asm volatile("s_waitcnt vmcnt(0)" ::: "memory"); PG8_IDX_TAKE(gA); }
    if constexpr (SP2) {
        PG8_STAGE(PG8_SB(0, 0), cB, voffB); PG8_STAGE(PG8_SB(0, 1), cB + hstep, voffB); PG8_STAGE(PG8_SA(0, 0), cA, PG8_VA(0)); PG8_STAGE(PG8_SA(0, 1), cA + hstepA, PG8_VA(1));
        if (wr == 1) PG8_BAR;
        PG8_WAIT_V(2); PG8_BAR;
        PG8_STAGE(PG8_SB(1, 0), cB + kstep, voffB); PG8_STAGE(PG8_SA(1, 0), cA + kstep, PG8_VA(0)); PG8_STAGE(PG8_SB(1, 1), cB + hstep + kstep, voffB);
        PG8_WAIT_V(6); PG8_BAR;
    } else {
        PG8_STAGE(PG8_SB(0, 0), cB, voffB); PG8_STAGE(PG8_SA(0, 0), cA, PG8_VA(0)); PG8_STAGE(PG8_SB(0, 1), cB + hstep, voffB); PG8_STAGE(PG8_SA(0, 1), cA + hstepA, PG8_VA(1));
        if (wr == 1) PG8_BAR;
        PG8_WAIT_V(4); PG8_BAR;
        PG8_STAGE(PG8_SB(1, 0), cB + kstep, voffB); PG8_STAGE(PG8_SA(1, 0), cA + kstep, PG8_VA(0)); PG8_STAGE(PG8_SB(1, 1), cB + hstep + kstep, voffB);
        PG8_WAIT_V(6); PG8_BAR;
    }
    for (;;) {
        const bool has_next = S.next(ui + 1, nxt);
        const char* nA = (has_next && !GATHER) ? (const char*)g.A + (size_t)nxt.pm * tstep : cA; const char* nB = has_next ? (const char*)g.Bt + (size_t)nxt.pn * tstep : cB;
        if constexpr (GATHER) { if (has_next) PG8_IDX_ISSUE(nxt); }
        for (int t = 0; t < nt; t += 2) {
            const bool last = (t == nt - 2);
            const char* a1 = cA + (size_t)(t + 1) * kstep;
            const char* a2 = last ? nA : cA + (size_t)(t + 2) * kstep; const char* b2 = last ? nB : cB + (size_t)(t + 2) * kstep;
            const char* a3 = a2 + kstep; const char* b3 = b2 + kstep;
            if (last && has_next) S.a_ready(nxt);
            if constexpr (GATHER) { if (last) { if (has_next) PG8_IDX_TAKE(gN); else { _Pragma("unroll") for (int _h = 0; _h < 2; ++_h) _Pragma("unroll") for (int _i = 0; _i < 2; ++_i) gN[_h][_i] = gA[_h][_i]; } }
                _Pragma("unroll") for (int _h = 0; _h < 2; ++_h) _Pragma("unroll") for (int _i = 0; _i < 2; ++_i) gS[_h][_i] = last ? gN[_h][_i] : gA[_h][_i]; }
            if constexpr (SP2) {
            PG8_LDB(B0, 0, 0); PG8_LDB(B1, 0, 1); PG8_SCHED; PG8_LDA(At, 0, 0); PG8_STAGE(PG8_SA(1, 1), a1 + hstepA, PG8_VA(1));
            PG8_WAIT_V(8); PG8_WAIT_L(0); PG8_BAR; PG8_MMA(0, 0, At, B0); PG8_MMA(0, 1, At, B1); PG8_BAR; PG8_SCHED;
            PG8_LDA(At, 0, 1); PG8_STAGE(PG8_SB(0, 0), b2, voffB); PG8_STAGE(PG8_SB(0, 1), b2 + hstep, voffB); PG8_STAGE(PG8_SA(0, 0), a2, PG8_VS(0));
            PG8_WAIT_V(8); PG8_WAIT_L(0); PG8_BAR; if (HALF_FROM_PM == (1 << 30) || cur.pm < HALF_FROM_PM) { PG8_MMA(1, 0, At, B0); PG8_MMA(1, 1, At, B1); } PG8_BAR; PG8_SCHED;
            PG8_LDB(B0, 1, 0); PG8_LDB(B1, 1, 1); PG8_SCHED; PG8_LDA(At, 1, 0); PG8_STAGE(PG8_SA(0, 1), a2 + hstepA, PG8_VS(1));
            PG8_WAIT_V(8); PG8_WAIT_L(0); PG8_BAR; PG8_MMA(0, 0, At, B0); PG8_MMA(0, 1, At, B1); PG8_BAR; PG8_SCHED;
            PG8_LDA(At, 1, 1); PG8_STAGE(PG8_SB(1, 0), b3, voffB); PG8_STAGE(PG8_SB(1, 1), b3 + hstep, voffB); PG8_STAGE(PG8_SA(1, 0), a3, PG8_VS(0));
            PG8_WAIT_V(8); PG8_WAIT_L(0); PG8_BAR; if (HALF_FROM_PM == (1 << 30) || cur.pm < HALF_FROM_PM) { PG8_MMA(1, 0, At, B0); PG8_MMA(1, 1, At, B1); } PG8_BAR; PG8_SCHED;
            } else {
            PG8_LDB(B0, 0, 0); PG8_SCHED; PG8_LDA(At, 0, 0); PG8_STAGE(PG8_SA(1, 1), a1 + hstepA, PG8_VA(1));
            PG8_WAIT_L(8); PG8_BAR; PG8_WAIT_L(0); PG8_MMA(0, 0, At, B0); PG8_BAR; PG8_SCHED;
            PG8_LDB(B1, 0, 1); PG8_STAGE(PG8_SB(0, 0), b2, voffB);
            PG8_BAR; PG8_WAIT_L(0); PG8_MMA(0, 1, At, B1); PG8_BAR;
            PG8_LDA(At, 0, 1); PG8_STAGE(PG8_SA(0, 0), a2, PG8_VS(0));
            PG8_BAR; PG8_WAIT_L(0); PG8_MMA(1, 0, At, B0); PG8_BAR; PG8_SCHED;
            PG8_STAGE(PG8_SB(0, 1), b2 + hstep, voffB);
            PG8_WAIT_V(6); PG8_BAR; PG8_MMA(1, 1, At, B1); PG8_BAR;
            PG8_LDB(B0, 1, 0); PG8_SCHED; PG8_LDA(At, 1, 0); PG8_STAGE(PG8_SA(0, 1), a2 + hstepA, PG8_VS(1));
            PG8_WAIT_L(8); PG8_BAR; PG8_WAIT_L(0); PG8_MMA(0, 0, At, B0); PG8_BAR; PG8_SCHED;
            PG8_LDB(B1, 1, 1); PG8_STAGE(PG8_SB(1, 0), b3, voffB);
            PG8_BAR; PG8_WAIT_L(0); PG8_MMA(0, 1, At, B1); PG8_BAR;
            PG8_LDA(At, 1, 1); PG8_STAGE(PG8_SA(1, 0), a3, PG8_VS(0));
            PG8_BAR; PG8_WAIT_L(0); PG8_MMA(1, 0, At, B0); PG8_BAR; PG8_SCHED;
            PG8_STAGE(PG8_SB(1, 1), b3 + hstep, voffB);
            PG8_WAIT_V(6); PG8_BAR; PG8_MMA(1, 1, At, B1); PG8_BAR;
            }
        }
        if constexpr (ALIGN_EPI) { if (wr == 0) PG8_BAR; }
        if constexpr (!Epi::AFTER_DRAIN) { E(acc, cur, wr, wc, fr, fq); S.done(cur); }
        if (!has_next) break;
#pragma unroll
        for (int a = 0; a < 2; ++a)
#pragma unroll
            for (int b = 0; b < 2; ++b)
#pragma unroll
                for (int m = 0; m < 4; ++m)
#pragma unroll
                    for (int n = 0; n < 2; ++n) acc[a][b][m][n] = (f32x4){0.f, 0.f, 0.f, 0.f};
        cur = nxt; cA = nA; cB = nB; ++ui;
        if constexpr (GATHER) { _Pragma("unroll") for (int _h = 0; _h < 2; ++_h) _Pragma("unroll") for (int _i = 0; _i < 2; ++_i) gA[_h][_i] = gN[_h][_i]; }
        if constexpr (ALIGN_EPI) { if (wr == 1) PG8_BAR; }
    }
    PG8_WAIT_V(0);
    if constexpr (!ALIGN_EPI) { if (wr == 0) PG8_BAR; }
    PG8_BAR;
    if constexpr (Epi::AFTER_DRAIN) { E.fused(acc, cur, wr, wc, fr, fq, lds, wid, lane); S.done(cur); }
#undef PG8_SA
#undef PG8_VA
#undef PG8_VS
#undef PG8_IDX_ISSUE
#undef PG8_IDX_TAKE
#undef PG8_SB
#undef PG8_STAGE
#undef PG8_LDA
#undef PG8_LDB
#undef PG8_MMA
#undef PG8_WAIT_V
#undef PG8_WAIT_L
#undef PG8_BAR
#undef PG8_SCHED
}
}
#define XB_TMO      128
#define XB_XCNT(j)  (256  + 64 * (j))
#define XB_XSUB(j)  (1280 + 64 * (j))
#define XB_XGEN(j)  (2304 + 64 * (j))
#define XB_TOP      3328
#define XB_TOPGEN   3392
#define XCD_BAR_WORDS 3456
#define XB_SPIN_CAP (1u << 18)

__device__ __forceinline__ unsigned xb_ld(unsigned* p)              { return __hip_atomic_load(p, __ATOMIC_RELAXED, __HIP_MEMORY_SCOPE_AGENT); }
__device__ __forceinline__ unsigned xb_add(unsigned* p, unsigned v) { return __hip_atomic_fetch_add(p, v, __ATOMIC_RELAXED, __HIP_MEMORY_SCOPE_AGENT); }
__device__ __forceinline__ unsigned xb_xcc_id() { return (unsigned)__builtin_amdgcn_s_getreg((3 << 11) | 20) & 0xFu; }
#define XB_SPIN(cond, bar) do { unsigned _sp = 0; while (cond) { __builtin_amdgcn_s_sleep(1); \
    if ((++_sp & 255u) == 0u) { if (xb_ld(&(bar)[XB_TMO])) break; if (_sp > XB_SPIN_CAP) { atomicAdd(&(bar)[XB_TMO], 1u); break; } } } } while (0)

struct XcdBarrier {
    unsigned* bar; unsigned x;
    volatile LAS unsigned* st;
};

__device__ __forceinline__ XcdBarrier xcd_barrier_post(unsigned* bar, volatile LAS unsigned* st) {
    XcdBarrier b; b.bar = bar; b.x = xb_xcc_id(); b.st = st;
    if (threadIdx.x == 0) (void)xb_add(&bar[XB_XCNT(b.x)], 1u);
    return b;
}
__device__ __forceinline__ void xcd_barrier_complete(unsigned* bar, unsigned x, unsigned& nloc, unsigned& nx) {
    const unsigned G = gridDim.x * gridDim.y * gridDim.z;
    unsigned sum, cnt, mine, sp = 0u;
    for (;;) {
        sum = 0u; cnt = 0u; mine = 0u;
#pragma unroll
        for (unsigned j = 0; j < 16; ++j) { const unsigned c = xb_ld(&bar[XB_XCNT(j)]); sum += c; cnt += (c > 0u) ? 1u : 0u; mine = (j == x) ? c : mine; }
        if (sum == G) break;
        __builtin_amdgcn_s_sleep(1);
        if ((++sp & 255u) == 0u) { if (xb_ld(&bar[XB_TMO])) break; if (sp > XB_SPIN_CAP) { atomicAdd(&bar[XB_TMO], 1u); break; } }
    }
    nloc = mine > 0u ? mine : 1u; nx = cnt > 0u ? cnt : 1u;
}

__device__ __forceinline__ void xcd_barrier(const XcdBarrier& b) {
    asm volatile("s_waitcnt vmcnt(0)" ::: "memory");
    __syncthreads();
    if (threadIdx.x == 0) {
        unsigned* bar = b.bar;
        __builtin_amdgcn_s_waitcnt(0);
        unsigned nloc = b.st[0], nx = b.st[1];
        if (nloc == 0u) { xcd_barrier_complete(bar, b.x, nloc, nx); b.st[0] = nloc; b.st[1] = nx; }
        const unsigned old = xb_add(&bar[XB_XSUB(b.x)], 1u);
        const unsigned gen = old / nloc;
        if (old + 1u == (gen + 1u) * nloc) {
            __builtin_amdgcn_fence(__ATOMIC_RELEASE, "agent");
            asm volatile("s_waitcnt vmcnt(0)" ::: "memory");
            const unsigned og = xb_add(&bar[XB_TOP], 1u);
            const unsigned tg = og / nx;
            if (og + 1u == (tg + 1u) * nx) xb_add(&bar[XB_TOPGEN], 1u);
            else XB_SPIN(xb_ld(&bar[XB_TOPGEN]) == tg, bar);
            __builtin_amdgcn_fence(__ATOMIC_ACQUIRE, "agent");
            xb_add(&bar[XB_XGEN(b.x)], 1u);
            asm volatile("s_waitcnt vmcnt(0)" ::: "memory");
        } else {
            XB_SPIN(xb_ld(&bar[XB_XGEN(b.x)]) == gen, bar);
            __builtin_amdgcn_fence(__ATOMIC_ACQUIRE, "agent");
            asm volatile("s_waitcnt vmcnt(0)" ::: "memory");
        }
    }
    __syncthreads();
}

typedef unsigned short bf16;
typedef unsigned v4u __attribute__((ext_vector_type(4)));
typedef unsigned v2u __attribute__((ext_vector_type(2)));
typedef float f32x4 __attribute__((ext_vector_type(4)));
typedef float f32x16 __attribute__((ext_vector_type(16)));
typedef short bf16x8 __attribute__((ext_vector_type(8)));
typedef unsigned short u16x8 __attribute__((ext_vector_type(8)));
#define LDS_WAIT() asm volatile("s_waitcnt lgkmcnt(0)" ::: "memory")
#define VM_WAIT() asm volatile("s_waitcnt vmcnt(0)" ::: "memory")

constexpr int NWAVES = 8, NTHR = 512;
constexpr int D = 1024, NB = 4, SEQ = 8192, CTXL = 256, NLAT = NB * SEQ, NCTX = NB * CTXL, NROW = NLAT + NCTX;
constexpr int INC = 2304;
constexpr int PXC = 2048;
constexpr int PX_Z = 1536;
constexpr int NE = 16, CAP_L = 1024, CAP_C = 32;
constexpr int SLAB_L = NB * NE * CAP_L;
constexpr int SLAB_ROWS = SLAB_L + NE * 256;
constexpr int NCHUNK = NROW / 64;
constexpr float EPS = 1e-6f;

enum { I_X = 0, I_C, I_CTX, I_CCTX, I_WADA, I_BADA, I_GN1, I_WIN, I_LCW, I_LCB, I_LWR, I_LBR, I_LWI, I_LBI, I_LAM, I_SCW, I_GOUT, I_WOUT, I_GN2, I_WRT, I_WG, I_WU, I_WD, I_GF, N_IN };

constexpr size_t MiB = 1u << 20;
constexpr size_t WS_CTL = 0, CTL_ZERO_BYTES = 64 * 1024;
constexpr size_t WS_MODP_OLD = 1 * MiB;
constexpr size_t WS_MODS = WS_MODP_OLD + 2 * MiB;
constexpr size_t WS_SP8 = WS_MODS + 256 * 1024;
constexpr size_t WS_TW = WS_SP8 + 8 * 1024;
constexpr size_t WS_C128 = WS_TW + 64 * 1024;
constexpr size_t WS_S128 = WS_C128 + 32 * 1024;
constexpr size_t WS_T2M = WS_S128 + 32 * 1024;
constexpr size_t WS_TCM = WS_T2M + 16 * 1024;
constexpr size_t WS_WGL = WS_TCM + 256 * 1024;
constexpr size_t WS_WIN = 5 * MiB;
constexpr size_t WS_WOUT = WS_WIN + 9 * MiB;
constexpr size_t WS_WGU = WS_WOUT + 4 * MiB;
constexpr size_t WS_WD = WS_WGU + 64 * MiB;
constexpr size_t WS_WEXP_L = 96 * MiB;
constexpr size_t WS_XB = WS_WGU + 2 * WS_WEXP_L;
constexpr size_t WS_HX = WS_XB;
constexpr size_t WS_REGA = WS_HX + 66 * MiB;
constexpr size_t WS_REGB = WS_REGA + 149 * MiB;
constexpr size_t WS_T1 = WS_REGB, WS_Y = WS_REGB + 32 * MiB;
constexpr size_t WS_MODP = WS_REGB;
constexpr size_t WS_CTXX = WS_REGB + 136 * MiB;
constexpr size_t WS_AFFL = WS_CTXX + 4 * MiB;
constexpr size_t WS_AFFC = WS_AFFL + 2 * MiB;
constexpr size_t WS_ENT = WS_AFFC + 1 * MiB;
constexpr size_t WS_IDX = WS_ENT + 3 * MiB;
constexpr size_t WS_GVAL = WS_IDX + 1 * MiB;
constexpr size_t WS_SUMM = WS_GVAL + 1 * MiB;
constexpr size_t WS_CARRY = WS_SUMM + 5 * MiB;
constexpr size_t WS_END = WS_CARRY + 3 * MiB;
static_assert(WS_WGL + 2 * 8 * 256 * 64 * 2 <= WS_WIN, "ws map");
static_assert((size_t)NROW * INC * 2 <= 149 * MiB && (size_t)SLAB_ROWS * 1024 * 2 <= 136 * MiB && 32 * MiB + (size_t)NROW * 1024 * 2 <= 136 * MiB, "ws map");

constexpr int CW_BAR = 1024;

constexpr int LDS_BYTES = 147456;
constexpr int RING_BYTES = 135168;
constexpr int MISC_OFF = RING_BYTES;

__device__ __forceinline__ unsigned f2bf(float f) { unsigned u = __builtin_bit_cast(unsigned, f); return (u + 0x7fffu + ((u >> 16) & 1u)) >> 16; }
__device__ __forceinline__ unsigned pk2(float lo, float hi) { unsigned r; asm volatile("v_cvt_pk_bf16_f32 %0, %1, %2" : "=v"(r) : "v"(lo), "v"(hi)); return r; }
__device__ __forceinline__ float bf2f(unsigned h) { return __builtin_bit_cast(float, h << 16); }
__device__ __forceinline__ float sigmoidf_(float x) { return __builtin_amdgcn_rcpf(1.0f + __builtin_amdgcn_exp2f(-1.4426950408889634f * x)); }
__device__ __forceinline__ float rsq_(float x) { return __builtin_amdgcn_rsqf(x); }
__device__ __forceinline__ float wave_sum(float v) {
#pragma unroll
    for (int o = 1; o < 64; o <<= 1) v += __shfl_xor(v, o);
    return v;
}

struct Args { const float* in[N_IN]; float* out; unsigned char* ws; int ph_lo, ph_hi, bar_region, pad_; };
template <int CTRL> __device__ __forceinline__ float dpp_(float v) { return __builtin_bit_cast(float, __builtin_amdgcn_update_dpp(0, __builtin_bit_cast(int, v), CTRL, 0xf, 0xf, false)); }
__device__ __forceinline__ float row_sum16(float v) { v += dpp_<0xB1>(v); v += dpp_<0x4E>(v); v += dpp_<0x141>(v); v += dpp_<0x140>(v); return v; }
__device__ __forceinline__ float row_max16(float v) { v = fmaxf(v, dpp_<0xB1>(v)); v = fmaxf(v, dpp_<0x4E>(v)); v = fmaxf(v, dpp_<0x141>(v)); v = fmaxf(v, dpp_<0x140>(v)); return v; }
__device__ __forceinline__ float wave_sum_fast(float v) { v = row_sum16(v);
    const int i = __builtin_bit_cast(int, v);
    return (__builtin_bit_cast(float, __builtin_amdgcn_readlane(i, 0)) + __builtin_bit_cast(float, __builtin_amdgcn_readlane(i, 16))) + (__builtin_bit_cast(float, __builtin_amdgcn_readlane(i, 32)) + __builtin_bit_cast(float, __builtin_amdgcn_readlane(i, 48))); }
struct Frame {
    LAS unsigned char* lds;
    int tid, lane, wave, wg, G;
};
constexpr int PT_OFF = 135168 + 256;
__device__ __forceinline__ unsigned long long ptab_(LAS unsigned char* lds, int i) { const unsigned long long v = ((const LAS unsigned long long*)(lds + PT_OFF))[i];
    const unsigned lo = __builtin_amdgcn_readfirstlane((unsigned)v), hi = __builtin_amdgcn_readfirstlane((unsigned)(v >> 32)); return ((unsigned long long)hi << 32) | lo; }
#define GAS __attribute__((address_space(1)))
template <class T> __device__ __forceinline__ T* as_global_(unsigned long long v) { return (T*)(GAS T*)v; }
#define INP(i) as_global_<const float>(ptab_(F.lds, (i)))
#define OUTP() as_global_<float>(ptab_(F.lds, N_IN))
#define HXP() as_global_<bf16>(ptab_(F.lds, N_IN))
#define XBP() WSP(bf16, WS_XB)
__device__ __forceinline__ void relaunder(Frame& F) { int t_ = threadIdx.x; asm volatile("" : "+v"(t_)); F.tid = t_; F.lane = t_ & 63; F.wave = __builtin_amdgcn_readfirstlane(t_ >> 6); }
#define WSP(T, off) as_global_<T>(ptab_(F.lds, N_IN + 1) + (off))

__device__ __forceinline__ void transpose_item(const float* __restrict__ W, int ldw, int k0, int n0, bf16* __restrict__ WT, int ldk, int drow0, LAS float* scr, int lane) {
#pragma unroll 8
    for (int i = 0; i < 32; ++i) { const int kk = 2 * i + (lane >> 5); scr[kk * 33 + (lane & 31)] = W[(size_t)(k0 + kk) * ldw + n0 + (lane & 31)]; }
    LDS_WAIT(); asm volatile("" ::: "memory");
    const int c = lane & 7;
#pragma unroll
    for (int j = 0; j < 4; ++j) { const int n = (lane >> 3) + 8 * j; const LAS float* s = scr + (8 * c) * 33 + n;
        v4u o; o.x = pk2(s[0 * 33], s[1 * 33]); o.y = pk2(s[2 * 33], s[3 * 33]); o.z = pk2(s[4 * 33], s[5 * 33]); o.w = pk2(s[6 * 33], s[7 * 33]);
        *(v4u*)(WT + (size_t)(drow0 + n) * ldk + k0 + 8 * c) = o; }
    LDS_WAIT(); asm volatile("" ::: "memory");
}
__device__ __forceinline__ void transpose_item64(const float* __restrict__ W, int ldw, int k0, int n0, bf16* __restrict__ WT, int ldk, int drow0, LAS float* scr, int lane) {
    const int q = lane & 15, kr = lane >> 4;
    f32x4 v[16];
#pragma unroll
    for (int i = 0; i < 16; ++i) v[i] = __builtin_nontemporal_load((const f32x4*)(W + (size_t)(k0 + 4 * i + kr) * ldw + n0 + 4 * q));
#pragma unroll
    for (int i = 0; i < 16; ++i) { LAS float* d = scr + (4 * i + kr) * 65 + 4 * q; d[0] = v[i].x; d[1] = v[i].y; d[2] = v[i].z; d[3] = v[i].w; }
    LDS_WAIT(); asm volatile("" ::: "memory");
    const int c = lane & 7;
#pragma unroll
    for (int j = 0; j < 8; ++j) { const int n = (lane >> 3) + 8 * j; const LAS float* s = scr + (8 * c) * 65 + n;
        v4u o; o.x = pk2(s[0 * 65], s[1 * 65]); o.y = pk2(s[2 * 65], s[3 * 65]); o.z = pk2(s[4 * 65], s[5 * 65]); o.w = pk2(s[6 * 65], s[7 * 65]);
        *(v4u*)(WT + (size_t)(drow0 + n) * ldk + k0 + 8 * c) = o; }
    LDS_WAIT(); asm volatile("" ::: "memory");
}
constexpr int N_EXP_ITEMS = 3 * 16 * 256;
constexpr int CW_FILL = 64;
__device__ __forceinline__ void convert_item(Frame& F, int l, int it) {
    LAS float* scr = (LAS float*)(F.lds + F.wave * 16640);
    bf16* WGU = WSP(bf16, WS_WGU + (size_t)l * WS_WEXP_L); bf16* WD = WSP(bf16, WS_WD + (size_t)l * WS_WEXP_L);
    const int mat = it / (16 * 256), r = it % (16 * 256), e = r >> 8, t = r & 255, kb = t >> 4, nb = t & 15, k0 = kb * 64, n0 = nb * 64;
    const size_t eoff = ((size_t)l * 16 + e) * 1024 * 1024;
    if (mat == 0)      transpose_item64(INP(I_WG) + eoff, 1024, k0, n0, WGU + (size_t)e * 2048 * 1024, 1024, (n0 >> 7) * 256 + (n0 & 127), scr, F.lane);
    else if (mat == 1) transpose_item64(INP(I_WU) + eoff, 1024, k0, n0, WGU + (size_t)e * 2048 * 1024, 1024, (n0 >> 7) * 256 + 128 + (n0 & 127), scr, F.lane);
    else               transpose_item64(INP(I_WD) + eoff, 1024, k0, n0, WD + (size_t)e * 1024 * 1024, 1024, n0, scr, F.lane);
}
__device__ __forceinline__ void filler(Frame& F, int budget, int only_l) {
    volatile LAS unsigned* MISC = (volatile LAS unsigned*)(F.lds + MISC_OFF);
    unsigned* ctr = WSP(unsigned, WS_CTL) + CW_FILL;
    int l = only_l >= 0 ? only_l : 0;
    for (int g = 0; only_l >= 0 || g < budget; ++g) {
        __syncthreads();
        if (F.tid == 0) { unsigned base = __hip_atomic_fetch_add(ctr + 64 * l, 8u, __ATOMIC_RELAXED, __HIP_MEMORY_SCOPE_AGENT);
            if (base >= (unsigned)N_EXP_ITEMS && only_l < 0 && l == 0) { base = __hip_atomic_fetch_add(ctr + 64, 8u, __ATOMIC_RELAXED, __HIP_MEMORY_SCOPE_AGENT) | 0x80000000u; }
            MISC[20] = base; }
        LDS_WAIT(); __syncthreads();
        unsigned base = MISC[20]; int ll = l;
        if (base & 0x80000000u) { base &= 0x7fffffffu; ll = 1; l = 1; }
        if (base >= (unsigned)N_EXP_ITEMS) break;
        convert_item(F, ll, (int)base + F.wave);
    }
    __syncthreads();
}
__device__ __forceinline__ void p0_prep(Frame& F) {
    const int gw = F.wg * NWAVES + F.wave, NGW = F.G * NWAVES;
    LAS float* sil = (LAS float*)(F.lds + 8 * 8448);
    for (int i = F.tid; i < 5 * 1024; i += NTHR) { const int s = i >> 10, k = i & 1023; const float cv = s < 4 ? INP(I_C)[s * 1024 + k] : INP(I_CCTX)[k]; sil[i] = cv * sigmoidf_(cv); }
    LAS float* cst = (LAS float*)(F.lds + 8 * 8448 + 5 * 1024 * 4);
    if (F.tid < 64) { cst[F.tid] = cospif((float)F.tid / 32.0f); cst[64 + F.tid] = sinpif((float)F.tid / 32.0f); }
    LDS_WAIT(); __syncthreads();
    constexpr int N_ADA = 16 * 24, N_FOLD = 256, N_IN_ITEMS = 16 * 56, N_OUT_ITEMS = 16 * 32, N_LRU = 32;
    constexpr int PER_L = N_ADA + N_FOLD + N_IN_ITEMS + N_OUT_ITEMS + N_LRU;
    LAS float* scr = (LAS float*)(F.lds + F.wave * 8448);
    for (int it = gw; it < 2 * PER_L; it += NGW) {
        const int l = it & 1; int r = it >> 1;
        if (r < N_ADA) {
            const int kq = r / 24, cb = r % 24, j0 = cb * 256 + 4 * F.lane;
            const float* W = INP(I_WADA) + (size_t)l * 1024 * 6144 + j0;
            f32x4 acc[5];
#pragma unroll
            for (int s = 0; s < 5; ++s) acc[s] = (f32x4){0.f, 0.f, 0.f, 0.f};
            for (int kb = 0; kb < 4; ++kb) { f32x4 w[16];
#pragma unroll
                for (int i = 0; i < 16; ++i) w[i] = __builtin_nontemporal_load((const f32x4*)(W + (size_t)(kq * 64 + kb * 16 + i) * 6144));
#pragma unroll
                for (int i = 0; i < 16; ++i)
#pragma unroll
                    for (int s = 0; s < 5; ++s) acc[s] += w[i] * sil[s * 1024 + kq * 64 + kb * 16 + i]; }
            float* MP = WSP(float, WS_MODP);
#pragma unroll
            for (int s = 0; s < 5; ++s) *(f32x4*)(MP + ((size_t)(kq * 2 + l) * 5 + s) * 6144 + j0) = acc[s];
            continue; }
        r -= N_ADA;
        if (r < N_FOLD) {
            const int kb = r >> 4, g = (r >> 2) & 3, mq = r & 3, k = kb * 64 + F.lane;
            const float* Wr = INP(I_WIN) + (size_t)l * 1024 * 2048 + (size_t)k * 2048 + 1792 + 64 * g;
            float wrow[64];
#pragma unroll
            for (int c4 = 0; c4 < 16; ++c4) { const f32x4 t = *(const f32x4*)(Wr + 4 * c4); wrow[4 * c4] = t.x; wrow[4 * c4 + 1] = t.y; wrow[4 * c4 + 2] = t.z; wrow[4 * c4 + 3] = t.w; }
            bf16* WT = WSP(bf16, WS_WIN) + (size_t)l * INC * 1024;
            for (int m = 16 * mq; m < 16 * mq + 16; ++m) { float re = 0.f, im = 0.f;
#pragma unroll
                for (int c = 0; c < 64; ++c) { const int a = (m * c) & 63; re += wrow[c] * cst[a]; im -= wrow[c] * cst[64 + a]; }
                WT[(size_t)(1792 + 64 * g + m) * 1024 + k] = (bf16)f2bf(re);
                WT[(size_t)(2048 + 64 * g + m) * 1024 + k] = (bf16)f2bf(im); }
            continue; }
        r -= N_FOLD;
        if (r < N_IN_ITEMS) {
            const int kb = r / 56, nb = r % 56;
            const int n0 = nb * 32, j = n0 < 1536 ? n0 - 1280 : n0 - 1536;
            const int drow = n0 < 1280 ? n0 : 1280 + (j >> 7) * 256 + (n0 < 1536 ? 0 : 128) + (j & 127);
            transpose_item(INP(I_WIN) + (size_t)l * 1024 * 2048, 2048, kb * 64, n0, WSP(bf16, WS_WIN) + (size_t)l * INC * 1024, 1024, drow, scr, F.lane); continue; }
        r -= N_IN_ITEMS;
        if (r < N_OUT_ITEMS) { const int kb = r >> 5, nb = r & 31;
            transpose_item(INP(I_WOUT) + (size_t)l * 1024 * 1024, 1024, kb * 64, nb * 32, WSP(bf16, WS_WOUT) + (size_t)l * 1024 * 1024, 1024, nb * 32, scr, F.lane); continue; }
        r -= N_OUT_ITEMS;
        {
            const int dir = r >> 4, gate = (r >> 3) & 1, h = r & 7;
            const float* W = INP(gate ? I_LWI : I_LWR) + ((size_t)(l * 2 + dir) * 8 + h) * 4096;
            bf16* WT = WSP(bf16, WS_WGL) + ((size_t)l * 8 + h) * 256 * 64 + (size_t)(dir * 2 + gate) * 64 * 64;
            for (int i = 0; i < 64; ++i) WT[F.lane * 64 + i] = (bf16)f2bf(W[i * 64 + F.lane]);
        }
    }
    const int gt = F.wg * NTHR + F.tid, NGT = F.G * NTHR;
    float* TW = WSP(float, WS_TW); bf16* C128 = WSP(bf16, WS_C128); bf16* S128 = WSP(bf16, WS_S128); bf16* T2M = WSP(bf16, WS_T2M); bf16* TCM = WSP(bf16, WS_TCM); float* SP8 = WSP(float, WS_SP8);
    for (int i = gt; i < 8192; i += NGT) { TW[2 * i] = cospif((float)i / 4096.0f); TW[2 * i + 1] = sinpif((float)i / 4096.0f); }
    for (int i = gt; i < 128 * 128; i += NGT) { const int k = i >> 7, n = i & 127, a = (k * n) & 127; C128[i] = (bf16)f2bf(cospif((float)a / 64.0f)); S128[i] = (bf16)f2bf(sinpif((float)a / 64.0f)); }
    for (int i = gt; i < 64 * 128; i += NGT) { const int k = i >> 7, nq = (i & 127) >> 1, ri = i & 1, a = (k * nq) & 63; T2M[i] = (bf16)f2bf(ri ? sinpif((float)a / 32.0f) : cospif((float)a / 32.0f)); }
    for (int i = gt; i < 256 * 512; i += NGT) { const int k = i >> 9, n = (i & 511) >> 1, ri = i & 1, a = (k * n) & 255; TCM[i] = (bf16)f2bf(ri ? sinpif((float)a / 128.0f) : cospif((float)a / 128.0f)); }
    for (int i = gt; i < 2048; i += NGT) { const float lam = INP(I_LAM)[i]; SP8[i] = 8.0f * log1pf(expf(-lam)); }
}
__device__ __forceinline__ void p0b_mods(Frame& F) {
    const int gt = F.wg * NTHR + F.tid, NGT = F.G * NTHR;
    const float* MP = WSP(float, WS_MODP); float* MS = WSP(float, WS_MODS);
    for (int i = gt; i < 2 * 5 * 6144; i += NGT) { const int l = i / (5 * 6144), r = i % (5 * 6144), s = r / 6144, j = r % 6144;
        float a = INP(I_BADA)[l * 6144 + j];
#pragma unroll
        for (int kq = 0; kq < 16; ++kq) a += MP[((size_t)(kq * 2 + l) * 5 + s) * 6144 + j];
        MS[i] = a; }
}

__device__ __forceinline__ int row_set(int row) { return row < NLAT ? (row >> 13) : 4; }
__device__ __forceinline__ void norm_mod_store(const f32x4 (&v)[4], const float* g, const float* shift, const float* scale, bf16* orow, int lane) {
    float ss = 0.f;
#pragma unroll
    for (int j = 0; j < 4; ++j) ss += (v[j].x * v[j].x + v[j].y * v[j].y) + (v[j].z * v[j].z + v[j].w * v[j].w);
    const float rstd = rsq_(wave_sum_fast(ss) * (1.0f / D) + EPS);
    unsigned long long* o8 = (unsigned long long*)orow + lane;
#pragma unroll
    for (int j = 0; j < 4; ++j) { const int c = 4 * lane + 256 * j;
        const f32x4 gg = *(const f32x4*)(g + c), sh = *(const f32x4*)(shift + c), sc = *(const f32x4*)(scale + c);
        const f32x4 o = (v[j] * rstd * gg) * (sc + 1.0f) + sh;
        o8[64 * j] = (unsigned long long)pk2(o.x, o.y) | ((unsigned long long)pk2(o.z, o.w) << 32); }
}
#define ROWCOL(lane, j) (8 * (lane) + 512 * ((j) >> 1) + 4 * ((j) & 1))
__device__ __forceinline__ void norm_mod_store8(const f32x4 (&v)[4], const float* g, const float* shift, const float* scale, bf16* orow, int lane) {
    float ss = 0.f;
#pragma unroll
    for (int j = 0; j < 4; ++j) ss += (v[j].x * v[j].x + v[j].y * v[j].y) + (v[j].z * v[j].z + v[j].w * v[j].w);
    const float rstd = rsq_(wave_sum_fast(ss) * (1.0f / D) + EPS);
#pragma unroll
    for (int h = 0; h < 2; ++h) { const int c = 8 * lane + 512 * h; f32x4 o[2];
#pragma unroll
        for (int q = 0; q < 2; ++q) { const f32x4 gg = *(const f32x4*)(g + c + 4 * q), sh = *(const f32x4*)(shift + c + 4 * q), sc = *(const f32x4*)(scale + c + 4 * q);
            o[q] = (v[2 * h + q] * rstd * gg) * (sc + 1.0f) + sh; }
        v4u w; w.x = pk2(o[0].x, o[0].y); w.y = pk2(o[0].z, o[0].w); w.z = pk2(o[1].x, o[1].y); w.w = pk2(o[1].z, o[1].w);
        *(v4u*)(orow + c) = w; }
}
__device__ __forceinline__ void load_row8(const bf16* row, int lane, f32x4 (&v)[4]) {
#pragma unroll
    for (int h = 0; h < 2; ++h) { const v4u w = *(const v4u*)(row + 8 * lane + 512 * h);
        v[2 * h] = (f32x4){bf2f(w.x & 0xffffu), bf2f(w.x >> 16), bf2f(w.y & 0xffffu), bf2f(w.y >> 16)}; v[2 * h + 1] = (f32x4){bf2f(w.z & 0xffffu), bf2f(w.z >> 16), bf2f(w.w & 0xffffu), bf2f(w.w >> 16)}; }
}
__device__ __forceinline__ void store_row8(bf16* row, int lane, const f32x4 (&v)[4]) {
#pragma unroll
    for (int h = 0; h < 2; ++h) { v4u w; w.x = pk2(v[2 * h].x, v[2 * h].y); w.y = pk2(v[2 * h].z, v[2 * h].w); w.z = pk2(v[2 * h + 1].x, v[2 * h + 1].y); w.w = pk2(v[2 * h + 1].z, v[2 * h + 1].w);
        *(v4u*)(row + 8 * lane + 512 * h) = w; }
}
__device__ __forceinline__ void s0_norm1(Frame& F) {
    const int gw = F.wg * NWAVES + F.wave, NGW = F.G * NWAVES;
    const float* MS = WSP(float, WS_MODS); bf16* HX = HXP();
    const int npairs = NROW / 2;
    f32x4 va[4], vb[4];
    if (gw < npairs) { const int ra = 2 * gw; const float* xr = ra < NLAT ? INP(I_X) + (size_t)ra * D : INP(I_CTX) + (size_t)(ra - NLAT) * D;
#pragma unroll
        for (int j = 0; j < 4; ++j) { va[j] = *(const f32x4*)(xr + 4 * F.lane + 256 * j); vb[j] = *(const f32x4*)(xr + D + 4 * F.lane + 256 * j); } }
    for (int rp = gw; rp < npairs; rp += NGW) {
        const int ra = 2 * rp; f32x4 na[4], nb[4]; const bool more = rp + NGW < npairs;
        if (more) { const int rn = 2 * (rp + NGW); const float* xr = rn < NLAT ? INP(I_X) + (size_t)rn * D : INP(I_CTX) + (size_t)(rn - NLAT) * D;
#pragma unroll
            for (int j = 0; j < 4; ++j) { na[j] = *(const f32x4*)(xr + 4 * F.lane + 256 * j); nb[j] = *(const f32x4*)(xr + D + 4 * F.lane + 256 * j); } }
        const float* m = MS + (size_t)row_set(ra) * 6144;
        norm_mod_store(va, INP(I_GN1), m, m + 1024, HX + (size_t)ra * D, F.lane);
        norm_mod_store(vb, INP(I_GN1), m, m + 1024, HX + (size_t)(ra + 1) * D, F.lane);
        if (more) {
#pragma unroll
            for (int j = 0; j < 4; ++j) { va[j] = na[j]; vb[j] = nb[j]; } }
    }
}

#define MFMA32(a, b, c) __builtin_amdgcn_mfma_f32_32x32x16_bf16((a), (b), (c), 0, 0, 0)
__device__ __forceinline__ bf16x8 ldsB_frag(const LAS bf16* t, int stride, int k0, int col, int lane) {
    const LAS bf16* p = t + (k0 + 8 * (lane >> 5)) * stride + col; bf16x8 r;
#pragma unroll
    for (int j = 0; j < 8; ++j) r[j] = (short)p[j * stride];
    return r;
}
__device__ __forceinline__ bf16x8 neg_frag(bf16x8 a) { v4u u = __builtin_bit_cast(v4u, a); u ^= 0x80008000u; return __builtin_bit_cast(bf16x8, u); }
__device__ __forceinline__ int rowmap(int r, int hh) { return (r & 3) + 8 * (r >> 2) + 4 * hh; }

constexpr int D1_STRIDE = 520;
__device__ __forceinline__ void dft1_unit(Frame& F, int b, int nq) {
    relaunder(F);
    LAS bf16* tile = (LAS bf16*)F.lds;
    const bf16* PX = WSP(bf16, WS_REGA);
#pragma unroll 4
    for (int i = 0; i < 16; ++i) { const int q = F.tid + NTHR * i, row = q >> 6, ch = q & 63;
        const v4u v = *(const v4u*)(PX + (size_t)(b * SEQ + 64 * row + nq) * PXC + PX_Z + ch * 8);
        *(LAS v4u*)(tile + row * D1_STRIDE + ch * 8) = v; }
    LDS_WAIT(); __syncthreads();
    const bf16* C128 = WSP(bf16, WS_C128); const bf16* S128 = WSP(bf16, WS_S128);
    const int hh = F.lane >> 5, ln = F.lane & 31, cw = 32 * F.wave + ln;
    f32x16 are[4], aim[4];
#pragma unroll
    for (int mb = 0; mb < 4; ++mb)
#pragma unroll
        for (int r = 0; r < 16; ++r) { are[mb][r] = 0.f; aim[mb][r] = 0.f; }
    for (int ks = 0; ks < 8; ++ks) {
        const bf16x8 xre = ldsB_frag(tile, D1_STRIDE, 16 * ks, cw, F.lane), xim = ldsB_frag(tile, D1_STRIDE, 16 * ks, 256 + cw, F.lane);
#pragma unroll
        for (int mb = 0; mb < 4; ++mb) {
            const bf16x8 cf = *(const bf16x8*)(C128 + (32 * mb + ln) * 128 + 16 * ks + 8 * hh), sf = *(const bf16x8*)(S128 + (32 * mb + ln) * 128 + 16 * ks + 8 * hh);
            are[mb] = MFMA32(cf, xre, are[mb]); are[mb] = MFMA32(sf, xim, are[mb]);
            aim[mb] = MFMA32(cf, xim, aim[mb]); aim[mb] = MFMA32(neg_frag(sf), xre, aim[mb]);
        }
    }
    const float* TW = WSP(float, WS_TW); bf16* T1 = WSP(bf16, WS_T1);
#pragma unroll
    for (int mb = 0; mb < 4; ++mb)
#pragma unroll
        for (int r = 0; r < 16; ++r) { const int kp = 32 * mb + rowmap(r, hh); const int a = (kp * nq) & 8191; const float c = TW[2 * a], s = TW[2 * a + 1];
            const float re = are[mb][r], im = aim[mb][r];
            bf16* o = T1 + ((size_t)((b * 128 + kp) * 64 + nq) * 2) * 256 + cw;
            o[0] = (bf16)f2bf(re * c + im * s); o[256] = (bf16)f2bf(im * c - re * s); }
    __syncthreads();
}
constexpr int D2_STRIDE = 264;
__device__ __forceinline__ void dft2_unit(Frame& F, int l, const bf16* Amat, int lda, int m0, int nchunks, const bf16* dbase, size_t tokstride, size_t chunkstride, float scale, int orow0, int ostride, const LAS bf16* Alds) {
    relaunder(F);
    LAS bf16* tile = (LAS bf16*)F.lds;
    const int hh = F.lane >> 5, ln = F.lane & 31, cw = 32 * F.wave + ln;
    f32x16 acc[2];
#pragma unroll
    for (int mb = 0; mb < 2; ++mb)
#pragma unroll
        for (int r = 0; r < 16; ++r) acc[mb][r] = 0.f;
    for (int ck = 0; ck < nchunks; ++ck) {
        const bf16* dsrc = dbase + (size_t)ck * chunkstride;
        { v4u dv[8];
#pragma unroll
          for (int i = 0; i < 8; ++i) { const int q = F.tid + NTHR * i, krow = q >> 5, ch = q & 31;
              dv[i] = *(const v4u*)(dsrc + (size_t)(krow >> 1) * tokstride + (krow & 1) * 256 + ch * 8); }
#pragma unroll
          for (int i = 0; i < 8; ++i) { const int q = F.tid + NTHR * i, krow = q >> 5, ch = q & 31; *(LAS v4u*)(tile + krow * D2_STRIDE + ch * 8) = dv[i]; } }
        LDS_WAIT(); __syncthreads();
        for (int ks = 0; ks < 8; ++ks) {
            const bf16x8 xf = ldsB_frag(tile, D2_STRIDE, 16 * ks, cw, F.lane);
#pragma unroll
            for (int mb = 0; mb < 2; ++mb) { const bf16x8 af = Alds ? *(const LAS bf16x8*)(Alds + (32 * mb + ln) * 136 + 16 * ks + 8 * hh) : *(const bf16x8*)(Amat + (size_t)(m0 + 32 * mb + ln) * lda + ck * 128 + 16 * ks + 8 * hh);
                acc[mb] = MFMA32(af, xf, acc[mb]); }
        }
        __syncthreads();
    }
    LAS float* yt = (LAS float*)F.lds;
#pragma unroll
    for (int mb = 0; mb < 2; ++mb)
#pragma unroll
        for (int r = 0; r < 16; ++r) yt[(32 * mb + rowmap(r, hh)) * 260 + cw] = acc[mb][r] * scale;
    LDS_WAIT(); __syncthreads();
    { const int m = F.tid >> 3, seg = F.tid & 7; const LAS float* p = yt + m * 260 + 32 * seg;
        f32x4 v[8]; float ss = 0.f;
#pragma unroll
        for (int j = 0; j < 8; ++j) { v[j] = *(const LAS f32x4*)(p + 4 * j); ss += (v[j].x * v[j].x + v[j].y * v[j].y) + (v[j].z * v[j].z + v[j].w * v[j].w); }
        ss += __shfl_xor(ss, 1); ss += __shfl_xor(ss, 2); ss += __shfl_xor(ss, 4);
        const float rstd = rsq_(ss * (1.0f / 256.0f) + EPS);
        const float* g = INP(I_GOUT) + l * 1024 + 768 + 32 * seg;
        bf16* o = WSP(bf16, WS_Y) + (size_t)(orow0 + m * ostride) * D + 768 + 32 * seg;
#pragma unroll
        for (int j = 0; j < 4; ++j) { const f32x4 g0 = *(const f32x4*)(g + 8 * j), g1 = *(const f32x4*)(g + 8 * j + 4); const f32x4 a = v[2 * j] * rstd * g0, c = v[2 * j + 1] * rstd * g1;
            v4u w; w.x = pk2(a.x, a.y); w.y = pk2(a.z, a.w); w.z = pk2(c.x, c.y); w.w = pk2(c.z, c.w); *(v4u*)(o + 8 * j) = w; } }
    __syncthreads();
}

constexpr int UT_STRIDE = 520;
constexpr int UT_BYTES = 64 * UT_STRIDE * 2;
struct UWin { u16x8 rows[11]; };
__device__ __forceinline__ void lru_bounds(int cid, int& lo, int& hi) { if (cid < 512) { lo = cid * 64; hi = lo + 64; } else { lo = NLAT + ((cid - 512) >> 2) * CTXL; hi = lo + CTXL; } }
__device__ __forceinline__ void lru_issue_u(Frame& F, int cid, UWin& w) {
    const bf16* PX = WSP(bf16, WS_REGA);
    const int row0 = cid * 64; int lo, hi; lru_bounds(cid, lo, hi);
    const int ch0 = (F.tid & 63) * 8, t0 = (F.tid >> 6) * 8;
#pragma unroll
    for (int k = 0; k < 11; ++k) { const int rr = row0 + t0 - 1 + k, rc = rr < lo ? lo : (rr >= hi ? hi - 1 : rr);
        w.rows[k] = *(const u16x8*)(PX + (size_t)rc * PXC + ch0); }
}
__device__ __forceinline__ void lru_finish_u(Frame& F, int l, int cid, UWin& win, LAS bf16* ut) {
    const int row0 = cid * 64; int lo, hi; lru_bounds(cid, lo, hi);
    const int ch0 = (F.tid & 63) * 8, t0 = (F.tid >> 6) * 8;
    f32x4 w[4][2], bias[2];
#pragma unroll
    for (int k = 0; k < 4; ++k) { w[k][0] = *(const f32x4*)(INP(I_LCW) + (l * 4 + k) * 512 + ch0); w[k][1] = *(const f32x4*)(INP(I_LCW) + (l * 4 + k) * 512 + ch0 + 4); }
    bias[0] = *(const f32x4*)(INP(I_LCB) + l * 512 + ch0); bias[1] = *(const f32x4*)(INP(I_LCB) + l * 512 + ch0 + 4);
#pragma unroll
    for (int k = 0; k < 11; ++k) { const int rr = row0 + t0 - 1 + k; if (rr < lo || rr >= hi) win.rows[k] = (u16x8){0, 0, 0, 0, 0, 0, 0, 0}; }
#pragma unroll
    for (int t = 0; t < 8; ++t) { f32x4 a0 = bias[0], a1 = bias[1];
#pragma unroll
        for (int k = 0; k < 4; ++k) { const u16x8 v = win.rows[t + k];
            a0 += w[k][0] * (f32x4){bf2f(v[0]), bf2f(v[1]), bf2f(v[2]), bf2f(v[3])}; a1 += w[k][1] * (f32x4){bf2f(v[4]), bf2f(v[5]), bf2f(v[6]), bf2f(v[7])}; }
        v4u o; o.x = pk2(a0.x, a0.y); o.y = pk2(a0.z, a0.w); o.z = pk2(a1.x, a1.y); o.w = pk2(a1.z, a1.w);
        *(LAS v4u*)(ut + (t0 + t) * UT_STRIDE + ch0) = o; }
}
struct LruOps { bf16x8 fr[2][4], fi[2][4]; float b_r[2], b_i[2], sp[2]; };
template <int dir> __device__ __forceinline__ void lru_load_ops(Frame& F, int l, int nb, LruOps& o) {
    const int hd = F.wave, hh = F.lane >> 5, ln = F.lane & 31, ch = hd * 64 + nb * 32 + ln;
    const bf16* WG = WSP(bf16, WS_WGL) + ((size_t)l * 8 + hd) * 256 * 64;
#pragma unroll
    for (int ks = 0; ks < 4; ++ks) {
        o.fr[dir][ks] = *(const bf16x8*)(WG + (size_t)((dir * 2 + 0) * 64 + nb * 32 + ln) * 64 + 16 * ks + 8 * hh);
        o.fi[dir][ks] = *(const bf16x8*)(WG + (size_t)((dir * 2 + 1) * 64 + nb * 32 + ln) * 64 + 16 * ks + 8 * hh); }
    o.b_r[dir] = -1.4426950408889634f * INP(I_LBR)[(l * 2 + dir) * 512 + ch]; o.b_i[dir] = -1.4426950408889634f * INP(I_LBI)[(l * 2 + dir) * 512 + ch]; o.sp[dir] = -1.4426950408889634f * WSP(float, WS_SP8)[(l * 2 + dir) * 512 + ch];
}
template <int dir> __device__ __forceinline__ void lru_gates(Frame& F, const LruOps& o, const LAS bf16* ut, int mb, f32x16& a, f32x16& bb) {
    const int hd = F.wave, hh = F.lane >> 5, ln = F.lane & 31;
#pragma unroll
    for (int r = 0; r < 16; ++r) { a[r] = 0.f; bb[r] = 0.f; }
#pragma unroll
    for (int ks = 0; ks < 4; ++ks) {
        const bf16x8 af = *(const LAS bf16x8*)(ut + (32 * mb + ln) * UT_STRIDE + hd * 64 + 16 * ks + 8 * hh);
        a = MFMA32(af, o.fr[dir][ks], a); bb = MFMA32(af, o.fi[dir][ks], bb);
    }
}
template <int dir> __device__ __forceinline__ void lru_elem(Frame& F, const LruOps& o, const LAS bf16* ut, int nb, int mb, f32x16& a, f32x16& bb) {
    const int hd = F.wave, hh = F.lane >> 5, ln = F.lane & 31, ch = hd * 64 + nb * 32 + ln;
    typedef float f32x2 __attribute__((ext_vector_type(2)));
    const float nb_r = o.b_r[dir], nb_i = o.b_i[dir], spl = o.sp[dir];
    const LAS bf16* ub = ut + (32 * mb + 4 * hh) * UT_STRIDE + ch;
#pragma unroll
    for (int r = 0; r < 16; r += 2) {
        const f32x2 pa = {a[r], a[r + 1]}, pb = {bb[r], bb[r + 1]};
        const f32x2 xr = pa * -1.4426950408889634f + nb_r, xi = pb * -1.4426950408889634f + nb_i;
        const f32x2 dr = (f32x2){__builtin_amdgcn_exp2f(xr.x), __builtin_amdgcn_exp2f(xr.y)} + 1.0f, di = (f32x2){__builtin_amdgcn_exp2f(xi.x), __builtin_amdgcn_exp2f(xi.y)} + 1.0f;
        const f32x2 rr = {__builtin_amdgcn_rcpf(dr.x), __builtin_amdgcn_rcpf(dr.y)}, ii = {__builtin_amdgcn_rcpf(di.x), __builtin_amdgcn_rcpf(di.y)};
        const f32x2 z = rr * spl;
        const f32x2 av = {__builtin_amdgcn_exp2f(z.x), __builtin_amdgcn_exp2f(z.y)};
        const f32x2 om = 1.0f - av * av;
        const f32x2 mult = {__builtin_amdgcn_sqrtf(om.x), __builtin_amdgcn_sqrtf(om.y)};
        const f32x2 uv = {bf2f(ub[((r & 3) + 8 * (r >> 2)) * UT_STRIDE]), bf2f(ub[(((r + 1) & 3) + 8 * ((r + 1) >> 2)) * UT_STRIDE])};
        const f32x2 bv = (mult * ii) * uv;
        a[r] = av.x; a[r + 1] = av.y; bb[r] = bv.x; bb[r + 1] = bv.y; }
}
#define MEMFENCE() asm volatile("" ::: "memory")
template <int dir> __device__ __forceinline__ float lru_scan(int lane, float hin, const f32x16& a, f32x16& bb, float* Atot) {
    const bool hi = (lane >> 5) != 0;
    const bool own_first = dir == 0 ? !hi : hi;
    float oA[4], oB[4];
#pragma unroll
    for (int q = 0; q < 4; ++q) {
        const float a0 = a[4 * q], a1 = a[4 * q + 1], a2 = a[4 * q + 2], a3 = a[4 * q + 3];
        const float b0 = bb[4 * q], b1 = bb[4 * q + 1], b2 = bb[4 * q + 2], b3 = bb[4 * q + 3];
        oA[q] = (a0 * a1) * (a2 * a3);
        oB[q] = dir == 0 ? ((b0 * a1 + b1) * a2 + b2) * a3 + b3 : ((b3 * a2 + b2) * a1 + b1) * a0 + b0; }
    float h = hin, At = 1.0f; float cin[4];
#pragma unroll
    for (int s = 0; s < 4; ++s) { const int q = dir == 0 ? s : 3 - s;
        const float pA = __shfl_xor(oA[q], 32), pB = __shfl_xor(oB[q], 32);
        const float A1 = own_first ? oA[q] : pA, B1 = own_first ? oB[q] : pB, A2 = own_first ? pA : oA[q], B2 = own_first ? pB : oB[q];
        const float h1 = A1 * h + B1, h2 = A2 * h1 + B2;
        cin[q] = own_first ? h : h1; h = h2; At *= A1 * A2; }
#pragma unroll
    for (int q = 0; q < 4; ++q) { float x = cin[q];
        if (dir == 0) {
#pragma unroll
            for (int j = 0; j < 4; ++j) { x = a[4 * q + j] * x + bb[4 * q + j]; bb[4 * q + j] = x; }
        } else {
#pragma unroll
            for (int j = 3; j >= 0; --j) { x = a[4 * q + j] * x + bb[4 * q + j]; bb[4 * q + j] = x; }
        } }
    *Atot = At; return h;
}
__device__ __forceinline__ void lru_a_phase(Frame& F, int l) {
    relaunder(F);
    LAS bf16* ut = (LAS bf16*)F.lds;
    float* SM = WSP(float, WS_SUMM);
    constexpr int NUNIT = 512 + 2 * (NCHUNK - 512);
    int un = F.wg; UWin win;
    if (un < NUNIT) lru_issue_u(F, un < 512 ? un : 512 + ((un - 512) >> 1), win);
    for (; un < NUNIT; un += F.G) {
        const int cid = un < 512 ? un : 512 + ((un - 512) >> 1), nbsel = un < 512 ? -1 : ((un - 512) & 1);
        LruOps o; lru_load_ops<0>(F, l, nbsel < 0 ? 0 : nbsel, o);
        lru_finish_u(F, l, cid, win, ut);
        LDS_WAIT(); __syncthreads();
        if (un + F.G < NUNIT) { const int u2 = un + F.G; lru_issue_u(F, u2 < 512 ? u2 : 512 + ((u2 - 512) >> 1), win); }
#pragma unroll
        for (int nb = 0; nb < 2; ++nb) { const int ch = F.wave * 64 + nb * 32 + (F.lane & 31);
            if (nbsel >= 0 && nb != nbsel) continue;
            f32x16 a, bb; float A0, A1;
            lru_gates<0>(F, o, ut, 0, a, bb); lru_elem<0>(F, o, ut, nb, 0, a, bb); const float B0 = lru_scan<0>(F.lane, 0.0f, a, bb, &A0);
            lru_gates<0>(F, o, ut, 1, a, bb); MEMFENCE(); lru_load_ops<1>(F, l, nb, o); MEMFENCE();
            lru_elem<0>(F, o, ut, nb, 1, a, bb); const float B1 = lru_scan<0>(F.lane, B0, a, bb, &A1);
            if (F.lane < 32) { SM[((size_t)(cid * 2 + 0) * 2 + 0) * 512 + ch] = A0 * A1; SM[((size_t)(cid * 2 + 0) * 2 + 1) * 512 + ch] = B1; }
            lru_gates<1>(F, o, ut, 1, a, bb); lru_elem<1>(F, o, ut, nb, 1, a, bb); const float C1 = lru_scan<1>(F.lane, 0.0f, a, bb, &A1);
            lru_gates<1>(F, o, ut, 0, a, bb); if (nb == 0 && nbsel < 0) { MEMFENCE(); lru_load_ops<0>(F, l, 1, o); MEMFENCE(); }
            lru_elem<1>(F, o, ut, nb, 0, a, bb); const float C0 = lru_scan<1>(F.lane, C1, a, bb, &A0);
            if (F.lane < 32) { SM[((size_t)(cid * 2 + 1) * 2 + 0) * 512 + ch] = A0 * A1; SM[((size_t)(cid * 2 + 1) * 2 + 1) * 512 + ch] = C0; }
        }
        __syncthreads();
    }
}
__device__ __forceinline__ int carry_cid(int b, int dir, int st) { return dir == 0 ? (st < 4 ? 512 + 4 * b + st : 128 * b + st - 4) : (st < 4 ? 512 + 4 * b + 3 - st : 128 * b + 131 - st); }
__device__ __forceinline__ void s3_carries(Frame& F, int wv  ) {
    const int part = F.lane >> 3, seq = wv * 8 + (F.lane & 7), b = seq >> 10, dir = (seq >> 9) & 1, ch = seq & 511;
    const int s0 = part * 16 + (part < 4 ? part : 4), len = part < 4 ? 17 : 16;
    const float* __restrict__ SM = WSP(float, WS_SUMM); float* __restrict__ CR = WSP(float, WS_CARRY);
    float A[17], B[17];
#pragma unroll
    for (int j = 0; j < 17; ++j) { const int st = s0 + (j < len ? j : 0), cid = carry_cid(b, dir, st);
        A[j] = SM[((size_t)(cid * 2 + dir) * 2 + 0) * 512 + ch]; B[j] = SM[((size_t)(cid * 2 + dir) * 2 + 1) * 512 + ch]; }
    float At = 1.f, Bt = 0.f;
#pragma unroll
    for (int j = 0; j < 17; ++j) if (j < len) { Bt = A[j] * Bt + B[j]; At *= A[j]; }
#pragma unroll
    for (int d = 8; d < 64; d <<= 1) { const float pA = __shfl_up(At, d), pB = __shfl_up(Bt, d); if (F.lane >= d) { Bt = At * pB + Bt; At = At * pA; } }
    float h = __shfl_up(Bt, 8); if (part == 0) h = 0.f;
#pragma unroll
    for (int j = 0; j < 17; ++j) if (j < len) { const int cid = carry_cid(b, dir, s0 + j); CR[(size_t)(cid * 2 + dir) * 512 + ch] = h; h = A[j] * h + B[j]; }
}
__device__ __forceinline__ float gelu_tanh(float x) { const float u = x * x, t = x * __builtin_fmaf(u, -0.10294324f, -2.3022082f);
    return x * __builtin_amdgcn_rcpf(1.0f + __builtin_amdgcn_exp2f(t)); }
__device__ __forceinline__ void lru_b_issue_g(Frame& F, int cid, v4u (&gv)[8]) {
    const bf16* PX = WSP(bf16, WS_REGA); const int row0 = cid * 64;
#pragma unroll
    for (int i = 0; i < 8; ++i) { const int q = F.tid + NTHR * i, tok = q >> 6, cg = q & 63; gv[i] = *(const v4u*)(PX + (size_t)(row0 + tok) * PXC + 512 + cg * 8); }
}
__device__ __forceinline__ void lru_b_phase(Frame& F, int l, int nc) {
    relaunder(F);
    LAS bf16* ut = (LAS bf16*)F.lds; LAS bf16* gt = (LAS bf16*)(F.lds + UT_BYTES);
    const float* CR = WSP(float, WS_CARRY); bf16* Y = WSP(bf16, WS_Y);
    const int hh = F.lane >> 5, ln = F.lane & 31;
    int cid = F.wg; UWin win;
    if (cid < nc) lru_issue_u(F, cid, win);
    for (; cid < nc; cid += F.G) {
        const int row0 = cid * 64;
        v4u gv[8]; lru_b_issue_g(F, cid, gv);
        LruOps o; lru_load_ops<0>(F, l, 0, o);
        float cr0 = CR[(size_t)(cid * 2 + 0) * 512 + F.wave * 64 + ln], cr1 = CR[(size_t)(cid * 2 + 1) * 512 + F.wave * 64 + ln];
        lru_finish_u(F, l, cid, win, ut);
#pragma unroll
        for (int i = 0; i < 8; ++i) { const int q = F.tid + NTHR * i, tok = q >> 6, cg = q & 63; *(LAS v4u*)(gt + tok * UT_STRIDE + cg * 8) = gv[i]; }
        LDS_WAIT(); __syncthreads();
        if (cid + F.G < nc) lru_issue_u(F, cid + F.G, win);
#pragma unroll
        for (int nb = 0; nb < 2; ++nb) { const int ch = F.wave * 64 + nb * 32 + ln;
            f32x16 hs0, hs1, a, bb; float At;
            lru_gates<0>(F, o, ut, 0, a, bb); lru_elem<0>(F, o, ut, nb, 0, a, bb); const float hm0 = lru_scan<0>(F.lane, cr0, a, bb, &At); hs0 = bb;
            lru_gates<0>(F, o, ut, 1, a, bb); MEMFENCE(); lru_load_ops<1>(F, l, nb, o); MEMFENCE();
            lru_elem<0>(F, o, ut, nb, 1, a, bb); (void)lru_scan<0>(F.lane, hm0, a, bb, &At); hs1 = bb;
            lru_gates<1>(F, o, ut, 1, a, bb); lru_elem<1>(F, o, ut, nb, 1, a, bb); const float hm1 = lru_scan<1>(F.lane, cr1, a, bb, &At); hs1 += bb;
            lru_gates<1>(F, o, ut, 0, a, bb);
            if (nb == 0) { MEMFENCE(); lru_load_ops<0>(F, l, 1, o); cr0 = CR[(size_t)(cid * 2 + 0) * 512 + ch + 32]; cr1 = CR[(size_t)(cid * 2 + 1) * 512 + ch + 32]; MEMFENCE(); }
            lru_elem<1>(F, o, ut, nb, 0, a, bb); (void)lru_scan<1>(F.lane, hm1, a, bb, &At); hs0 += bb;
            LAS bf16* gb = gt + (4 * hh) * UT_STRIDE + ch;
#pragma unroll
            for (int r = 0; r < 16; ++r) { LAS bf16* p = gb + ((r & 3) + 8 * (r >> 2)) * UT_STRIDE;
                const float g = bf2f(*p); *p = (bf16)f2bf(hs0[r] * gelu_tanh(g)); }
#pragma unroll
            for (int r = 0; r < 16; ++r) { LAS bf16* p = gb + (32 + (r & 3) + 8 * (r >> 2)) * UT_STRIDE;
                const float g = bf2f(*p); *p = (bf16)f2bf(hs1[r] * gelu_tanh(g)); }
        }
        LDS_WAIT(); __syncthreads();
        {
            const int tok = F.tid >> 3, seg = F.tid & 7; const LAS bf16* p = gt + tok * UT_STRIDE + 64 * seg;
            u16x8 v[8]; float ss = 0.f;
#pragma unroll
            for (int j = 0; j < 8; ++j) { v[j] = *(const LAS u16x8*)(p + 8 * j);
#pragma unroll
                for (int e = 0; e < 8; ++e) { const float f = bf2f(v[j][e]); ss += f * f; } }
            ss += __shfl_xor(ss, 1); ss += __shfl_xor(ss, 2); ss += __shfl_xor(ss, 4);
            const float rstd = rsq_(ss * (1.0f / 512.0f) + EPS);
            const float* g = INP(I_GOUT) + l * 1024 + 64 * seg; bf16* op = Y + (size_t)(row0 + tok) * D + 64 * seg;
#pragma unroll
            for (int j = 0; j < 8; ++j) { const f32x4 g0 = *(const f32x4*)(g + 8 * j), g1 = *(const f32x4*)(g + 8 * j + 4);
                v4u w; w.x = pk2(bf2f(v[j][0]) * rstd * g0.x, bf2f(v[j][1]) * rstd * g0.y); w.y = pk2(bf2f(v[j][2]) * rstd * g0.z, bf2f(v[j][3]) * rstd * g0.w);
                w.z = pk2(bf2f(v[j][4]) * rstd * g1.x, bf2f(v[j][5]) * rstd * g1.y); w.w = pk2(bf2f(v[j][6]) * rstd * g1.z, bf2f(v[j][7]) * rstd * g1.w);
                *(v4u*)(op + 8 * j) = w; } }
        __syncthreads();
    }
}
struct ScWin { u16x8 pp[4], bv[2]; };
__device__ __forceinline__ void sc_issue(Frame& F, int hu, ScWin& w) {
    const bf16* PX = WSP(bf16, WS_REGA); const int cid = hu >> 1, row0 = hu * 32, c0 = 8 * (F.tid & 31), t0 = (F.tid >> 5) * 2; int lo, hi; lru_bounds(cid, lo, hi);
#pragma unroll
    for (int k = 0; k < 4; ++k) { const int r2 = row0 + t0 - 1 + k, rc = r2 < lo ? lo : (r2 >= hi ? hi - 1 : r2);
        w.pp[k] = *(const u16x8*)(PX + (size_t)rc * PXC + 1280 + c0); }
#pragma unroll
    for (int t = 0; t < 2; ++t) w.bv[t] = *(const u16x8*)(PX + (size_t)(row0 + t0 + t) * PXC + 1024 + c0);
}
__device__ __forceinline__ void sc_phase(Frame& F, int l, int nc, int wg0, int nwg) {
    relaunder(F);
    if (F.wg < wg0) return;
    bf16* Y = WSP(bf16, WS_Y);
    const int c0 = 8 * (F.tid & 31), t0 = (F.tid >> 5) * 2, nh = 2 * nc;
    f32x4 w[3][2], gg[2];
#pragma unroll
    for (int k = 0; k < 3; ++k) { w[k][0] = *(const f32x4*)(INP(I_SCW) + (l * 3 + k) * 256 + c0); w[k][1] = *(const f32x4*)(INP(I_SCW) + (l * 3 + k) * 256 + c0 + 4); }
    gg[0] = *(const f32x4*)(INP(I_GOUT) + l * 1024 + 512 + c0); gg[1] = *(const f32x4*)(INP(I_GOUT) + l * 1024 + 512 + c0 + 4);
    int hu = F.wg - wg0; ScWin cur;
    if (hu < nh) sc_issue(F, hu, cur);
    for (; hu < nh; hu += nwg) {
        ScWin nxt; const bool more = hu + nwg < nh;
        if (more) sc_issue(F, hu + nwg, nxt);
        const int row0 = hu * 32; int lo, hi; lru_bounds(hu >> 1, lo, hi);
        f32x4 p0[4], p1[4];
#pragma unroll
        for (int k = 0; k < 4; ++k) { const int r2 = row0 + t0 - 1 + k; const float ok = (r2 >= lo && r2 < hi) ? 1.0f : 0.0f;
            p0[k] = (f32x4){bf2f(cur.pp[k][0]), bf2f(cur.pp[k][1]), bf2f(cur.pp[k][2]), bf2f(cur.pp[k][3])} * ok;
            p1[k] = (f32x4){bf2f(cur.pp[k][4]), bf2f(cur.pp[k][5]), bf2f(cur.pp[k][6]), bf2f(cur.pp[k][7])} * ok; }
#pragma unroll
        for (int t = 0; t < 2; ++t) { const u16x8 bv = cur.bv[t];
            f32x4 a0 = (w[0][0] * p0[t] + w[1][0] * p0[t + 1] + w[2][0] * p0[t + 2]) * (f32x4){bf2f(bv[0]), bf2f(bv[1]), bf2f(bv[2]), bf2f(bv[3])};
            f32x4 a1 = (w[0][1] * p1[t] + w[1][1] * p1[t + 1] + w[2][1] * p1[t + 2]) * (f32x4){bf2f(bv[4]), bf2f(bv[5]), bf2f(bv[6]), bf2f(bv[7])};
            float ss = (a0.x * a0.x + a0.y * a0.y) + (a0.z * a0.z + a0.w * a0.w) + (a1.x * a1.x + a1.y * a1.y) + (a1.z * a1.z + a1.w * a1.w);
            ss += __shfl_xor(ss, 1); ss += __shfl_xor(ss, 2); ss += __shfl_xor(ss, 4); ss += __shfl_xor(ss, 8); ss += __shfl_xor(ss, 16);
            const float rstd = rsq_(ss * (1.0f / 256.0f) + EPS);
            a0 = a0 * rstd * gg[0]; a1 = a1 * rstd * gg[1];
            v4u wv; wv.x = pk2(a0.x, a0.y); wv.y = pk2(a0.z, a0.w); wv.z = pk2(a1.x, a1.y); wv.w = pk2(a1.z, a1.w);
            *(v4u*)(Y + (size_t)(row0 + t0 + t) * D + 512 + c0) = wv; }
        if (more) cur = nxt;
    }
}

__device__ __forceinline__ void s6_norm2_router(Frame& F, int l, int pair0, int npairs, int gw, int NGW) {
    LAS float* wP = (LAS float*)F.lds;
    for (int c = F.tid; c < 1024; c += NTHR) { const float* w = INP(I_WRT) + (size_t)l * 16384 + c * 16;
        const int h = c >> 9, ln = (c & 511) >> 3, q = (c >> 2) & 1, i = c & 3, base = (h * 2 + q) * 256 + 4 * ln + i;
        const f32x4 w0 = *(const f32x4*)w, w1 = *(const f32x4*)(w + 4), w2 = *(const f32x4*)(w + 8), w3 = *(const f32x4*)(w + 12);
        const float wv[16] = {w0.x, w0.y, w0.z, w0.w, w1.x, w1.y, w1.z, w1.w, w2.x, w2.y, w2.z, w2.w, w3.x, w3.y, w3.z, w3.w};
#pragma unroll
        for (int e = 0; e < 16; ++e) wP[e * 1024 + base] = wv[e]; }
    LDS_WAIT(); __syncthreads();
    const float* MS = WSP(float, WS_MODS) + (size_t)l * 5 * 6144; bf16* HX = HXP(); int* ENT = WSP(int, WS_ENT); const bf16* XB = XBP();
    const float* g2 = INP(I_GN2) + l * 1024;
    const bool up32 = (F.lane & 32) != 0, up16 = (F.lane & 16) != 0, up8 = (F.lane & 8) != 0, up4 = (F.lane & 4) != 0, up2 = (F.lane & 2) != 0;
    v4u ra_[2], rb_[2];
    if (pair0 + gw < npairs) { const bf16* xr = XB + (size_t)(2 * (pair0 + gw)) * D;
#pragma unroll
        for (int h = 0; h < 2; ++h) { ra_[h] = *(const v4u*)(xr + 8 * F.lane + 512 * h); rb_[h] = *(const v4u*)(xr + D + 8 * F.lane + 512 * h); } }
    for (int rp = pair0 + gw; rp < npairs; rp += NGW) {
        const int ra = 2 * rp; const bool more = rp + NGW < npairs;
        v4u na_[2], nb_[2];
        if (more) { const bf16* xr = XB + (size_t)(2 * (rp + NGW)) * D;
#pragma unroll
            for (int h = 0; h < 2; ++h) { na_[h] = *(const v4u*)(xr + 8 * F.lane + 512 * h); nb_[h] = *(const v4u*)(xr + D + 8 * F.lane + 512 * h); } }
        f32x4 va[4], vb[4];
#pragma unroll
        for (int h = 0; h < 2; ++h) {
            va[2 * h] = (f32x4){bf2f(ra_[h].x & 0xffffu), bf2f(ra_[h].x >> 16), bf2f(ra_[h].y & 0xffffu), bf2f(ra_[h].y >> 16)}; va[2 * h + 1] = (f32x4){bf2f(ra_[h].z & 0xffffu), bf2f(ra_[h].z >> 16), bf2f(ra_[h].w & 0xffffu), bf2f(ra_[h].w >> 16)};
            vb[2 * h] = (f32x4){bf2f(rb_[h].x & 0xffffu), bf2f(rb_[h].x >> 16), bf2f(rb_[h].y & 0xffffu), bf2f(rb_[h].y >> 16)}; vb[2 * h + 1] = (f32x4){bf2f(rb_[h].z & 0xffffu), bf2f(rb_[h].z >> 16), bf2f(rb_[h].w & 0xffffu), bf2f(rb_[h].w >> 16)}; }
        float sa = 0.f, sb = 0.f;
#pragma unroll
        for (int j = 0; j < 4; ++j) {
            sa += (va[j].x * va[j].x + va[j].y * va[j].y) + (va[j].z * va[j].z + va[j].w * va[j].w); sb += (vb[j].x * vb[j].x + vb[j].y * vb[j].y) + (vb[j].z * vb[j].z + vb[j].w * vb[j].w); }
        const float ra_std = rsq_(wave_sum_fast(sa) * (1.0f / D) + EPS), rb_std = rsq_(wave_sum_fast(sb) * (1.0f / D) + EPS);
        const float* m = MS + (size_t)row_set(ra) * 6144;
#pragma unroll
        for (int j = 0; j < 4; ++j) { const int c = ROWCOL(F.lane, j);
            const f32x4 gg = *(const f32x4*)(g2 + c), sh = *(const f32x4*)(m + 3 * 1024 + c), sc = *(const f32x4*)(m + 4 * 1024 + c) + 1.0f;
            va[j] = (va[j] * ra_std * gg) * sc + sh; vb[j] = (vb[j] * rb_std * gg) * sc + sh; }
        store_row8(HX + (size_t)ra * D, F.lane, va); store_row8(HX + (size_t)(ra + 1) * D, F.lane, vb);
        float lg[32];
#pragma unroll
        for (int e = 0; e < 16; ++e) { float a = 0.f, b = 0.f;
#pragma unroll
            for (int j = 0; j < 4; ++j) { const f32x4 w = *(const LAS f32x4*)(wP + e * 1024 + j * 256 + 4 * F.lane);
                a += (va[j].x * w.x + va[j].y * w.y) + (va[j].z * w.z + va[j].w * w.w); b += (vb[j].x * w.x + vb[j].y * w.y) + (vb[j].z * w.z + vb[j].w * w.w); }
            lg[e] = a; lg[16 + e] = b; }
#define RS_STEP(n, msk, up) _Pragma("unroll") for (int i = 0; i < (n) / 2; ++i) { const float keep = (up) ? lg[i + (n) / 2] : lg[i], send = (up) ? lg[i] : lg[i + (n) / 2]; lg[i] = keep + __shfl_xor(send, (msk)); }
        RS_STEP(32, 32, up32) RS_STEP(16, 16, up16) RS_STEP(8, 8, up8) RS_STEP(4, 4, up4) RS_STEP(2, 2, up2)
#undef RS_STEP
        float v = lg[0] + __shfl_xor(lg[0], 1);
        float mx = row_max16(v); mx = fmaxf(mx, __shfl_xor(mx, 16));
        const float ex = __expf(v - mx); float den = row_sum16(ex); den += __shfl_xor(den, 16);
        const float p = 2.0f * ex / den;
        if ((F.lane & 1) == 0) { const int row = ra + (F.lane >> 5), e = (F.lane >> 1) & 15;
            if (row < NLAT) WSP(float, WS_AFFL)[((size_t)((row >> 13) * 16 + e)) * SEQ + (row & (SEQ - 1))] = p;
            else { const int rc = row - NLAT; WSP(float, WS_AFFC)[((size_t)((rc >> 8) * 16 + e)) * CTXL + (rc & (CTXL - 1))] = p; }
            ENT[(size_t)row * 16 + e] = -1; }
        if (more) {
#pragma unroll
            for (int h = 0; h < 2; ++h) { ra_[h] = na_[h]; rb_[h] = nb_[h]; } }
    }
    __syncthreads();
}
__device__ __forceinline__ void s7_topk_problem(Frame& F, const float* aff, int n, int cap, int slab_base, int tokrow_base, int e) {
    LAS unsigned* keys = (LAS unsigned*)F.lds;
    LAS unsigned* hist = keys + 8192;
    LAS unsigned* wtot = hist + 256;
    LAS unsigned* ctl = wtot + 16;
    if (n == SEQ) {
        float kv[16];
#pragma unroll
        for (int i = 0; i < 16; ++i) kv[i] = aff[F.tid + NTHR * i];
#pragma unroll
        for (int i = 0; i < 16; ++i) keys[F.tid + NTHR * i] = __builtin_bit_cast(unsigned, kv[i]);
    } else for (int i = F.tid; i < n; i += NTHR) keys[i] = __builtin_bit_cast(unsigned, aff[i]);
    unsigned prefix = 0u, mask = 0u; int kk = cap;
    for (int pass = 0; pass < 4; ++pass) { const int shift = 24 - 8 * pass;
        if (F.tid < 256) hist[F.tid] = 0u;
        LDS_WAIT(); __syncthreads();
        for (int i = F.tid; i < n; i += NTHR) { const unsigned k = keys[i]; if ((k & mask) == prefix) atomicAdd((unsigned*)&hist[(k >> shift) & 255u], 1u); }
        LDS_WAIT(); __syncthreads();
        if (F.wave == 0) {
            const v4u c = *(const LAS v4u*)(hist + 4 * F.lane); const unsigned s4 = c.x + c.y + c.z + c.w; unsigned suf = s4;
#pragma unroll
            for (int d = 1; d < 64; d <<= 1) { const unsigned t = __shfl_down(suf, d); if (F.lane + d < 64) suf += t; }
            const unsigned above = suf - s4;
            if (above < (unsigned)kk && suf >= (unsigned)kk) { unsigned cum = above; int bin;
                if (cum + c.w >= (unsigned)kk) bin = 3; else { cum += c.w; if (cum + c.z >= (unsigned)kk) bin = 2; else { cum += c.z; if (cum + c.y >= (unsigned)kk) bin = 1; else { cum += c.y; bin = 0; } } }
                ctl[0] = (unsigned)(4 * F.lane + bin); ctl[1] = (unsigned)kk - cum; } }
        LDS_WAIT(); __syncthreads();
        prefix |= ctl[0] << shift; mask |= 0xFFu << shift; kk = (int)ctl[1];
        __syncthreads();
    }
    const unsigned T = prefix;
    const int per = (n + NTHR - 1) / NTHR, i0 = F.tid * per;
    unsigned ngt = 0u, neq = 0u;
    for (int i = i0; i < i0 + per && i < n; ++i) { const unsigned k = keys[i]; ngt += k > T; neq += k == T; }
    unsigned igt = ngt, ieq = neq;
#pragma unroll
    for (int d = 1; d < 64; d <<= 1) { const unsigned a = __shfl_up(igt, d), b = __shfl_up(ieq, d); if (F.lane >= d) { igt += a; ieq += b; } }
    if (F.lane == 63) { wtot[2 * F.wave] = igt; wtot[2 * F.wave + 1] = ieq; }
    LDS_WAIT(); __syncthreads();
    unsigned bgt = igt - ngt, beq = ieq - neq;
    for (int w = 0; w < F.wave; ++w) { bgt += wtot[2 * w]; beq += wtot[2 * w + 1]; }
    int* IDX = WSP(int, WS_IDX); float* GV = WSP(float, WS_GVAL); int* ENT = WSP(int, WS_ENT);
    for (int i = i0; i < i0 + per && i < n; ++i) { const unsigned k = keys[i];
        const bool sel = k > T || (k == T && (int)beq < kk);
        if (sel) { const int slot = (int)bgt + ((int)beq < kk ? (int)beq : kk); const int sr = slab_base + slot, tr = tokrow_base + i;
            IDX[sr] = tr; GV[sr] = __builtin_bit_cast(float, k); ENT[(size_t)tr * 16 + e] = sr; }
        bgt += k > T; beq += k == T; }
    __syncthreads();
}
__device__ __forceinline__ void s8_gather(Frame& F, bool do_ctx) {
    const int gw = F.wg * NWAVES + F.wave, NGW = F.G * NWAVES;
    const int* IDX = WSP(int, WS_IDX); const bf16* HX = HXP(); bf16* XE = WSP(bf16, WS_REGB);
    const int total = SLAB_L + (do_ctx ? NE * 128 : 0);
    for (int i = gw; i < total; i += NGW) {
        const int sr = i < SLAB_L ? i : SLAB_L + ((i - SLAB_L) >> 7) * 256 + ((i - SLAB_L) & 127);
        const int tr = IDX[sr];
        const v4u a = *(const v4u*)(HX + (size_t)tr * D + 8 * F.lane), b = *(const v4u*)(HX + (size_t)tr * D + 512 + 8 * F.lane);
        *(v4u*)(XE + (size_t)sr * D + 8 * F.lane) = a; *(v4u*)(XE + (size_t)sr * D + 512 + 8 * F.lane) = b; }
}
__device__ __forceinline__ void s11_finish_row(Frame& F, int l, int row, bf16* xr, f32x4 (&v)[4], const f32x4 (&acc)[4], bool last) {
    const float* MS = WSP(float, WS_MODS); const int s = row_set(row);
    const float* gate = MS + ((size_t)l * 5 + s) * 6144 + 5 * 1024;
#pragma unroll
    for (int j = 0; j < 4; ++j) v[j] += *(const f32x4*)(gate + ROWCOL(F.lane, j)) * acc[j];
    if (!last) {
        store_row8(xr, F.lane, v);
        const float* m = MS + ((size_t)(l + 1) * 5 + s) * 6144;
        norm_mod_store8(v, INP(I_GN1) + (l + 1) * 1024, m, m + 1024, HXP() + (size_t)row * D, F.lane);
    } else {
        float ss = 0.f;
#pragma unroll
        for (int j = 0; j < 4; ++j) ss += (v[j].x * v[j].x + v[j].y * v[j].y) + (v[j].z * v[j].z + v[j].w * v[j].w);
        const float rstd = rsq_(wave_sum_fast(ss) * (1.0f / D) + EPS);
#pragma unroll
        for (int j = 0; j < 4; ++j) *(f32x4*)(OUTP() + (size_t)row * D + ROWCOL(F.lane, j)) = v[j] * rstd * *(const f32x4*)(INP(I_GF) + ROWCOL(F.lane, j));
    }
}
__device__ __forceinline__ void s11_combine(Frame& F, int l, bool do_ctx, bool last) {
    const int gw = F.wg * NWAVES + F.wave, NGW = F.G * NWAVES;
    const bf16* YS = WSP(bf16, WS_REGB); const int* ENT = WSP(int, WS_ENT); bf16* XB = XBP();
    const int npairs = (do_ctx ? NROW : NLAT) / 2;
    v4u ra_[2], rb_[2]; int ent = -1;
    if (gw < npairs) { const bf16* xr = XB + (size_t)(2 * gw) * D;
#pragma unroll
        for (int h = 0; h < 2; ++h) { ra_[h] = *(const v4u*)(xr + 8 * F.lane + 512 * h); rb_[h] = *(const v4u*)(xr + D + 8 * F.lane + 512 * h); }
        ent = F.lane < 32 ? ENT[(size_t)(2 * gw) * 16 + F.lane] : -1; }
    for (int rp = gw; rp < npairs; rp += NGW) {
        const int ra = 2 * rp; bf16* xa = XB + (size_t)ra * D; bf16* xb = xa + D;
        f32x4 aa[4], ab[4]; v4u na_[2], nb_[2]; int nent = -1; const bool more = rp + NGW < npairs;
#pragma unroll
        for (int j = 0; j < 4; ++j) { aa[j] = (f32x4){0.f, 0.f, 0.f, 0.f}; ab[j] = (f32x4){0.f, 0.f, 0.f, 0.f}; }
        if (more) { const int rn = 2 * (rp + NGW); const bf16* xr = XB + (size_t)rn * D;
#pragma unroll
            for (int h = 0; h < 2; ++h) { na_[h] = *(const v4u*)(xr + 8 * F.lane + 512 * h); nb_[h] = *(const v4u*)(xr + D + 8 * F.lane + 512 * h); }
            nent = F.lane < 32 ? ENT[(size_t)rn * 16 + F.lane] : -1; }
        const unsigned long long bm = __ballot(ent >= 0);
        unsigned ma = (unsigned)bm & 0xffffu, mb = ((unsigned)bm >> 16) & 0xffffu;
        do {
            int sa[4], sb[4]; float wa[4], wb[4];
#pragma unroll
            for (int j = 0; j < 4; ++j) {
                if (ma) { const int e = __builtin_ctz(ma); ma &= ma - 1; sa[j] = __builtin_amdgcn_readlane(ent, e); wa[j] = 1.f; } else { sa[j] = 0; wa[j] = 0.f; }
                if (mb) { const int e = __builtin_ctz(mb); mb &= mb - 1; sb[j] = __builtin_amdgcn_readlane(ent, 16 + e); wb[j] = 1.f; } else { sb[j] = 0; wb[j] = 0.f; } }
            v4u ya[4][2], yb[4][2];
#pragma unroll
            for (int j = 0; j < 4; ++j)
#pragma unroll
                for (int h = 0; h < 2; ++h) { ya[j][h] = *(const v4u*)(YS + (size_t)sa[j] * D + 8 * F.lane + 512 * h); yb[j][h] = *(const v4u*)(YS + (size_t)sb[j] * D + 8 * F.lane + 512 * h); }
#pragma unroll
            for (int j = 0; j < 4; ++j)
#pragma unroll
                for (int h = 0; h < 2; ++h) {
                    aa[2 * h].x += wa[j] * bf2f(ya[j][h].x & 0xffffu); aa[2 * h].y += wa[j] * bf2f(ya[j][h].x >> 16); aa[2 * h].z += wa[j] * bf2f(ya[j][h].y & 0xffffu); aa[2 * h].w += wa[j] * bf2f(ya[j][h].y >> 16);
                    aa[2 * h + 1].x += wa[j] * bf2f(ya[j][h].z & 0xffffu); aa[2 * h + 1].y += wa[j] * bf2f(ya[j][h].z >> 16); aa[2 * h + 1].z += wa[j] * bf2f(ya[j][h].w & 0xffffu); aa[2 * h + 1].w += wa[j] * bf2f(ya[j][h].w >> 16);
                    ab[2 * h].x += wb[j] * bf2f(yb[j][h].x & 0xffffu); ab[2 * h].y += wb[j] * bf2f(yb[j][h].x >> 16); ab[2 * h].z += wb[j] * bf2f(yb[j][h].y & 0xffffu); ab[2 * h].w += wb[j] * bf2f(yb[j][h].y >> 16);
                    ab[2 * h + 1].x += wb[j] * bf2f(yb[j][h].z & 0xffffu); ab[2 * h + 1].y += wb[j] * bf2f(yb[j][h].z >> 16); ab[2 * h + 1].z += wb[j] * bf2f(yb[j][h].w & 0xffffu); ab[2 * h + 1].w += wb[j] * bf2f(yb[j][h].w >> 16); }
        } while (ma | mb);
        f32x4 va[4], vb[4];
#pragma unroll
        for (int h = 0; h < 2; ++h) {
            va[2 * h] = (f32x4){bf2f(ra_[h].x & 0xffffu), bf2f(ra_[h].x >> 16), bf2f(ra_[h].y & 0xffffu), bf2f(ra_[h].y >> 16)}; va[2 * h + 1] = (f32x4){bf2f(ra_[h].z & 0xffffu), bf2f(ra_[h].z >> 16), bf2f(ra_[h].w & 0xffffu), bf2f(ra_[h].w >> 16)};
            vb[2 * h] = (f32x4){bf2f(rb_[h].x & 0xffffu), bf2f(rb_[h].x >> 16), bf2f(rb_[h].y & 0xffffu), bf2f(rb_[h].y >> 16)}; vb[2 * h + 1] = (f32x4){bf2f(rb_[h].z & 0xffffu), bf2f(rb_[h].z >> 16), bf2f(rb_[h].w & 0xffffu), bf2f(rb_[h].w >> 16)}; }
        s11_finish_row(F, l, ra, xa, va, aa, last);
        s11_finish_row(F, l, ra + 1, xb, vb, ab, last);
        if (more) { ent = nent;
#pragma unroll
            for (int h = 0; h < 2; ++h) { ra_[h] = na_[h]; rb_[h] = nb_[h]; } }
    }
}

constexpr int N_PHASES = 26;
#define PH_IN(k) (lo <= (k) && (k) < hi)
#define PH_SEAM(k) do { if ((k) + 1 < hi) xcd_barrier(bar); } while (0)
#ifndef DUP_PHASE
#define DUP_PHASE (-1)
#endif
#ifndef DUP_N
#define DUP_N 1
#endif
#define PH_BEGIN(k) if (PH_IN(k)) { for (int rep_ = 0; rep_ < ((k) == DUP_PHASE ? DUP_N : 1); ++rep_) { if (rep_) xcd_barrier(bar); relaunder(F);
#define PH_END(k) } PH_SEAM(k); }
template <int l> __device__ __forceinline__ void layer_steps(Frame& F, const Args& args, const XcdBarrier& bar, const int lo, const int hi) {
    constexpr int P0 = l == 0 ? 3 : 15;
    constexpr bool last = l == 1, do_ctx = !last;
    PH_BEGIN(P0 + 0)
        pg8::Gemm g{(pg8::bf16_t*)HXP(), WSP(pg8::bf16_t, WS_WIN) + (size_t)l * INC * 1024, NROW, INC, D, nullptr};
        pg8::StaticOrder S; S.init(NROW, INC, F.G, F.wg);
        pg8::EpiInProj E{WSP(pg8::bf16_t, WS_REGA), PXC};
        pg8::gemm_phase<pg8::EpiInProj, pg8::StaticOrder, true, true>(F.lds, g, S, E);
        PH_END(P0 + 0)
    PH_BEGIN(P0 + 1)
        for (int u = F.wg; u < NB * 64; u += F.G) dft1_unit(F, u >> 6, u & 63);
        lru_a_phase(F, l);
        if (F.wg >= 32) filler(F, 1, -1);
        PH_END(P0 + 1)
    PH_BEGIN(P0 + 2)
        if (F.wg >= 192) s3_carries(F, (F.wg - 192) * NWAVES + F.wave);
        { LAS bf16* t2l = (LAS bf16*)(F.lds + 67584);
          const bf16* T2 = WSP(bf16, WS_T2M);
          for (int i = F.tid; i < 64 * 16; i += NTHR) { const int r = i >> 4, c = i & 15; *(LAS v4u*)(t2l + r * 136 + c * 8) = *(const v4u*)(T2 + r * 128 + c * 8); }
          LDS_WAIT(); __syncthreads();
          if (do_ctx && F.wg < 16) { const int b = F.wg >> 2, mq = F.wg & 3;
              dft2_unit(F, l, WSP(bf16, WS_TCM), 512, 64 * mq, 4, WSP(bf16, WS_REGA) + (size_t)(NLAT + CTXL * b) * PXC + PX_Z, PXC, (size_t)64 * PXC, 0.0078125f, NLAT + CTXL * b + 64 * mq, 1, nullptr);
          } else { const int w0 = do_ctx ? 16 : 0, nw = F.G - w0;
              for (int u = F.wg - w0; u < NB * 128; u += nw) { const int b = u >> 7, kp = u & 127;
                  dft2_unit(F, l, WSP(bf16, WS_T2M), 128, 0, 1, WSP(bf16, WS_T1) + (size_t)(b * 128 + kp) * 64 * 512, 512, 0, 0.001381067932004976f, b * SEQ + kp, 128, t2l); } } }
        PH_END(P0 + 2)
    PH_BEGIN(P0 + 3)
        const int nc = do_ctx ? NCHUNK : 512;
        if (do_ctx) sc_phase(F, l, nc, 16, F.G - 16); else sc_phase(F, l, nc, 0, F.G);
        lru_b_phase(F, l, nc);
        if (do_ctx && F.wg >= 16) filler(F, 2, -1);
        PH_END(P0 + 3)
    PH_BEGIN(P0 + 4)
        pg8::Gemm g{WSP(pg8::bf16_t, WS_Y), WSP(pg8::bf16_t, WS_WOUT) + (size_t)l * 1024 * 1024, NLAT, D, D, nullptr};
        pg8::StaticOrder S; S.init(NLAT, D, F.G, F.wg);
        pg8::EpiResid E{INP(I_X), INP(I_CTX), (pg8::bf16_t*)XBP(), WSP(float, WS_MODS) + (size_t)l * 5 * 6144 + 2 * 1024, NLAT, l == 0};
        pg8::gemm_phase<pg8::EpiResid, pg8::StaticOrder, true, true>(F.lds, g, S, E);
        PH_END(P0 + 4)
    PH_BEGIN(P0 + 5)
        if (do_ctx) {
            int* IDX = WSP(int, WS_IDX); for (int i = F.wg * NTHR + F.tid; i < NE * 256; i += F.G * NTHR) IDX[SLAB_L + i] = NLAT;
            if (F.wg < 16) {
                pg8::Gemm g{WSP(pg8::bf16_t, WS_Y), WSP(pg8::bf16_t, WS_WOUT) + (size_t)l * 1024 * 1024, NROW, D, D, nullptr};
                pg8::CtxOrder S{F.wg};
                pg8::EpiResid E{INP(I_X), INP(I_CTX), (pg8::bf16_t*)XBP(), WSP(float, WS_MODS) + (size_t)l * 5 * 6144 + 2 * 1024, NLAT, l == 0};
                pg8::gemm_phase<pg8::EpiResid, pg8::CtxOrder, true, true>(F.lds, g, S, E);
                VM_WAIT(); __syncthreads();
                if (F.tid == 0) { unsigned* ctr = WSP(unsigned, WS_CTL) + 192 + 64 * l;
                    __builtin_amdgcn_fence(__ATOMIC_RELEASE, "agent"); VM_WAIT();
                    __hip_atomic_fetch_add(ctr, 1u, __ATOMIC_RELAXED, __HIP_MEMORY_SCOPE_AGENT);
                    unsigned sp = 0; while (__hip_atomic_load(ctr, __ATOMIC_RELAXED, __HIP_MEMORY_SCOPE_AGENT) < 16u && ++sp < (1u << 22)) __builtin_amdgcn_s_sleep(2);
                    __builtin_amdgcn_fence(__ATOMIC_ACQUIRE, "agent"); VM_WAIT(); }
                __syncthreads();
                relaunder(F);
                s6_norm2_router(F, l, NLAT / 2, NROW / 2, F.wg * NWAVES + F.wave, 16 * NWAVES);
            } else s6_norm2_router(F, l, 0, NLAT / 2, (F.wg - 16) * NWAVES + F.wave, (F.G - 16) * NWAVES);
        } else s6_norm2_router(F, l, 0, NLAT / 2, F.wg * NWAVES + F.wave, F.G * NWAVES);
        PH_END(P0 + 5)
    PH_BEGIN(P0 + 6)
        const int np = do_ctx ? 128 : 64;
        if (F.wg >= np) filler(F, 4, -1);
        for (int p = F.wg; p < np; p += F.G) {
            if (p < 64) { const int b = p >> 4, e = p & 15; s7_topk_problem(F, WSP(float, WS_AFFL) + (size_t)p * SEQ, SEQ, CAP_L, (b * 16 + e) * CAP_L, b * SEQ, e); }
            else { const int q = p - 64, b = q >> 4, e = q & 15; s7_topk_problem(F, WSP(float, WS_AFFC) + (size_t)q * CTXL, CTXL, CAP_C, SLAB_L + e * 256 + b * CAP_C, NLAT + b * CTXL, e); } }
        filler(F, 0, l);
        PH_END(P0 + 6)
    PH_BEGIN(P0 + 8)
        pg8::Gemm g{(pg8::bf16_t*)HXP(), WSP(pg8::bf16_t, WS_WGU + (size_t)l * WS_WEXP_L), SLAB_ROWS, NE * 2048, D, WSP(int, WS_IDX)};
        pg8::MoeOrder1 S{F.wg, do_ctx};
        pg8::EpiSwiGLU E{WSP(pg8::bf16_t, WS_REGA), D};
        pg8::gemm_phase<pg8::EpiSwiGLU, pg8::MoeOrder1, true, true, true>(F.lds, g, S, E);
        if (do_ctx && F.wg >= 128) filler(F, 5, -1);
        PH_END(P0 + 8)
    PH_BEGIN(P0 + 9)
        pg8::Gemm g{WSP(pg8::bf16_t, WS_REGA), WSP(pg8::bf16_t, WS_WD + (size_t)l * WS_WEXP_L), SLAB_ROWS, NE * 1024, D, nullptr};
        pg8::MoeOrder2 S{F.wg, do_ctx};
        pg8::EpiScaleBf16 E{WSP(pg8::bf16_t, WS_REGB), D, WSP(float, WS_GVAL)};
        pg8::gemm_phase<pg8::EpiScaleBf16, pg8::MoeOrder2, true, true>(F.lds, g, S, E);
        if (do_ctx && F.wg >= 64) filler(F, 4, -1);
        PH_END(P0 + 9)
    PH_BEGIN(P0 + 10) s11_combine(F, l, do_ctx, last); PH_END(P0 + 10)
}
__global__ void __launch_bounds__(NTHR, 2) fwd(Args args) {
    extern __shared__ __attribute__((aligned(16))) unsigned char lds_raw[];
    Frame F;
    F.lds = (LAS unsigned char*)lds_raw;
    F.tid = threadIdx.x; F.lane = F.tid & 63; F.wave = __builtin_amdgcn_readfirstlane(F.tid >> 6);
    F.G = gridDim.x; F.wg = blockIdx.x;
    volatile LAS unsigned* MISC = (volatile LAS unsigned*)(F.lds + MISC_OFF);
    if (F.tid < 64) MISC[F.tid] = 0u;
    if (F.tid == 0) { LAS unsigned long long* PT = (LAS unsigned long long*)(F.lds + PT_OFF);
#pragma unroll
        for (int i = 0; i < N_IN; ++i) PT[i] = (unsigned long long)args.in[i];
        PT[N_IN] = (unsigned long long)args.out; PT[N_IN + 1] = (unsigned long long)args.ws; }
    LDS_WAIT(); __syncthreads();
    const int lo = args.ph_lo, hi = args.ph_hi;
    unsigned* barw = (unsigned*)(args.ws + WS_CTL) + CW_BAR + args.bar_region * XCD_BAR_WORDS;
    XcdBarrier bar; bar.bar = barw; bar.x = 0; bar.st = MISC + 8;
    if (hi - lo > 1) bar = xcd_barrier_post(barw, MISC + 8);
    PH_BEGIN(0) p0_prep(F); PH_END(0)
    PH_BEGIN(1) p0b_mods(F); PH_END(1)
    PH_BEGIN(2) s0_norm1(F); PH_END(2)
    layer_steps<0>(F, args, bar, lo, hi);
    layer_steps<1>(F, args, bar, lo, hi);
}

extern "C" void kernel_launch(void* const* d_in, const int* in_sizes, int n_in, void* d_out, int out_size, void* d_ws, size_t ws_size, hipStream_t stream) {
    static int grid = 0;
    if (grid == 0) {
        if (n_in != N_IN || out_size != NLAT * D || ws_size < WS_END) { fprintf(stderr, "kernel_launch: unexpected shapes (n_in %d, out %d, ws %zu, need %zu)\n", n_in, out_size, ws_size, (size_t)WS_END); grid = -1; return; }
        int dev = 0, cus = 0, per_cu = 0;
        if (hipGetDevice(&dev) != hipSuccess || hipDeviceGetAttribute(&cus, hipDeviceAttributeMultiprocessorCount, dev) != hipSuccess) { grid = -1; return; }
        if (hipFuncSetAttribute((const void*)fwd, hipFuncAttributeMaxDynamicSharedMemorySize, LDS_BYTES) != hipSuccess) { fprintf(stderr, "kernel_launch: hipFuncSetAttribute failed\n"); grid = -1; return; }
        if (hipOccupancyMaxActiveBlocksPerMultiprocessor(&per_cu, (const void*)fwd, NTHR, LDS_BYTES) != hipSuccess || per_cu < 1) { fprintf(stderr, "kernel_launch: occupancy query says %d\n", per_cu); }
        (void)hipGetLastError();
        grid = cus;
        if (grid != 256) { fprintf(stderr, "kernel_launch: needs a 256-CU device (got %d)\n", grid); grid = -1; return; }
    }
    if (grid < 0) return;
    (void)hipMemsetAsync((char*)d_ws + WS_CTL, 0, CTL_ZERO_BYTES, stream);
    Args a{};
    for (int i = 0; i < N_IN; ++i) a.in[i] = (const float*)d_in[i];
    a.out = (float*)d_out; a.ws = (unsigned char*)d_ws;
#ifndef ONE_LAUNCH
#define ONE_LAUNCH 1
#endif
#ifndef PROBE_K
#define PROBE_K (-1)
#endif
#ifndef PROBE_N
#define PROBE_N 1
#endif
    if (PROBE_K >= 0) {
        a.ph_lo = 0; a.ph_hi = PROBE_K + 1; a.bar_region = 0; hipLaunchKernelGGL(fwd, dim3(grid), dim3(NTHR), LDS_BYTES, stream, a);
        for (int r = 1; r < PROBE_N; ++r) { a.ph_lo = PROBE_K; a.ph_hi = PROBE_K + 1; hipLaunchKernelGGL(fwd, dim3(grid), dim3(NTHR), LDS_BYTES, stream, a); }
        if (PROBE_K + 1 < N_PHASES) { a.ph_lo = PROBE_K + 1; a.ph_hi = N_PHASES; a.bar_region = 1; hipLaunchKernelGGL(fwd, dim3(grid), dim3(NTHR), LDS_BYTES, stream, a); }
    } else if (ONE_LAUNCH) { a.ph_lo = 0; a.ph_hi = N_PHASES; hipLaunchKernelGGL(fwd, dim3(grid), dim3(NTHR), LDS_BYTES, stream, a); }
    else for (int ph = 0; ph < N_PHASES; ++ph) { a.ph_lo = ph; a.ph_hi = ph + 1; hipLaunchKernelGGL(fwd, dim3(grid), dim3(NTHR), LDS_BYTES, stream, a); }
}
```

```cpp
#include <hip/hip_runtime.h>
#include <cstdio>
#include <cstdint>
#define LAS __attribute__((address_space(3)))
namespace pg8 {
#define PG8_LAS __attribute__((address_space(3)))
typedef unsigned short bf16_t;
typedef short bf16x8 __attribute__((ext_vector_type(8)));
typedef float f32x4 __attribute__((ext_vector_type(4)));
typedef unsigned u32x4 __attribute__((ext_vector_type(4)));
constexpr int BM = 256, BK = 64, HALF = 128, HTB = HALF * BK * 2  , STAGE_BYTES = 8 * HTB, NXCD = 8, WGM = 8;

__host__ __device__ __forceinline__ int lds_byte(int r, int c) { const int st = (r >> 4) * 2 + (c >> 5), rr = r & 15, cc = c & 31, ob = rr * 64 + cc * 2; return st * 1024 + (ob ^ (((ob >> 9) & 1) << 5)); }
__host__ __device__ __forceinline__ void stage_rc(int b, int& R, int& C) { const int st = b / 1024, sb = b % 1024, swz = sb ^ (((sb >> 9) & 1) << 5); R = (st >> 1) * 16 + swz / 64; C = (st & 1) * 32 + (swz % 64) / 2; }
__host__ __device__ __forceinline__ int perm32(int rho) { const int n = rho >> 4, i = rho & 15; return 8 * (i >> 2) + 4 * n + (i & 3); }

struct Unit { int pm, pn; };
struct Gemm { const bf16_t* A; const bf16_t* Bt; int M, N, K; const int* gidx; };

struct StaticOrder {
    int nM, nN, nwg, G, c;
    __host__ __device__ void init(int M, int N, int G_, int c_) { nM = M / BM; nN = N / BM; nwg = nM * nN; G = G_; c = c_; }
    __host__ __device__ bool next(int i, Unit& u) const {
        const long L = (long)i * G + c; if (L >= nwg) return false;
        int wgid = (int)L; { const int q = nwg / NXCD, r = nwg % NXCD, xcd = wgid % NXCD, off = wgid / NXCD; wgid = (xcd < r ? xcd * (q + 1) : r * (q + 1) + (xcd - r) * q) + off; }
        const int nig = WGM * nN, gid = wgid / nig, fm = gid * WGM, gsz = (nM - fm) < WGM ? (nM - fm) : WGM;
        u.pm = fm + ((wgid % nig) % gsz); u.pn = (wgid % nig) / gsz; return true;
    }
    __device__ __forceinline__ void a_ready(const Unit&) const {}
    __device__ __forceinline__ void done(const Unit&) const {}
};


__device__ __forceinline__ unsigned cvt_pk_bf16(float lo, float hi) { unsigned r; asm volatile("v_cvt_pk_bf16_f32 %0, %1, %2" : "=v"(r) : "v"(lo), "v"(hi)); return r; }

struct EpiBf16Plain {
    static constexpr bool PERM = true, AFTER_DRAIN = false;
    bf16_t* O; int ldc;
    __device__ __forceinline__ void operator()(const f32x4 (&acc)[2][2][4][2], const Unit& u, int wr, int wc, int fr, int fq) const {
        const int row0 = u.pm * BM + wr * 64 + fr; const int col0 = u.pn * BM + wc * 32 + 8 * fq;
#pragma unroll
        for (int ai = 0; ai < 2; ++ai)
#pragma unroll
            for (int m = 0; m < 4; ++m) { bf16_t* rowp = O + (size_t)(row0 + ai * HALF + m * 16) * ldc + col0;
#pragma unroll
                for (int bj = 0; bj < 2; ++bj) { const f32x4 v0 = acc[ai][bj][m][0], v1 = acc[ai][bj][m][1];
                    u32x4 w; w.x = cvt_pk_bf16(v0[0], v0[1]); w.y = cvt_pk_bf16(v0[2], v0[3]); w.z = cvt_pk_bf16(v1[0], v1[1]); w.w = cvt_pk_bf16(v1[2], v1[3]);
                    *(u32x4*)(rowp + bj * HALF) = w; } }
    }
};
struct EpiInProj {
    static constexpr bool PERM = true, AFTER_DRAIN = false;
    bf16_t* O; int ldc;
    __device__ __forceinline__ void operator()(const f32x4 (&acc)[2][2][4][2], const Unit& u, int wr, int wc, int fr, int fq) const {
        const int row0 = u.pm * BM + wr * 64 + fr;
        if (u.pn == 5 || u.pn == 6) { const int col0 = 1280 + (u.pn - 5) * HALF + wc * 32 + 8 * fq;
#pragma unroll
            for (int ai = 0; ai < 2; ++ai)
#pragma unroll
                for (int m = 0; m < 4; ++m) { const f32x4 v0 = acc[ai][0][m][0] * acc[ai][1][m][0], v1 = acc[ai][0][m][1] * acc[ai][1][m][1];
                    u32x4 w; w.x = cvt_pk_bf16(v0[0], v0[1]); w.y = cvt_pk_bf16(v0[2], v0[3]); w.z = cvt_pk_bf16(v1[0], v1[1]); w.w = cvt_pk_bf16(v1[2], v1[3]);
                    *(u32x4*)(O + (size_t)(row0 + ai * HALF + m * 16) * ldc + col0) = w; }
        } else { const int col0 = (u.pn < 5 ? u.pn : u.pn - 1) * BM + wc * 32 + 8 * fq;
#pragma unroll
            for (int ai = 0; ai < 2; ++ai)
#pragma unroll
                for (int m = 0; m < 4; ++m) { bf16_t* rowp = O + (size_t)(row0 + ai * HALF + m * 16) * ldc + col0;
#pragma unroll
                    for (int bj = 0; bj < 2; ++bj) { const f32x4 v0 = acc[ai][bj][m][0], v1 = acc[ai][bj][m][1];
                        u32x4 w; w.x = cvt_pk_bf16(v0[0], v0[1]); w.y = cvt_pk_bf16(v0[2], v0[3]); w.z = cvt_pk_bf16(v1[0], v1[1]); w.w = cvt_pk_bf16(v1[2], v1[3]);
                        *(u32x4*)(rowp + bj * HALF) = w; } }
        }
    }
};
struct EpiSwiGLU {
    static constexpr bool PERM = true, AFTER_DRAIN = false;
    bf16_t* H; int ldc;
    __device__ __forceinline__ void operator()(const f32x4 (&acc)[2][2][4][2], const Unit& u, int wr, int wc, int fr, int fq) const {
        const int row0 = u.pm * BM + wr * 64 + fr; const int col0 = (u.pn & 7) * HALF + wc * 32 + 8 * fq;
#pragma unroll
        for (int ai = 0; ai < 2; ++ai)
#pragma unroll
            for (int m = 0; m < 4; ++m) { bf16_t* rowp = H + (size_t)(row0 + ai * HALF + m * 16) * ldc + col0;
                float o[8];
#pragma unroll
                for (int n = 0; n < 2; ++n)
#pragma unroll
                    for (int i = 0; i < 4; ++i) { const float g = acc[ai][0][m][n][i], up = acc[ai][1][m][n][i];
                        o[n * 4 + i] = g * __builtin_amdgcn_rcpf(1.0f + __expf(-g)) * up; }
                u32x4 w; w.x = cvt_pk_bf16(o[0], o[1]); w.y = cvt_pk_bf16(o[2], o[3]); w.z = cvt_pk_bf16(o[4], o[5]); w.w = cvt_pk_bf16(o[6], o[7]);
                *(u32x4*)rowp = w; }
    }
};
struct EpiScaleBf16 {
    static constexpr bool PERM = true, AFTER_DRAIN = false;
    bf16_t* Y; int ldc; const float* gval;
    __device__ __forceinline__ void operator()(const f32x4 (&acc)[2][2][4][2], const Unit& u, int wr, int wc, int fr, int fq) const {
        const int row0 = u.pm * BM + wr * 64 + fr; const int col0 = (u.pn & 3) * BM + wc * 32 + 8 * fq;
#pragma unroll
        for (int ai = 0; ai < 2; ++ai)
#pragma unroll
            for (int m = 0; m < 4; ++m) { const int row = row0 + ai * HALF + m * 16; const float g = gval[row]; bf16_t* rowp = Y + (size_t)row * ldc + col0;
#pragma unroll
                for (int bj = 0; bj < 2; ++bj) { const f32x4 v0 = acc[ai][bj][m][0] * g, v1 = acc[ai][bj][m][1] * g;
                    u32x4 w; w.x = cvt_pk_bf16(v0[0], v0[1]); w.y = cvt_pk_bf16(v0[2], v0[3]); w.z = cvt_pk_bf16(v1[0], v1[1]); w.w = cvt_pk_bf16(v1[2], v1[3]);
                    *(u32x4*)(rowp + bj * HALF) = w; } }
    }
};
struct EpiResid {
    static constexpr bool PERM = true, AFTER_DRAIN = false;
    const float* xin_lat; const float* xin_ctx; bf16_t* xb; const float* gate  ; int nlat; bool in_f32;
    __device__ __forceinline__ void operator()(const f32x4 (&acc)[2][2][4][2], const Unit& u, int wr, int wc, int fr, int fq) const {
        const int trow = u.pm * BM; const bool isctx = trow >= nlat;
        const int s = isctx ? 4 : (trow >> 13);
        const float* xin = isctx ? xin_ctx - (size_t)nlat * 1024 : xin_lat;
        const float* gp = gate + (size_t)s * 6144;
        const int row0 = trow + wr * 64 + fr, col0 = u.pn * BM + wc * 32 + 8 * fq;
        f32x4 gv[2][2];
#pragma unroll
        for (int bj = 0; bj < 2; ++bj)
#pragma unroll
            for (int n = 0; n < 2; ++n) gv[bj][n] = *(const f32x4*)(gp + col0 + bj * HALF + 4 * n);
#pragma unroll
        for (int ai = 0; ai < 2; ++ai)
#pragma unroll
            for (int m = 0; m < 4; ++m) { const size_t off = (size_t)(row0 + ai * HALF + m * 16) * 1024 + col0;
#pragma unroll
                for (int bj = 0; bj < 2; ++bj) { f32x4 x0, x1;
                    if (in_f32) { x0 = *(const f32x4*)(xin + off + bj * HALF); x1 = *(const f32x4*)(xin + off + bj * HALF + 4); }
                    else { const u32x4 w = *(const u32x4*)(xb + off + bj * HALF);
                        x0 = (f32x4){__builtin_bit_cast(float, w.x << 16), __builtin_bit_cast(float, w.x & 0xffff0000u), __builtin_bit_cast(float, w.y << 16), __builtin_bit_cast(float, w.y & 0xffff0000u)};
                        x1 = (f32x4){__builtin_bit_cast(float, w.z << 16), __builtin_bit_cast(float, w.z & 0xffff0000u), __builtin_bit_cast(float, w.w << 16), __builtin_bit_cast(float, w.w & 0xffff0000u)}; }
                    x0 += gv[bj][0] * acc[ai][bj][m][0]; x1 += gv[bj][1] * acc[ai][bj][m][1];
                    u32x4 o; o.x = cvt_pk_bf16(x0[0], x0[1]); o.y = cvt_pk_bf16(x0[2], x0[3]); o.z = cvt_pk_bf16(x1[0], x1[1]); o.w = cvt_pk_bf16(x1[2], x1[3]);
                    *(u32x4*)(xb + off + bj * HALF) = o; } }
    }
};
struct MoeOrder1 {
    int c; bool ctx;
    __device__ __forceinline__ bool next(int i, Unit& u) const {
        if (i < 8) { const int P = i * 8 + (c & 7), j = c >> 3, e = P >> 2, b = P & 3; u.pm = (b * 16 + e) * 4 + (j >> 3); u.pn = e * 8 + (j & 7); return true; }
        if (i == 8 && ctx && c < 128) { const int e = c >> 3; u.pm = 256 + e; u.pn = e * 8 + (c & 7); return true; }
        return false;
    }
    __device__ __forceinline__ void a_ready(const Unit&) const {}
    __device__ __forceinline__ void done(const Unit&) const {}
};
struct CtxOrder {
    int c;
    __device__ __forceinline__ bool next(int i, Unit& u) const { if (i != 0 || c >= 16) return false; u.pm = 128 + (c >> 2); u.pn = c & 3; return true; }
    __device__ __forceinline__ void a_ready(const Unit&) const {}
    __device__ __forceinline__ void done(const Unit&) const {}
};
struct MoeOrder2 {
    int c; bool ctx;
    __device__ __forceinline__ bool next(int i, Unit& u) const {
        if (i < 4) { const int j = c >> 3, P = i * 16 + (c & 7) * 2 + (j >> 4), e = P >> 2, b = P & 3; u.pm = (b * 16 + e) * 4 + ((j >> 2) & 3); u.pn = e * 4 + (j & 3); return true; }
        if (i == 4 && ctx && c < 64) { const int e = c >> 2; u.pm = 256 + e; u.pn = e * 4 + (c & 3); return true; }
        return false;
    }
    __device__ __forceinline__ void a_ready(const Unit&) const {}
    __device__ __forceinline__ void done(const Unit&) const {}
};

template <class Epi, class Sched, bool ALIGN_EPI = false, bool SP2 = false, bool GATHER = false, int HALF_FROM_PM = (1 << 30)>
__device__ __forceinline__ void gemm_phase(PG8_LAS unsigned char* lds, const Gemm g, const Sched& S, const Epi& E) {
    const int tid = threadIdx.x, wid = __builtin_amdgcn_readfirstlane(tid >> 6), lane = tid & 63, wr = wid >> 2, wc = wid & 3, fr = lane & 15, fq = lane >> 4;
    const int K = g.K, nt = K / BK;
    unsigned voffA[2], voffB[2]; int rowA[2]; unsigned colA2[2];
#pragma unroll
    for (int i = 0; i < 2; ++i) { int R, C; stage_rc(tid * 16 + i * 8192, R, C); const int Rb = Epi::PERM ? ((R & ~31) + perm32(R & 31)) : R;
        voffA[i] = (unsigned)(R * K + C) * 2u; voffB[i] = (unsigned)(Rb * K + C) * 2u; rowA[i] = R; colA2[i] = (unsigned)C * 2u; }
    unsigned gA[2][2], gN[2][2], gS[2][2], gRaw[2][2];
#define PG8_VA(h) (GATHER ? gA[h] : voffA)
#define PG8_VS(h) (GATHER ? gS[h] : voffA)
#define PG8_IDX_ISSUE(u) do { _Pragma("unroll") for (int _h = 0; _h < 2; ++_h) _Pragma("unroll") for (int _i = 0; _i < 2; ++_i) { const int* _p = g.gidx + (u).pm * BM + _h * HALF + rowA[_i]; \
        asm volatile("global_load_dword %0, %1, off" : "=v"(gRaw[_h][_i]) : "v"(_p) : "memory"); } } while (0)
#define PG8_IDX_TAKE(dst) do { _Pragma("unroll") for (int _h = 0; _h < 2; ++_h) _Pragma("unroll") for (int _i = 0; _i < 2; ++_i) { asm volatile("" : "+v"(gRaw[_h][_i])); dst[_h][_i] = gRaw[_h][_i] * (unsigned)(K * 2) + colA2[_i]; } } while (0)
    const size_t kstep = (size_t)(BK * 2);
    const size_t hstep = (size_t)HALF * K * 2;
    const size_t hstepA = GATHER ? 0 : hstep;
    const size_t tstep = 2 * hstep;
    const unsigned ldsw = (unsigned)wid * 1024u;
    const int aoff = lds_byte(wr * 64 + fr, fq * 8), boff = lds_byte(wc * 32 + fr, fq * 8);
#define PG8_SA(b, h) (((b) * 2 + (h)) * HTB)
#define PG8_SB(b, h) ((4 + (b) * 2 + (h)) * HTB)
#define PG8_STAGE(bufoff, gbase, voff) do { _Pragma("unroll") for (int _i = 0; _i < 2; ++_i) \
        __builtin_amdgcn_global_load_lds((const unsigned*)((const char*)(gbase) + (voff)[_i]), (PG8_LAS unsigned*)(lds + (bufoff) + ldsw + _i * 8192), 16, 0, 0); } while (0)
#define PG8_LDA(dst, b, h) do { _Pragma("unroll") for (int m = 0; m < 4; ++m) _Pragma("unroll") for (int k = 0; k < 2; ++k) dst[m][k] = *(const PG8_LAS bf16x8*)(lds + PG8_SA(b, h) + aoff + m * 2048 + k * 1024); } while (0)
#define PG8_LDB(dst, b, h) do { _Pragma("unroll") for (int n = 0; n < 2; ++n) _Pragma("unroll") for (int k = 0; k < 2; ++k) dst[n][k] = *(const PG8_LAS bf16x8*)(lds + PG8_SB(b, h) + boff + n * 2048 + k * 1024); } while (0)
#define PG8_MMA(ai, bj, At, Bt) do { __builtin_amdgcn_s_setprio(1); _Pragma("unroll") for (int m = 0; m < 4; ++m) _Pragma("unroll") for (int n = 0; n < 2; ++n) _Pragma("unroll") for (int k = 0; k < 2; ++k) \
        acc[ai][bj][m][n] = __builtin_amdgcn_mfma_f32_16x16x32_bf16(Bt[n][k], At[m][k], acc[ai][bj][m][n], 0, 0, 0); __builtin_amdgcn_s_setprio(0); } while (0)
#define PG8_WAIT_V(n) asm volatile("s_waitcnt vmcnt(" #n ")" ::: "memory")
#define PG8_WAIT_L(n) asm volatile("s_waitcnt lgkmcnt(" #n ")" ::: "memory")
#define PG8_BAR __builtin_amdgcn_s_barrier()
#define PG8_SCHED __builtin_amdgcn_sched_barrier(0)
    Unit cur, nxt; int ui = 0;
    if (!S.next(0, cur)) return;
    f32x4 acc[2][2][4][2];
#pragma unroll
    for (int a = 0; a < 2; ++a)
#pragma unroll
        for (int b = 0; b < 2; ++b)
#pragma unroll
            for (int m = 0; m < 4; ++m)
#pragma unroll
                for (int n = 0; n < 2; ++n) acc[a][b][m][n] = (f32x4){0.f, 0.f, 0.f, 0.f};
    bf16x8 At[4][2], B0[2][2], B1[2][2];
    const char* cA = (const char*)g.A + (GATHER ? (size_t)0 : (size_t)cur.pm * tstep); const char* cB = (const char*)g.Bt + (size_t)cur.pn * tstep;
    S.a_ready(cur);
    if constexpr (GATHER) { PG8_IDX_ISSUE(cur); asm volatile("s_waitcnt vmcnt(0)" ::: "memory"); PG8_IDX_TAKE(gA); }
    if constexpr (SP2) {
        PG8_STAGE(PG8_SB(0, 0), cB, voffB); PG8_STAGE(PG8_SB(0, 1), cB + hstep, voffB); PG8_STAGE(PG8_SA(0, 0), cA, PG8_VA(0)); PG8_STAGE(PG8_SA(0, 1), cA + hstepA, PG8_VA(1));
        if (wr == 1) PG8_BAR;
        PG8_WAIT_V(2); PG8_BAR;
        PG8_STAGE(PG8_SB(1, 0), cB + kstep, voffB); PG8_STAGE(PG8_SA(1, 0), cA + kstep, PG8_VA(0)); PG8_STAGE(PG8_SB(1, 1), cB + hstep + kstep, voffB);
        PG8_WAIT_V(6); PG8_BAR;
    } else {
        PG8_STAGE(PG8_SB(0, 0), cB, voffB); PG8_STAGE(PG8_SA(0, 0), cA, PG8_VA(0)); PG8_STAGE(PG8_SB(0, 1), cB + hstep, voffB); PG8_STAGE(PG8_SA(0, 1), cA + hstepA, PG8_VA(1));
        if (wr == 1) PG8_BAR;
        PG8_WAIT_V(4); PG8_BAR;
        PG8_STAGE(PG8_SB(1, 0), cB + kstep, voffB); PG8_STAGE(PG8_SA(1, 0), cA + kstep, PG8_VA(0)); PG8_STAGE(PG8_SB(1, 1), cB + hstep + kstep, voffB);
        PG8_WAIT_V(6); PG8_BAR;
    }
    for (;;) {
        const bool has_next = S.next(ui + 1, nxt);
        const char* nA = (has_next && !GATHER) ? (const char*)g.A + (size_t)nxt.pm * tstep : cA; const char* nB = has_next ? (const char*)g.Bt + (size_t)nxt.pn * tstep : cB;
        if constexpr (GATHER) { if (has_next) PG8_IDX_ISSUE(nxt); }
        for (int t = 0; t < nt; t += 2) {
            const bool last = (t == nt - 2);
            const char* a1 = cA + (size_t)(t + 1) * kstep;
            const char* a2 = last ? nA : cA + (size_t)(t + 2) * kstep; const char* b2 = last ? nB : cB + (size_t)(t + 2) * kstep;
            const char* a3 = a2 + kstep; const char* b3 = b2 + kstep;
            if (last && has_next) S.a_ready(nxt);
            if constexpr (GATHER) { if (last) { if (has_next) PG8_IDX_TAKE(gN); else { _Pragma("unroll") for (int _h = 0; _h < 2; ++_h) _Pragma("unroll") for (int _i = 0; _i < 2; ++_i) gN[_h][_i] = gA[_h][_i]; } }
                _Pragma("unroll") for (int _h = 0; _h < 2; ++_h) _Pragma("unroll") for (int _i = 0; _i < 2; ++_i) gS[_h][_i] = last ? gN[_h][_i] : gA[_h][_i]; }
            if constexpr (SP2) {
            PG8_LDB(B0, 0, 0); PG8_LDB(B1, 0, 1); PG8_SCHED; PG8_LDA(At, 0, 0); PG8_STAGE(PG8_SA(1, 1), a1 + hstepA, PG8_VA(1));
            PG8_WAIT_V(8); PG8_WAIT_L(0); PG8_BAR; PG8_MMA(0, 0, At, B0); PG8_MMA(0, 1, At, B1); PG8_BAR; PG8_SCHED;
            PG8_LDA(At, 0, 1); PG8_STAGE(PG8_SB(0, 0), b2, voffB); PG8_STAGE(PG8_SB(0, 1), b2 + hstep, voffB); PG8_STAGE(PG8_SA(0, 0), a2, PG8_VS(0));
            PG8_WAIT_V(8); PG8_WAIT_L(0); PG8_BAR; if (HALF_FROM_PM == (1 << 30) || cur.pm < HALF_FROM_PM) { PG8_MMA(1, 0, At, B0); PG8_MMA(1, 1, At, B1); } PG8_BAR; PG8_SCHED;
            PG8_LDB(B0, 1, 0); PG8_LDB(B1, 1, 1); PG8_SCHED; PG8_LDA(At, 1, 0); PG8_STAGE(PG8_SA(0, 1), a2 + hstepA, PG8_VS(1));
            PG8_WAIT_V(8); PG8_WAIT_L(0); PG8_BAR; PG8_MMA(0, 0, At, B0); PG8_MMA(0, 1, At, B1); PG8_BAR; PG8_SCHED;
            PG8_LDA(At, 1, 1); PG8_STAGE(PG8_SB(1, 0), b3, voffB); PG8_STAGE(PG8_SB(1, 1), b3 + hstep, voffB); PG8_STAGE(PG8_SA(1, 0), a3, PG8_VS(0));
            PG8_WAIT_V(8); PG8_WAIT_L(0); PG8_BAR; if (HALF_FROM_PM == (1 << 30) || cur.pm < HALF_FROM_PM) { PG8_MMA(1, 0, At, B0); PG8_MMA(1, 1, At, B1); } PG8_BAR; PG8_SCHED;
            } else {
            PG8_LDB(B0, 0, 0); PG8_SCHED; PG8_LDA(At, 0, 0); PG8_STAGE(PG8_SA(1, 1), a1 + hstepA, PG8_VA(1));
            PG8_WAIT_L(8); PG8_BAR; PG8_WAIT_L(0); PG8_MMA(0, 0, At, B0); PG8_BAR; PG8_SCHED;
            PG8_LDB(B1, 0, 1); PG8_STAGE(PG8_SB(0, 0), b2, voffB);
            PG8_BAR; PG8_WAIT_L(0); PG8_MMA(0, 1, At, B1); PG8_BAR;
            PG8_LDA(At, 0, 1); PG8_STAGE(PG8_SA(0, 0), a2, PG8_VS(0));
            PG8_BAR; PG8_WAIT_L(0); PG8_MMA(1, 0, At, B0); PG8_BAR; PG8_SCHED;
            PG8_STAGE(PG8_SB(0, 1), b2 + hstep, voffB);
            PG8_WAIT_V(6); PG8_BAR; PG8_MMA(1, 1, At, B1); PG8_BAR;
            PG8_LDB(B0, 1, 0); PG8_SCHED; PG8_LDA(At, 1, 0); PG8_STAGE(PG8_SA(0, 1), a2 + hstepA, PG8_VS(1));
            PG8_WAIT_L(8); PG8_BAR; PG8_WAIT_L(0); PG8_MMA(0, 0, At, B0); PG8_BAR; PG8_SCHED;
            PG8_LDB(B1, 1, 1); PG8_STAGE(PG8_SB(1, 0), b3, voffB);
            PG8_BAR; PG8_WAIT_L(0); PG8_MMA(0, 1, At, B1); PG8_BAR;
            PG8_LDA(At, 1, 1); PG8_STAGE(PG8_SA(1, 0), a3, PG8_VS(0));
            PG8_BAR; PG8_WAIT_L(0); PG8_MMA(1, 0, At, B0); PG8_BAR; PG8_SCHED;
            PG8_STAGE(PG8_SB(1, 1), b3 + hstep, voffB);
            PG8_WAIT_V(6); PG8_BAR; PG8_MMA(1, 1, At, B1); PG8_BAR;
            }
        }
        if constexpr (ALIGN_EPI) { if (wr == 0) PG8_BAR; }
        if constexpr (!Epi::AFTER_DRAIN) { E(acc, cur, wr, wc, fr, fq); S.done(cur); }
        if (!has_next) break;
#pragma unroll
        for (int a = 0; a < 2; ++a)
#pragma unroll
            for (int b = 0; b < 2; ++b)
#pragma unroll
                for (int m = 0; m < 4; ++m)
#pragma unroll
                    for (int n = 0; n < 2; ++n) acc[a][b][m][n] = (f32x4){0.f, 0.f, 0.f, 0.f};
        cur = nxt; cA = nA; cB = nB; ++ui;
        if constexpr (GATHER) { _Pragma("unroll") for (int _h = 0; _h < 2; ++_h) _Pragma("unroll") for (int _i = 0; _i < 2; ++_i) gA[_h][_i] = gN[_h][_i]; }
        if constexpr (ALIGN_EPI) { if (wr == 1) PG8_BAR; }
    }
    PG8_WAIT_V(0);
    if constexpr (!ALIGN_EPI) { if (wr == 0) PG8_BAR; }
    PG8_BAR;
    if constexpr (Epi::AFTER_DRAIN) { E.fused(acc, cur, wr, wc, fr, fq, lds, wid, lane); S.done(cur); }
#undef PG8_SA
#undef PG8_VA
#undef PG8_VS
#undef PG8_IDX_ISSUE
#undef PG8_IDX_TAKE
#undef PG8_SB
#undef PG8_STAGE
#undef PG8_LDA
#undef PG8_LDB
#undef PG8_MMA
#undef PG8_WAIT_V
#undef PG8_WAIT_L
#undef PG8_BAR
#undef PG8_SCHED
}
}
#define XB_TMO      128
#define XB_XCNT(j)  (256  + 64 * (j))
#define XB_XSUB(j)  (1280 + 64 * (j))
#define XB_XGEN(j)  (2304 + 64 * (j))
#define XB_TOP      3328
#define XB_TOPGEN   3392
#define XCD_BAR_WORDS 3456
#define XB_SPIN_CAP (1u << 18)

__device__ __forceinline__ unsigned xb_ld(unsigned* p)              { return __hip_atomic_load(p, __ATOMIC_RELAXED, __HIP_MEMORY_SCOPE_AGENT); }
__device__ __forceinline__ unsigned xb_add(unsigned* p, unsigned v) { return __hip_atomic_fetch_add(p, v, __ATOMIC_RELAXED, __HIP_MEMORY_SCOPE_AGENT); }
__device__ __forceinline__ unsigned xb_xcc_id() { return (unsigned)__builtin_amdgcn_s_getreg((3 << 11) | 20) & 0xFu; }
#define XB_SPIN(cond, bar) do { unsigned _sp = 0; while (cond) { __builtin_amdgcn_s_sleep(1); \
    if ((++_sp & 255u) == 0u) { if (xb_ld(&(bar)[XB_TMO])) break; if (_sp > XB_SPIN_CAP) { atomicAdd(&(bar)[XB_TMO], 1u); break; } } } } while (0)

struct XcdBarrier {
    unsigned* bar; unsigned x;
    volatile LAS unsigned* st;
};

__device__ __forceinline__ XcdBarrier xcd_barrier_post(unsigned* bar, volatile LAS unsigned* st) {
    XcdBarrier b; b.bar = bar; b.x = xb_xcc_id(); b.st = st;
    if (threadIdx.x == 0) (void)xb_add(&bar[XB_XCNT(b.x)], 1u);
    return b;
}
__device__ __forceinline__ void xcd_barrier_complete(unsigned* bar, unsigned x, unsigned& nloc, unsigned& nx) {
    const unsigned G = gridDim.x * gridDim.y * gridDim.z;
    unsigned sum, cnt, mine, sp = 0u;
    for (;;) {
        sum = 0u; cnt = 0u; mine = 0u;
#pragma unroll
        for (unsigned j = 0; j < 16; ++j) { const unsigned c = xb_ld(&bar[XB_XCNT(j)]); sum += c; cnt += (c > 0u) ? 1u : 0u; mine = (j == x) ? c : mine; }
        if (sum == G) break;
        __builtin_amdgcn_s_sleep(1);
        if ((++sp & 255u) == 0u) { if (xb_ld(&bar[XB_TMO])) break; if (sp > XB_SPIN_CAP) { atomicAdd(&bar[XB_TMO], 1u); break; } }
    }
    nloc = mine > 0u ? mine : 1u; nx = cnt > 0u ? cnt : 1u;
}

__device__ __forceinline__ void xcd_barrier(const XcdBarrier& b) {
    asm volatile("s_waitcnt vmcnt(0)" ::: "memory");
    __syncthreads();
    if (threadIdx.x == 0) {
        unsigned* bar = b.bar;
        __builtin_amdgcn_s_waitcnt(0);
        unsigned nloc = b.st[0], nx = b.st[1];
        if (nloc == 0u) { xcd_barrier_complete(bar, b.x, nloc, nx); b.st[0] = nloc; b.st[1] = nx; }
        const unsigned old = xb_add(&bar[XB_XSUB(b.x)], 1u);
        const unsigned gen = old / nloc;
        if (old + 1u == (gen + 1u) * nloc) {
            __builtin_amdgcn_fence(__ATOMIC_RELEASE, "agent");
            asm volatile("s_waitcnt vmcnt(0)" ::: "memory");
            const unsigned og = xb_add(&bar[XB_TOP], 1u);
            const unsigned tg = og / nx;
            if (og + 1u == (tg + 1u) * nx) xb_add(&bar[XB_TOPGEN], 1u);
            else XB_SPIN(xb_ld(&bar[XB_TOPGEN]) == tg, bar);
            __builtin_amdgcn_fence(__ATOMIC_ACQUIRE, "agent");
            xb_add(&bar[XB_XGEN(b.x)], 1u);
            asm volatile("s_waitcnt vmcnt(0)" ::: "memory");
        } else {
            XB_SPIN(xb_ld(&bar[XB_XGEN(b.x)]) == gen, bar);
            __builtin_amdgcn_fence(__ATOMIC_ACQUIRE, "agent");
            asm volatile("s_waitcnt vmcnt(0)" ::: "memory");
        }
    }
    __syncthreads();
}

typedef unsigned short bf16;
typedef unsigned v4u __attribute__((ext_vector_type(4)));
typedef unsigned v2u __attribute__((ext_vector_type(2)));
typedef float f32x4 __attribute__((ext_vector_type(4)));
typedef float f32x16 __attribute__((ext_vector_type(16)));
typedef short bf16x8 __attribute__((ext_vector_type(8)));
typedef unsigned short u16x8 __attribute__((ext_vector_type(8)));
#define LDS_WAIT() asm volatile("s_waitcnt lgkmcnt(0)" ::: "memory")
#define VM_WAIT() asm volatile("s_waitcnt vmcnt(0)" ::: "memory")

constexpr int NWAVES = 8, NTHR = 512;
constexpr int D = 1024, NB = 4, SEQ = 8192, CTXL = 256, NLAT = NB * SEQ, NCTX = NB * CTXL, NROW = NLAT + NCTX;
constexpr int INC = 2304;
constexpr int PXC = 2048;
constexpr int PX_Z = 1536;
constexpr int NE = 16, CAP_L = 1024, CAP_C = 32;
constexpr int SLAB_L = NB * NE * CAP_L;
constexpr int SLAB_ROWS = SLAB_L + NE * 256;
constexpr int NCHUNK = NROW / 64;
constexpr float EPS = 1e-6f;

enum { I_X = 0, I_C, I_CTX, I_CCTX, I_WADA, I_BADA, I_GN1, I_WIN, I_LCW, I_LCB, I_LWR, I_LBR, I_LWI, I_LBI, I_LAM, I_SCW, I_GOUT, I_WOUT, I_GN2, I_WRT, I_WG, I_WU, I_WD, I_GF, N_IN };

constexpr size_t MiB = 1u << 20;
constexpr size_t WS_CTL = 0, CTL_ZERO_BYTES = 64 * 1024;
constexpr size_t WS_MODP_OLD = 1 * MiB;
constexpr size_t WS_MODS = WS_MODP_OLD + 2 * MiB;
constexpr size_t WS_SP8 = WS_MODS + 256 * 1024;
constexpr size_t WS_TW = WS_SP8 + 8 * 1024;
constexpr size_t WS_C128 = WS_TW + 64 * 1024;
constexpr size_t WS_S128 = WS_C128 + 32 * 1024;
constexpr size_t WS_T2M = WS_S128 + 32 * 1024;
constexpr size_t WS_TCM = WS_T2M + 16 * 1024;
constexpr size_t WS_WGL = WS_TCM + 256 * 1024;
constexpr size_t WS_WIN = 5 * MiB;
constexpr size_t WS_WOUT = WS_WIN + 9 * MiB;
constexpr size_t WS_WGU = WS_WOUT + 4 * MiB;
constexpr size_t WS_WD = WS_WGU + 64 * MiB;
constexpr size_t WS_WEXP_L = 96 * MiB;
constexpr size_t WS_XB = WS_WGU + 2 * WS_WEXP_L;
constexpr size_t WS_HX = WS_XB;
constexpr size_t WS_REGA = WS_HX + 66 * MiB;
constexpr size_t WS_REGB = WS_REGA + 149 * MiB;
constexpr size_t WS_T1 = WS_REGB, WS_SP = WS_REGB + 32 * MiB;
constexpr size_t WS_MODP = WS_REGB;
constexpr size_t WS_CTXX = WS_REGB + 136 * MiB;
constexpr size_t WS_AFFL = WS_CTXX + 4 * MiB;
constexpr size_t WS_AFFC = WS_AFFL + 2 * MiB;
constexpr size_t WS_ENT = WS_AFFC + 1 * MiB;
constexpr size_t WS_IDX = WS_ENT + 3 * MiB;
constexpr size_t WS_GVAL = WS_IDX + 1 * MiB;
constexpr size_t WS_SUMM = WS_GVAL + 1 * MiB;
constexpr size_t WS_CARRY = WS_SUMM + 5 * MiB;
constexpr size_t WS_END = WS_CARRY + 3 * MiB;
static_assert(WS_WGL + 2 * 8 * 256 * 64 * 2 <= WS_WIN, "ws map");
static_assert((size_t)NROW * INC * 2 <= 149 * MiB && (size_t)SLAB_ROWS * 1024 * 2 <= 136 * MiB && 32 * MiB + (size_t)NCHUNK * 8 * 2 * 3 * 2 * 1024 * 2 <= 136 * MiB, "ws map");

constexpr int CW_BAR = 1024;

constexpr int LDS_BYTES = 147456;
constexpr int RING_BYTES = 135168;
constexpr int MISC_OFF = RING_BYTES;

__device__ __forceinline__ unsigned f2bf(float f) { unsigned u = __builtin_bit_cast(unsigned, f); return (u + 0x7fffu + ((u >> 16) & 1u)) >> 16; }
__device__ __forceinline__ unsigned pk2(float lo, float hi) { unsigned r; asm volatile("v_cvt_pk_bf16_f32 %0, %1, %2" : "=v"(r) : "v"(lo), "v"(hi)); return r; }
__device__ __forceinline__ float bf2f(unsigned h) { return __builtin_bit_cast(float, h << 16); }
__device__ __forceinline__ float sigmoidf_(float x) { return __builtin_amdgcn_rcpf(1.0f + __builtin_amdgcn_exp2f(-1.4426950408889634f * x)); }
__device__ __forceinline__ float rsq_(float x) { return __builtin_amdgcn_rsqf(x); }
__device__ __forceinline__ float wave_sum(float v) {
#pragma unroll
    for (int o = 1; o < 64; o <<= 1) v += __shfl_xor(v, o);
    return v;
}

struct Args { const float* in[N_IN]; float* out; unsigned char* ws; int ph_lo, ph_hi, bar_region, pad_; };
template <int CTRL> __device__ __forceinline__ float dpp_(float v) { return __builtin_bit_cast(float, __builtin_amdgcn_update_dpp(0, __builtin_bit_cast(int, v), CTRL, 0xf, 0xf, false)); }
__device__ __forceinline__ float row_sum16(float v) { v += dpp_<0xB1>(v); v += dpp_<0x4E>(v); v += dpp_<0x141>(v); v += dpp_<0x140>(v); return v; }
__device__ __forceinline__ float row_max16(float v) { v = fmaxf(v, dpp_<0xB1>(v)); v = fmaxf(v, dpp_<0x4E>(v)); v = fmaxf(v, dpp_<0x141>(v)); v = fmaxf(v, dpp_<0x140>(v)); return v; }
__device__ __forceinline__ float wave_sum_fast(float v) { v = row_sum16(v);
    const int i = __builtin_bit_cast(int, v);
    return (__builtin_bit_cast(float, __builtin_amdgcn_readlane(i, 0)) + __builtin_bit_cast(float, __builtin_amdgcn_readlane(i, 16))) + (__builtin_bit_cast(float, __builtin_amdgcn_readlane(i, 32)) + __builtin_bit_cast(float, __builtin_amdgcn_readlane(i, 48))); }
struct Frame {
    LAS unsigned char* lds;
    int tid, lane, wave, wg, G;
};
constexpr int PT_OFF = 135168 + 256;
__device__ __forceinline__ unsigned long long ptab_(LAS unsigned char* lds, int i) { const unsigned long long v = ((const LAS unsigned long long*)(lds + PT_OFF))[i];
    const unsigned lo = __builtin_amdgcn_readfirstlane((unsigned)v), hi = __builtin_amdgcn_readfirstlane((unsigned)(v >> 32)); return ((unsigned long long)hi << 32) | lo; }
#define GAS __attribute__((address_space(1)))
template <class T> __device__ __forceinline__ T* as_global_(unsigned long long v) { return (T*)(GAS T*)v; }
#define INP(i) as_global_<const float>(ptab_(F.lds, (i)))
#define OUTP() as_global_<float>(ptab_(F.lds, N_IN))
#define HXP() as_global_<bf16>(ptab_(F.lds, N_IN))
#define XBP() WSP(bf16, WS_XB)
__device__ __forceinline__ void relaunder(Frame& F) { int t_ = threadIdx.x; asm volatile("" : "+v"(t_)); F.tid = t_; F.lane = t_ & 63; F.wave = __builtin_amdgcn_readfirstlane(t_ >> 6); }
#define WSP(T, off) as_global_<T>(ptab_(F.lds, N_IN + 1) + (off))

__device__ __forceinline__ void transpose_item(const float* __restrict__ W, int ldw, int k0, int n0, bf16* __restrict__ WT, int ldk, int drow0, LAS float* scr, int lane) {
#pragma unroll 8
    for (int i = 0; i < 32; ++i) { const int kk = 2 * i + (lane >> 5); scr[kk * 33 + (lane & 31)] = W[(size_t)(k0 + kk) * ldw + n0 + (lane & 31)]; }
    LDS_WAIT(); asm volatile("" ::: "memory");
    const int c = lane & 7;
#pragma unroll
    for (int j = 0; j < 4; ++j) { const int n = (lane >> 3) + 8 * j; const LAS float* s = scr + (8 * c) * 33 + n;
        v4u o; o.x = pk2(s[0 * 33], s[1 * 33]); o.y = pk2(s[2 * 33], s[3 * 33]); o.z = pk2(s[4 * 33], s[5 * 33]); o.w = pk2(s[6 * 33], s[7 * 33]);
        *(v4u*)(WT + (size_t)(drow0 + n) * ldk + k0 + 8 * c) = o; }
    LDS_WAIT(); asm volatile("" ::: "memory");
}
__device__ __forceinline__ void transpose_item64(const float* __restrict__ W, int ldw, int k0, int n0, bf16* __restrict__ WT, int ldk, int drow0, LAS float* scr, int lane) {
    const int q = lane & 15, kr = lane >> 4;
    f32x4 v[16];
#pragma unroll
    for (int i = 0; i < 16; ++i) v[i] = __builtin_nontemporal_load((const f32x4*)(W + (size_t)(k0 + 4 * i + kr) * ldw + n0 + 4 * q));
#pragma unroll
    for (int i = 0; i < 16; ++i) { LAS float* d = scr + (4 * i + kr) * 65 + 4 * q; d[0] = v[i].x; d[1] = v[i].y; d[2] = v[i].z; d[3] = v[i].w; }
    LDS_WAIT(); asm volatile("" ::: "memory");
    const int c = lane & 7;
#pragma unroll
    for (int j = 0; j < 8; ++j) { const int n = (lane >> 3) + 8 * j; const LAS float* s = scr + (8 * c) * 65 + n;
        v4u o; o.x = pk2(s[0 * 65], s[1 * 65]); o.y = pk2(s[2 * 65], s[3 * 65]); o.z = pk2(s[4 * 65], s[5 * 65]); o.w = pk2(s[6 * 65], s[7 * 65]);
        *(v4u*)(WT + (size_t)(drow0 + n) * ldk + k0 + 8 * c) = o; }
    LDS_WAIT(); asm volatile("" ::: "memory");
}
constexpr int N_EXP_ITEMS = 3 * 16 * 256;
constexpr int CW_FILL = 64;
__device__ __forceinline__ void convert_item(Frame& F, int l, int it) {
    LAS float* scr = (LAS float*)(F.lds + F.wave * 16640);
    bf16* WGU = WSP(bf16, WS_WGU + (size_t)l * WS_WEXP_L); bf16* WD = WSP(bf16, WS_WD + (size_t)l * WS_WEXP_L);
    const int mat = it / (16 * 256), r = it % (16 * 256), e = r >> 8, t = r & 255, kb = t >> 4, nb = t & 15, k0 = kb * 64, n0 = nb * 64;
    const size_t eoff = ((size_t)l * 16 + e) * 1024 * 1024;
    if (mat == 0)      transpose_item64(INP(I_WG) + eoff, 1024, k0, n0, WGU + (size_t)e * 2048 * 1024, 1024, (n0 >> 7) * 256 + (n0 & 127), scr, F.lane);
    else if (mat == 1) transpose_item64(INP(I_WU) + eoff, 1024, k0, n0, WGU + (size_t)e * 2048 * 1024, 1024, (n0 >> 7) * 256 + 128 + (n0 & 127), scr, F.lane);
    else               transpose_item64(INP(I_WD) + eoff, 1024, k0, n0, WD + (size_t)e * 1024 * 1024, 1024, n0, scr, F.lane);
}
__device__ __forceinline__ void filler(Frame& F, int budget, int only_l) {
    volatile LAS unsigned* MISC = (volatile LAS unsigned*)(F.lds + MISC_OFF);
    unsigned* ctr = WSP(unsigned, WS_CTL) + CW_FILL;
    int l = only_l >= 0 ? only_l : 0;
    for (int g = 0; only_l >= 0 || g < budget; ++g) {
        __syncthreads();
        if (F.tid == 0) { unsigned base = __hip_atomic_fetch_add(ctr + 64 * l, 8u, __ATOMIC_RELAXED, __HIP_MEMORY_SCOPE_AGENT);
            if (base >= (unsigned)N_EXP_ITEMS && only_l < 0 && l == 0) { base = __hip_atomic_fetch_add(ctr + 64, 8u, __ATOMIC_RELAXED, __HIP_MEMORY_SCOPE_AGENT) | 0x80000000u; }
            MISC[20] = base; }
        LDS_WAIT(); __syncthreads();
        unsigned base = MISC[20]; int ll = l;
        if (base & 0x80000000u) { base &= 0x7fffffffu; ll = 1; l = 1; }
        if (base >= (unsigned)N_EXP_ITEMS) break;
        convert_item(F, ll, (int)base + F.wave);
    }
    __syncthreads();
}
__device__ __forceinline__ void p0_prep(Frame& F) {
    const int gw = F.wg * NWAVES + F.wave, NGW = F.G * NWAVES;
    LAS float* sil = (LAS float*)(F.lds + 8 * 8448);
    for (int i = F.tid; i < 5 * 1024; i += NTHR) { const int s = i >> 10, k = i & 1023; const float cv = s < 4 ? INP(I_C)[s * 1024 + k] : INP(I_CCTX)[k]; sil[i] = cv * sigmoidf_(cv); }
    LAS float* cst = (LAS float*)(F.lds + 8 * 8448 + 5 * 1024 * 4);
    if (F.tid < 64) { cst[F.tid] = cospif((float)F.tid / 32.0f); cst[64 + F.tid] = sinpif((float)F.tid / 32.0f); }
    LDS_WAIT(); __syncthreads();
    constexpr int N_ADA = 16 * 24, N_FOLD = 256, N_IN_ITEMS = 16 * 56, N_OUT_ITEMS = 16 * 32, N_LRU = 32;
    constexpr int PER_L = N_ADA + N_FOLD + N_IN_ITEMS + N_OUT_ITEMS + N_LRU;
    LAS float* scr = (LAS float*)(F.lds + F.wave * 8448);
    for (int it = gw; it < 2 * PER_L; it += NGW) {
        const int l = it & 1; int r = it >> 1;
        if (r < N_ADA) {
            const int kq = r / 24, cb = r % 24, j0 = cb * 256 + 4 * F.lane;
            const float* W = INP(I_WADA) + (size_t)l * 1024 * 6144 + j0;
            f32x4 acc[5];
#pragma unroll
            for (int s = 0; s < 5; ++s) acc[s] = (f32x4){0.f, 0.f, 0.f, 0.f};
            for (int kb = 0; kb < 4; ++kb) { f32x4 w[16];
#pragma unroll
                for (int i = 0; i < 16; ++i) w[i] = __builtin_nontemporal_load((const f32x4*)(W + (size_t)(kq * 64 + kb * 16 + i) * 6144));
#pragma unroll
                for (int i = 0; i < 16; ++i)
#pragma unroll
                    for (int s = 0; s < 5; ++s) acc[s] += w[i] * sil[s * 1024 + kq * 64 + kb * 16 + i]; }
            float* MP = WSP(float, WS_MODP);
#pragma unroll
            for (int s = 0; s < 5; ++s) *(f32x4*)(MP + ((size_t)(kq * 2 + l) * 5 + s) * 6144 + j0) = acc[s];
            continue; }
        r -= N_ADA;
        if (r < N_FOLD) {
            const int kb = r >> 4, g = (r >> 2) & 3, mq = r & 3, k = kb * 64 + F.lane;
            const float* Wr = INP(I_WIN) + (size_t)l * 1024 * 2048 + (size_t)k * 2048 + 1792 + 64 * g;
            float wrow[64];
#pragma unroll
            for (int c4 = 0; c4 < 16; ++c4) { const f32x4 t = *(const f32x4*)(Wr + 4 * c4); wrow[4 * c4] = t.x; wrow[4 * c4 + 1] = t.y; wrow[4 * c4 + 2] = t.z; wrow[4 * c4 + 3] = t.w; }
            bf16* WT = WSP(bf16, WS_WIN) + (size_t)l * INC * 1024;
            for (int m = 16 * mq; m < 16 * mq + 16; ++m) { float re = 0.f, im = 0.f;
#pragma unroll
                for (int c = 0; c < 64; ++c) { const int a = (m * c) & 63; re += wrow[c] * cst[a]; im -= wrow[c] * cst[64 + a]; }
                WT[(size_t)(1792 + 64 * g + m) * 1024 + k] = (bf16)f2bf(re);
                WT[(size_t)(2048 + 64 * g + m) * 1024 + k] = (bf16)f2bf(im); }
            continue; }
        r -= N_FOLD;
        if (r < N_IN_ITEMS) {
            const int kb = r / 56, nb = r % 56;
            const int n0 = nb * 32, j = n0 < 1536 ? n0 - 1280 : n0 - 1536;
            const int drow = n0 < 1280 ? n0 : 1280 + (j >> 7) * 256 + (n0 < 1536 ? 0 : 128) + (j & 127);
            transpose_item(INP(I_WIN) + (size_t)l * 1024 * 2048, 2048, kb * 64, n0, WSP(bf16, WS_WIN) + (size_t)l * INC * 1024, 1024, drow, scr, F.lane); continue; }
        r -= N_IN_ITEMS;
        if (r < N_OUT_ITEMS) { const int kb = r >> 5, nb = r & 31;
            transpose_item(INP(I_WOUT) + (size_t)l * 1024 * 1024, 1024, kb * 64, nb * 32, WSP(bf16, WS_WOUT) + (size_t)l * 1024 * 1024, 1024, nb * 32, scr, F.lane); continue; }
        r -= N_OUT_ITEMS;
        {
            const int dir = r >> 4, gate = (r >> 3) & 1, h = r & 7;
            const float* W = INP(gate ? I_LWI : I_LWR) + ((size_t)(l * 2 + dir) * 8 + h) * 4096;
            bf16* WT = WSP(bf16, WS_WGL) + ((size_t)l * 8 + h) * 256 * 64 + (size_t)(dir * 2 + gate) * 64 * 64;
            for (int i = 0; i < 64; ++i) WT[F.lane * 64 + i] = (bf16)f2bf(W[i * 64 + F.lane]);
        }
    }
    const int gt = F.wg * NTHR + F.tid, NGT = F.G * NTHR;
    float* TW = WSP(float, WS_TW); bf16* C128 = WSP(bf16, WS_C128); bf16* S128 = WSP(bf16, WS_S128); bf16* T2M = WSP(bf16, WS_T2M); bf16* TCM = WSP(bf16, WS_TCM); float* SP8 = WSP(float, WS_SP8);
    for (int i = gt; i < 8192; i += NGT) { TW[2 * i] = cospif((float)i / 4096.0f); TW[2 * i + 1] = sinpif((float)i / 4096.0f); }
    for (int i = gt; i < 128 * 128; i += NGT) { const int k = i >> 7, n = i & 127, a = (k * n) & 127; C128[i] = (bf16)f2bf(cospif((float)a / 64.0f)); S128[i] = (bf16)f2bf(sinpif((float)a / 64.0f)); }
    for (int i = gt; i < 64 * 128; i += NGT) { const int k = i >> 7, nq = (i & 127) >> 1, ri = i & 1, a = (k * nq) & 63; T2M[i] = (bf16)f2bf(ri ? sinpif((float)a / 32.0f) : cospif((float)a / 32.0f)); }
    for (int i = gt; i < 256 * 512; i += NGT) { const int k = i >> 9, n = (i & 511) >> 1, ri = i & 1, a = (k * n) & 255; TCM[i] = (bf16)f2bf(ri ? sinpif((float)a / 128.0f) : cospif((float)a / 128.0f)); }
    for (int i = gt; i < 2048; i += NGT) { const float lam = INP(I_LAM)[i]; SP8[i] = 8.0f * log1pf(expf(-lam)); }
}
__device__ __forceinline__ void p0b_mods(Frame& F) {
    const int gt = F.wg * NTHR + F.tid, NGT = F.G * NTHR;
    const float* MP = WSP(float, WS_MODP); float* MS = WSP(float, WS_MODS);
    for (int i = gt; i < 2 * 5 * 6144; i += NGT) { const int l = i / (5 * 6144), r = i % (5 * 6144), s = r / 6144, j = r % 6144;
        float a = INP(I_BADA)[l * 6144 + j];
#pragma unroll
        for (int kq = 0; kq < 16; ++kq) a += MP[((size_t)(kq * 2 + l) * 5 + s) * 6144 + j];
        MS[i] = a; }
}

__device__ __forceinline__ int row_set(int row) { return row < NLAT ? (row >> 13) : 4; }
__device__ __forceinline__ void norm_mod_store(const f32x4 (&v)[4], const float* g, const float* shift, const float* scale, bf16* orow, int lane) {
    float ss = 0.f;
#pragma unroll
    for (int j = 0; j < 4; ++j) ss += (v[j].x * v[j].x + v[j].y * v[j].y) + (v[j].z * v[j].z + v[j].w * v[j].w);
    const float rstd = rsq_(wave_sum_fast(ss) * (1.0f / D) + EPS);
    unsigned long long* o8 = (unsigned long long*)orow + lane;
#pragma unroll
    for (int j = 0; j < 4; ++j) { const int c = 4 * lane + 256 * j;
        const f32x4 gg = *(const f32x4*)(g + c), sh = *(const f32x4*)(shift + c), sc = *(const f32x4*)(scale + c);
        const f32x4 o = (v[j] * rstd * gg) * (sc + 1.0f) + sh;
        o8[64 * j] = (unsigned long long)pk2(o.x, o.y) | ((unsigned long long)pk2(o.z, o.w) << 32); }
}
#define ROWCOL(lane, j) (8 * (lane) + 512 * ((j) >> 1) + 4 * ((j) & 1))
__device__ __forceinline__ void norm_mod_store8(const f32x4 (&v)[4], const float* g, const float* shift, const float* scale, bf16* orow, int lane) {
    float ss = 0.f;
#pragma unroll
    for (int j = 0; j < 4; ++j) ss += (v[j].x * v[j].x + v[j].y * v[j].y) + (v[j].z * v[j].z + v[j].w * v[j].w);
    const float rstd = rsq_(wave_sum_fast(ss) * (1.0f / D) + EPS);
#pragma unroll
    for (int h = 0; h < 2; ++h) { const int c = 8 * lane + 512 * h; f32x4 o[2];
#pragma unroll
        for (int q = 0; q < 2; ++q) { const f32x4 gg = *(const f32x4*)(g + c + 4 * q), sh = *(const f32x4*)(shift + c + 4 * q), sc = *(const f32x4*)(scale + c + 4 * q);
            o[q] = (v[2 * h + q] * rstd * gg) * (sc + 1.0f) + sh; }
        v4u w; w.x = pk2(o[0].x, o[0].y); w.y = pk2(o[0].z, o[0].w); w.z = pk2(o[1].x, o[1].y); w.w = pk2(o[1].z, o[1].w);
        *(v4u*)(orow + c) = w; }
}
__device__ __forceinline__ void load_row8(const bf16* row, int lane, f32x4 (&v)[4]) {
#pragma unroll
    for (int h = 0; h < 2; ++h) { const v4u w = *(const v4u*)(row + 8 * lane + 512 * h);
        v[2 * h] = (f32x4){bf2f(w.x & 0xffffu), bf2f(w.x >> 16), bf2f(w.y & 0xffffu), bf2f(w.y >> 16)}; v[2 * h + 1] = (f32x4){bf2f(w.z & 0xffffu), bf2f(w.z >> 16), bf2f(w.w & 0xffffu), bf2f(w.w >> 16)}; }
}
__device__ __forceinline__ void store_row8(bf16* row, int lane, const f32x4 (&v)[4]) {
#pragma unroll
    for (int h = 0; h < 2; ++h) { v4u w; w.x = pk2(v[2 * h].x, v[2 * h].y); w.y = pk2(v[2 * h].z, v[2 * h].w); w.z = pk2(v[2 * h + 1].x, v[2 * h + 1].y); w.w = pk2(v[2 * h + 1].z, v[2 * h + 1].w);
        *(v4u*)(row + 8 * lane + 512 * h) = w; }
}
__device__ __forceinline__ void s0_norm1(Frame& F) {
    const int gw = F.wg * NWAVES + F.wave, NGW = F.G * NWAVES;
    const float* MS = WSP(float, WS_MODS); bf16* HX = HXP();
    const int npairs = NROW / 2;
    f32x4 va[4], vb[4];
    if (gw < npairs) { const int ra = 2 * gw; const float* xr = ra < NLAT ? INP(I_X) + (size_t)ra * D : INP(I_CTX) + (size_t)(ra - NLAT) * D;
#pragma unroll
        for (int j = 0; j < 4; ++j) { va[j] = *(const f32x4*)(xr + 4 * F.lane + 256 * j); vb[j] = *(const f32x4*)(xr + D + 4 * F.lane + 256 * j); } }
    for (int rp = gw; rp < npairs; rp += NGW) {
        const int ra = 2 * rp; f32x4 na[4], nb[4]; const bool more = rp + NGW < npairs;
        if (more) { const int rn = 2 * (rp + NGW); const float* xr = rn < NLAT ? INP(I_X) + (size_t)rn * D : INP(I_CTX) + (size_t)(rn - NLAT) * D;
#pragma unroll
            for (int j = 0; j < 4; ++j) { na[j] = *(const f32x4*)(xr + 4 * F.lane + 256 * j); nb[j] = *(const f32x4*)(xr + D + 4 * F.lane + 256 * j); } }
        const float* m = MS + (size_t)row_set(ra) * 6144;
        norm_mod_store(va, INP(I_GN1), m, m + 1024, HX + (size_t)ra * D, F.lane);
        norm_mod_store(vb, INP(I_GN1), m, m + 1024, HX + (size_t)(ra + 1) * D, F.lane);
        if (more) {
#pragma unroll
            for (int j = 0; j < 4; ++j) { va[j] = na[j]; vb[j] = nb[j]; } }
    }
}

#define MFMA32(a, b, c) __builtin_amdgcn_mfma_f32_32x32x16_bf16((a), (b), (c), 0, 0, 0)
__device__ __forceinline__ bf16x8 ldsB_frag(const LAS bf16* t, int stride, int k0, int col, int lane) {
    const LAS bf16* p = t + (k0 + 8 * (lane >> 5)) * stride + col; bf16x8 r;
#pragma unroll
    for (int j = 0; j < 8; ++j) r[j] = (short)p[j * stride];
    return r;
}
__device__ __forceinline__ bf16x8 neg_frag(bf16x8 a) { v4u u = __builtin_bit_cast(v4u, a); u ^= 0x80008000u; return __builtin_bit_cast(bf16x8, u); }
__device__ __forceinline__ int rowmap(int r, int hh) { return (r & 3) + 8 * (r >> 2) + 4 * hh; }

constexpr int D1_STRIDE = 520;
__device__ __forceinline__ void dft1_unit(Frame& F, int b, int nq) {
    relaunder(F);
    LAS bf16* tile = (LAS bf16*)F.lds;
    const bf16* PX = WSP(bf16, WS_REGA);
#pragma unroll 4
    for (int i = 0; i < 16; ++i) { const int q = F.tid + NTHR * i, row = q >> 6, ch = q & 63;
        const v4u v = *(const v4u*)(PX + (size_t)(b * SEQ + 64 * row + nq) * PXC + PX_Z + ch * 8);
        *(LAS v4u*)(tile + row * D1_STRIDE + ch * 8) = v; }
    LDS_WAIT(); __syncthreads();
    const bf16* C128 = WSP(bf16, WS_C128); const bf16* S128 = WSP(bf16, WS_S128);
    const int hh = F.lane >> 5, ln = F.lane & 31, cw = 32 * F.wave + ln;
    f32x16 are[4], aim[4];
#pragma unroll
    for (int mb = 0; mb < 4; ++mb)
#pragma unroll
        for (int r = 0; r < 16; ++r) { are[mb][r] = 0.f; aim[mb][r] = 0.f; }
    for (int ks = 0; ks < 8; ++ks) {
        const bf16x8 xre = ldsB_frag(tile, D1_STRIDE, 16 * ks, cw, F.lane), xim = ldsB_frag(tile, D1_STRIDE, 16 * ks, 256 + cw, F.lane);
#pragma unroll
        for (int mb = 0; mb < 4; ++mb) {
            const bf16x8 cf = *(const bf16x8*)(C128 + (32 * mb + ln) * 128 + 16 * ks + 8 * hh), sf = *(const bf16x8*)(S128 + (32 * mb + ln) * 128 + 16 * ks + 8 * hh);
            are[mb] = MFMA32(cf, xre, are[mb]); are[mb] = MFMA32(sf, xim, are[mb]);
            aim[mb] = MFMA32(cf, xim, aim[mb]); aim[mb] = MFMA32(neg_frag(sf), xre, aim[mb]);
        }
    }
    const float* TW = WSP(float, WS_TW); bf16* T1 = WSP(bf16, WS_T1);
#pragma unroll
    for (int mb = 0; mb < 4; ++mb)
#pragma unroll
        for (int r = 0; r < 16; ++r) { const int kp = 32 * mb + rowmap(r, hh); const int a = (kp * nq) & 8191; const float c = TW[2 * a], s = TW[2 * a + 1];
            const float re = are[mb][r], im = aim[mb][r];
            bf16* o = T1 + ((size_t)((b * 128 + kp) * 64 + nq) * 2) * 256 + cw;
            o[0] = (bf16)f2bf(re * c + im * s); o[256] = (bf16)f2bf(im * c - re * s); }
    __syncthreads();
}
constexpr int D2_STRIDE = 264;
__device__ __forceinline__ void dft2_unit(Frame& F, int l, const bf16* Amat, int lda, int m0, int nchunks, const bf16* dbase, size_t tokstride, size_t chunkstride, float scale, int orow0, int ostride, const LAS bf16* Alds) {
    relaunder(F);
    LAS bf16* tile = (LAS bf16*)F.lds;
    const int hh = F.lane >> 5, ln = F.lane & 31, cw = 32 * F.wave + ln;
    f32x16 acc[2];
#pragma unroll
    for (int mb = 0; mb < 2; ++mb)
#pragma unroll
        for (int r = 0; r < 16; ++r) acc[mb][r] = 0.f;
    for (int ck = 0; ck < nchunks; ++ck) {
        const bf16* dsrc = dbase + (size_t)ck * chunkstride;
        { v4u dv[8];
#pragma unroll
          for (int i = 0; i < 8; ++i) { const int q = F.tid + NTHR * i, krow = q >> 5, ch = q & 31;
              dv[i] = *(const v4u*)(dsrc + (size_t)(krow >> 1) * tokstride + (krow & 1) * 256 + ch * 8); }
#pragma unroll
          for (int i = 0; i < 8; ++i) { const int q = F.tid + NTHR * i, krow = q >> 5, ch = q & 31; *(LAS v4u*)(tile + krow * D2_STRIDE + ch * 8) = dv[i]; } }
        LDS_WAIT(); __syncthreads();
        for (int ks = 0; ks < 8; ++ks) {
            const bf16x8 xf = ldsB_frag(tile, D2_STRIDE, 16 * ks, cw, F.lane);
#pragma unroll
            for (int mb = 0; mb < 2; ++mb) { const bf16x8 af = Alds ? *(const LAS bf16x8*)(Alds + (32 * mb + ln) * 136 + 16 * ks + 8 * hh) : *(const bf16x8*)(Amat + (size_t)(m0 + 32 * mb + ln) * lda + ck * 128 + 16 * ks + 8 * hh);
                acc[mb] = MFMA32(af, xf, acc[mb]); }
        }
        __syncthreads();
    }
    LAS float* yt = (LAS float*)F.lds;
#pragma unroll
    for (int mb = 0; mb < 2; ++mb)
#pragma unroll
        for (int r = 0; r < 16; ++r) yt[(32 * mb + rowmap(r, hh)) * 260 + cw] = acc[mb][r] * scale;
    LDS_WAIT(); __syncthreads();
    { const int m = F.tid >> 3, seg = F.tid & 7; const LAS float* p = yt + m * 260 + 32 * seg;
        f32x4 v[8]; float ss = 0.f;
#pragma unroll
        for (int j = 0; j < 8; ++j) { v[j] = *(const LAS f32x4*)(p + 4 * j); ss += (v[j].x * v[j].x + v[j].y * v[j].y) + (v[j].z * v[j].z + v[j].w * v[j].w); }
        ss += __shfl_xor(ss, 1); ss += __shfl_xor(ss, 2); ss += __shfl_xor(ss, 4);
        const float rstd = rsq_(ss * (1.0f / 256.0f) + EPS);
        const float* g = INP(I_GOUT) + l * 1024 + 768 + 32 * seg;
        bf16* o = HXP() + (size_t)(orow0 + m * ostride) * D + 768 + 32 * seg;
#pragma unroll
        for (int j = 0; j < 4; ++j) { const f32x4 g0 = *(const f32x4*)(g + 8 * j), g1 = *(const f32x4*)(g + 8 * j + 4); const f32x4 a = v[2 * j] * rstd * g0, c = v[2 * j + 1] * rstd * g1;
            v4u w; w.x = pk2(a.x, a.y); w.y = pk2(a.z, a.w); w.z = pk2(c.x, c.y); w.w = pk2(c.z, c.w); *(v4u*)(o + 8 * j) = w; } }
    __syncthreads();
}

constexpr int UT_STRIDE = 520;
constexpr int UT_BYTES = 64 * UT_STRIDE * 2;
struct UWin { u16x8 rows[11]; };
__device__ __forceinline__ void lru_bounds(int cid, int& lo, int& hi) { if (cid < 512) { lo = cid * 64; hi = lo + 64; } else { lo = NLAT + ((cid - 512) >> 2) * CTXL; hi = lo + CTXL; } }
__device__ __forceinline__ void lru_issue_u(Frame& F, int cid, UWin& w) {
    const bf16* PX = WSP(bf16, WS_REGA);
    const int row0 = cid * 64; int lo, hi; lru_bounds(cid, lo, hi);
    const int ch0 = (F.tid & 63) * 8, t0 = (F.tid >> 6) * 8;
#pragma unroll
    for (int k = 0; k < 11; ++k) { const int rr = row0 + t0 - 1 + k, rc = rr < lo ? lo : (rr >= hi ? hi - 1 : rr);
        w.rows[k] = *(const u16x8*)(PX + (size_t)rc * PXC + ch0); }
}
__device__ __forceinline__ void lru_finish_u(Frame& F, int l, int cid, UWin& win, LAS bf16* ut) {
    const int row0 = cid * 64; int lo, hi; lru_bounds(cid, lo, hi);
    const int ch0 = (F.tid & 63) * 8, t0 = (F.tid >> 6) * 8;
    f32x4 w[4][2], bias[2];
#pragma unroll
    for (int k = 0; k < 4; ++k) { w[k][0] = *(const f32x4*)(INP(I_LCW) + (l * 4 + k) * 512 + ch0); w[k][1] = *(const f32x4*)(INP(I_LCW) + (l * 4 + k) * 512 + ch0 + 4); }
    bias[0] = *(const f32x4*)(INP(I_LCB) + l * 512 + ch0); bias[1] = *(const f32x4*)(INP(I_LCB) + l * 512 + ch0 + 4);
#pragma unroll
    for (int k = 0; k < 11; ++k) { const int rr = row0 + t0 - 1 + k; if (rr < lo || rr >= hi) win.rows[k] = (u16x8){0, 0, 0, 0, 0, 0, 0, 0}; }
#pragma unroll
    for (int t = 0; t < 8; ++t) { f32x4 a0 = bias[0], a1 = bias[1];
#pragma unroll
        for (int k = 0; k < 4; ++k) { const u16x8 v = win.rows[t + k];
            a0 += w[k][0] * (f32x4){bf2f(v[0]), bf2f(v[1]), bf2f(v[2]), bf2f(v[3])}; a1 += w[k][1] * (f32x4){bf2f(v[4]), bf2f(v[5]), bf2f(v[6]), bf2f(v[7])}; }
        v4u o; o.x = pk2(a0.x, a0.y); o.y = pk2(a0.z, a0.w); o.z = pk2(a1.x, a1.y); o.w = pk2(a1.z, a1.w);
        *(LAS v4u*)(ut + (t0 + t) * UT_STRIDE + ch0) = o; }
}
struct LruOps { bf16x8 fr[2][4], fi[2][4]; float b_r[2], b_i[2], sp[2]; };
template <int dir> __device__ __forceinline__ void lru_load_ops(Frame& F, int l, int nb, LruOps& o) {
    const int hd = F.wave, hh = F.lane >> 5, ln = F.lane & 31, ch = hd * 64 + nb * 32 + ln;
    const bf16* WG = WSP(bf16, WS_WGL) + ((size_t)l * 8 + hd) * 256 * 64;
#pragma unroll
    for (int ks = 0; ks < 4; ++ks) {
        o.fr[dir][ks] = *(const bf16x8*)(WG + (size_t)((dir * 2 + 0) * 64 + nb * 32 + ln) * 64 + 16 * ks + 8 * hh);
        o.fi[dir][ks] = *(const bf16x8*)(WG + (size_t)((dir * 2 + 1) * 64 + nb * 32 + ln) * 64 + 16 * ks + 8 * hh); }
    o.b_r[dir] = -1.4426950408889634f * INP(I_LBR)[(l * 2 + dir) * 512 + ch]; o.b_i[dir] = -1.4426950408889634f * INP(I_LBI)[(l * 2 + dir) * 512 + ch]; o.sp[dir] = -1.4426950408889634f * WSP(float, WS_SP8)[(l * 2 + dir) * 512 + ch];
}
template <int dir> __device__ __forceinline__ void lru_gates(Frame& F, const LruOps& o, const LAS bf16* ut, int mb, f32x16& a, f32x16& bb) {
    const int hd = F.wave, hh = F.lane >> 5, ln = F.lane & 31;
#pragma unroll
    for (int r = 0; r < 16; ++r) { a[r] = 0.f; bb[r] = 0.f; }
#pragma unroll
    for (int ks = 0; ks < 4; ++ks) {
        const bf16x8 af = *(const LAS bf16x8*)(ut + (32 * mb + ln) * UT_STRIDE + hd * 64 + 16 * ks + 8 * hh);
        a = MFMA32(af, o.fr[dir][ks], a); bb = MFMA32(af, o.fi[dir][ks], bb);
    }
}
template <int dir> __device__ __forceinline__ void lru_elem(Frame& F, const LruOps& o, const LAS bf16* ut, int nb, int mb, f32x16& a, f32x16& bb) {
    const int hd = F.wave, hh = F.lane >> 5, ln = F.lane & 31, ch = hd * 64 + nb * 32 + ln;
    typedef float f32x2 __attribute__((ext_vector_type(2)));
    const float nb_r = o.b_r[dir], nb_i = o.b_i[dir], spl = o.sp[dir];
    const LAS bf16* ub = ut + (32 * mb + 4 * hh) * UT_STRIDE + ch;
#pragma unroll
    for (int r = 0; r < 16; r += 2) {
        const f32x2 pa = {a[r], a[r + 1]}, pb = {bb[r], bb[r + 1]};
        const f32x2 xr = pa * -1.4426950408889634f + nb_r, xi = pb * -1.4426950408889634f + nb_i;
        const f32x2 dr = (f32x2){__builtin_amdgcn_exp2f(xr.x), __builtin_amdgcn_exp2f(xr.y)} + 1.0f, di = (f32x2){__builtin_amdgcn_exp2f(xi.x), __builtin_amdgcn_exp2f(xi.y)} + 1.0f;
        const f32x2 rr = {__builtin_amdgcn_rcpf(dr.x), __builtin_amdgcn_rcpf(dr.y)}, ii = {__builtin_amdgcn_rcpf(di.x), __builtin_amdgcn_rcpf(di.y)};
        const f32x2 z = rr * spl;
        const f32x2 av = {__builtin_amdgcn_exp2f(z.x), __builtin_amdgcn_exp2f(z.y)};
        const f32x2 om = 1.0f - av * av;
        const f32x2 mult = {__builtin_amdgcn_sqrtf(om.x), __builtin_amdgcn_sqrtf(om.y)};
        const f32x2 uv = {bf2f(ub[((r & 3) + 8 * (r >> 2)) * UT_STRIDE]), bf2f(ub[(((r + 1) & 3) + 8 * ((r + 1) >> 2)) * UT_STRIDE])};
        const f32x2 bv = (mult * ii) * uv;
        a[r] = av.x; a[r + 1] = av.y; bb[r] = bv.x; bb[r + 1] = bv.y; }
}
#define MEMFENCE() asm volatile("" ::: "memory")
template <int dir> __device__ __forceinline__ float lru_scan(int lane, float hin, const f32x16& a, f32x16& bb, float* Atot) {
    const bool hi = (lane >> 5) != 0;
    const bool own_first = dir == 0 ? !hi : hi;
    float oA[4], oB[4];
#pragma unroll
    for (int q = 0; q < 4; ++q) {
        const float a0 = a[4 * q], a1 = a[4 * q + 1], a2 = a[4 * q + 2], a3 = a[4 * q + 3];
        const float b0 = bb[4 * q], b1 = bb[4 * q + 1], b2 = bb[4 * q + 2], b3 = bb[4 * q + 3];
        oA[q] = (a0 * a1) * (a2 * a3);
        oB[q] = dir == 0 ? ((b0 * a1 + b1) * a2 + b2) * a3 + b3 : ((b3 * a2 + b2) * a1 + b1) * a0 + b0; }
    float h = hin, At = 1.0f; float cin[4];
#pragma unroll
    for (int s = 0; s < 4; ++s) { const int q = dir == 0 ? s : 3 - s;
        const float pA = __shfl_xor(oA[q], 32), pB = __shfl_xor(oB[q], 32);
        const float A1 = own_first ? oA[q] : pA, B1 = own_first ? oB[q] : pB, A2 = own_first ? pA : oA[q], B2 = own_first ? pB : oB[q];
        const float h1 = A1 * h + B1, h2 = A2 * h1 + B2;
        cin[q] = own_first ? h : h1; h = h2; At *= A1 * A2; }
#pragma unroll
    for (int q = 0; q < 4; ++q) { float x = cin[q];
        if (dir == 0) {
#pragma unroll
            for (int j = 0; j < 4; ++j) { x = a[4 * q + j] * x + bb[4 * q + j]; bb[4 * q + j] = x; }
        } else {
#pragma unroll
            for (int j = 3; j >= 0; --j) { x = a[4 * q + j] * x + bb[4 * q + j]; bb[4 * q + j] = x; }
        } }
    *Atot = At; return h;
}
template <int dir> __device__ __forceinline__ float lru_scanP(int lane, float hin, float pin, f32x16& a, f32x16& bb, float* Pend) {
    const bool hi = (lane >> 5) != 0;
    const bool own_first = dir == 0 ? !hi : hi;
    float oA[4], oB[4];
#pragma unroll
    for (int q = 0; q < 4; ++q) {
        const float a0 = a[4 * q], a1 = a[4 * q + 1], a2 = a[4 * q + 2], a3 = a[4 * q + 3];
        const float b0 = bb[4 * q], b1 = bb[4 * q + 1], b2 = bb[4 * q + 2], b3 = bb[4 * q + 3];
        oA[q] = (a0 * a1) * (a2 * a3);
        oB[q] = dir == 0 ? ((b0 * a1 + b1) * a2 + b2) * a3 + b3 : ((b3 * a2 + b2) * a1 + b1) * a0 + b0; }
    float h = hin, pr = pin; float cin[4], cinP[4];
#pragma unroll
    for (int s = 0; s < 4; ++s) { const int q = dir == 0 ? s : 3 - s;
        const float pA = __shfl_xor(oA[q], 32), pB = __shfl_xor(oB[q], 32);
        const float A1 = own_first ? oA[q] : pA, B1 = own_first ? oB[q] : pB, A2 = own_first ? pA : oA[q], B2 = own_first ? pB : oB[q];
        const float h1 = A1 * h + B1, h2 = A2 * h1 + B2, p1 = pr * A1, p2 = p1 * A2;
        cin[q] = own_first ? h : h1; cinP[q] = own_first ? pr : p1; h = h2; pr = p2; }
#pragma unroll
    for (int q = 0; q < 4; ++q) { float x = cin[q], p = cinP[q];
        if (dir == 0) {
#pragma unroll
            for (int j = 0; j < 4; ++j) { const float av = a[4 * q + j]; x = av * x + bb[4 * q + j]; p *= av; bb[4 * q + j] = x; a[4 * q + j] = p; }
        } else {
#pragma unroll
            for (int j = 3; j >= 0; --j) { const float av = a[4 * q + j]; x = av * x + bb[4 * q + j]; p *= av; bb[4 * q + j] = x; a[4 * q + j] = p; }
        } }
    *Pend = pr; return h;
}
__device__ __forceinline__ void store_blk(bf16* blk, int lane, const f32x16& v) {
    v4u w0, w1;
    w0.x = pk2(v[0], v[1]); w0.y = pk2(v[2], v[3]); w0.z = pk2(v[4], v[5]); w0.w = pk2(v[6], v[7]);
    w1.x = pk2(v[8], v[9]); w1.y = pk2(v[10], v[11]); w1.z = pk2(v[12], v[13]); w1.w = pk2(v[14], v[15]);
    *(v4u*)(blk + lane * 8) = w0; *(v4u*)(blk + 512 + lane * 8) = w1;
}
__device__ __forceinline__ size_t sp_block(int cid, int head, int nb, int arr, int mb) { return ((size_t)((((cid * 8 + head) * 2 + nb) * 3 + arr) * 2 + mb)) * 1024; }
__device__ __forceinline__ void lru_a_phase(Frame& F, int l) {
    relaunder(F);
    LAS bf16* ut = (LAS bf16*)F.lds;
    float* SM = WSP(float, WS_SUMM);
    constexpr int NUNIT = 512 + 2 * (NCHUNK - 512);
    int un = F.wg; UWin win;
    if (un < NUNIT) lru_issue_u(F, un < 512 ? un : 512 + ((un - 512) >> 1), win);
    for (; un < NUNIT; un += F.G) {
        const int cid = un < 512 ? un : 512 + ((un - 512) >> 1), nbsel = un < 512 ? -1 : ((un - 512) & 1);
        LruOps o; lru_load_ops<0>(F, l, nbsel < 0 ? 0 : nbsel, o);
        lru_finish_u(F, l, cid, win, ut);
        LDS_WAIT(); __syncthreads();
        if (un + F.G < NUNIT) { const int u2 = un + F.G; lru_issue_u(F, u2 < 512 ? u2 : 512 + ((u2 - 512) >> 1), win); }
#pragma unroll
        for (int nb = 0; nb < 2; ++nb) { const int ch = F.wave * 64 + nb * 32 + (F.lane & 31);
            if (nbsel >= 0 && nb != nbsel) continue;
            f32x16 a, bb, S0, S1; float A0, A1; bf16* SP = WSP(bf16, WS_SP);
            lru_gates<0>(F, o, ut, 0, a, bb); lru_elem<0>(F, o, ut, nb, 0, a, bb); const float B0 = lru_scanP<0>(F.lane, 0.0f, 1.0f, a, bb, &A0); S0 = bb; store_blk(SP + sp_block(cid, F.wave, nb, 1, 0), F.lane, a);
            lru_gates<0>(F, o, ut, 1, a, bb); MEMFENCE(); lru_load_ops<1>(F, l, nb, o); MEMFENCE();
            lru_elem<0>(F, o, ut, nb, 1, a, bb); const float B1 = lru_scanP<0>(F.lane, B0, A0, a, bb, &A1); S1 = bb; store_blk(SP + sp_block(cid, F.wave, nb, 1, 1), F.lane, a);
            if (F.lane < 32) { SM[((size_t)(cid * 2 + 0) * 2 + 0) * 512 + ch] = A1; SM[((size_t)(cid * 2 + 0) * 2 + 1) * 512 + ch] = B1; }
            lru_gates<1>(F, o, ut, 1, a, bb); lru_elem<1>(F, o, ut, nb, 1, a, bb); const float C1 = lru_scanP<1>(F.lane, 0.0f, 1.0f, a, bb, &A1); S1 += bb;
            store_blk(SP + sp_block(cid, F.wave, nb, 2, 1), F.lane, a); store_blk(SP + sp_block(cid, F.wave, nb, 0, 1), F.lane, S1);
            lru_gates<1>(F, o, ut, 0, a, bb);
            lru_elem<1>(F, o, ut, nb, 0, a, bb); const float C0 = lru_scanP<1>(F.lane, C1, A1, a, bb, &A0); S0 += bb;
            store_blk(SP + sp_block(cid, F.wave, nb, 2, 0), F.lane, a); store_blk(SP + sp_block(cid, F.wave, nb, 0, 0), F.lane, S0);
            if (F.lane < 32) { SM[((size_t)(cid * 2 + 1) * 2 + 0) * 512 + ch] = A0; SM[((size_t)(cid * 2 + 1) * 2 + 1) * 512 + ch] = C0; }
            if (nb == 0 && nbsel < 0) { MEMFENCE(); lru_load_ops<0>(F, l, 1, o); MEMFENCE(); }
        }
        __syncthreads();
    }
}
__device__ __forceinline__ int carry_cid(int b, int dir, int st) { return dir == 0 ? (st < 4 ? 512 + 4 * b + st : 128 * b + st - 4) : (st < 4 ? 512 + 4 * b + 3 - st : 128 * b + 131 - st); }
__device__ __forceinline__ void s3_carries(Frame& F, int wv  ) {
    const int part = F.lane >> 3, seq = wv * 8 + (F.lane & 7), b = seq >> 10, dir = (seq >> 9) & 1, ch = seq & 511;
    const int s0 = part * 16 + (part < 4 ? part : 4), len = part < 4 ? 17 : 16;
    const float* __restrict__ SM = WSP(float, WS_SUMM); float* __restrict__ CR = WSP(float, WS_CARRY);
    float A[17], B[17];
#pragma unroll
    for (int j = 0; j < 17; ++j) { const int st = s0 + (j < len ? j : 0), cid = carry_cid(b, dir, st);
        A[j] = SM[((size_t)(cid * 2 + dir) * 2 + 0) * 512 + ch]; B[j] = SM[((size_t)(cid * 2 + dir) * 2 + 1) * 512 + ch]; }
    float At = 1.f, Bt = 0.f;
#pragma unroll
    for (int j = 0; j < 17; ++j) if (j < len) { Bt = A[j] * Bt + B[j]; At *= A[j]; }
#pragma unroll
    for (int d = 8; d < 64; d <<= 1) { const float pA = __shfl_up(At, d), pB = __shfl_up(Bt, d); if (F.lane >= d) { Bt = At * pB + Bt; At = At * pA; } }
    float h = __shfl_up(Bt, 8); if (part == 0) h = 0.f;
#pragma unroll
    for (int j = 0; j < 17; ++j) if (j < len) { const int cid = carry_cid(b, dir, s0 + j); CR[(size_t)(cid * 2 + dir) * 512 + ch] = h; h = A[j] * h + B[j]; }
}
__device__ __forceinline__ float gelu_tanh(float x) { const float u = x * x, t = x * __builtin_fmaf(u, -0.10294324f, -2.3022082f);
    return x * __builtin_amdgcn_rcpf(1.0f + __builtin_amdgcn_exp2f(t)); }
__device__ __forceinline__ void lru_b_issue_g(Frame& F, int cid, v4u (&gv)[8]) {
    const bf16* PX = WSP(bf16, WS_REGA); const int row0 = cid * 64;
#pragma unroll
    for (int i = 0; i < 8; ++i) { const int q = F.tid + NTHR * i, tok = q >> 6, cg = q & 63; gv[i] = *(const v4u*)(PX + (size_t)(row0 + tok) * PXC + 512 + cg * 8); }
}
__device__ __forceinline__ void unpack8(const v4u w, float (&f)[8]) {
    f[0] = bf2f(w.x & 0xffffu); f[1] = bf2f(w.x >> 16); f[2] = bf2f(w.y & 0xffffu); f[3] = bf2f(w.y >> 16); f[4] = bf2f(w.z & 0xffffu); f[5] = bf2f(w.z >> 16); f[6] = bf2f(w.w & 0xffffu); f[7] = bf2f(w.w >> 16); }
__device__ __forceinline__ void lru_b_phase(Frame& F, int l, int nc) {
    typedef float f32x2 __attribute__((ext_vector_type(2)));
    relaunder(F);
    LAS bf16* ht = (LAS bf16*)F.lds;
    const float* CR = WSP(float, WS_CARRY); bf16* Y = HXP(); const bf16* SP = WSP(bf16, WS_SP); const bf16* PX = WSP(bf16, WS_REGA);
    const int hh = F.lane >> 5, ln = F.lane & 31;
    for (int cid = F.wg; cid < nc; cid += F.G) {
        const int row0 = cid * 64, tok = F.tid >> 3, seg = F.tid & 7;
        v4u blk[2][2][3][2]; float cf[2], cb[2];
#pragma unroll
        for (int nb = 0; nb < 2; ++nb) { const int ch = F.wave * 64 + nb * 32 + ln;
            cf[nb] = CR[(size_t)(cid * 2 + 0) * 512 + ch]; cb[nb] = CR[(size_t)(cid * 2 + 1) * 512 + ch];
#pragma unroll
            for (int mb = 0; mb < 2; ++mb)
#pragma unroll
                for (int arr = 0; arr < 3; ++arr) { const bf16* p = SP + sp_block(cid, F.wave, nb, arr, mb);
                    blk[nb][mb][arr][0] = *(const v4u*)(p + F.lane * 8); blk[nb][mb][arr][1] = *(const v4u*)(p + 512 + F.lane * 8); } }
        v4u gv[8];
#pragma unroll
        for (int j = 0; j < 8; ++j) gv[j] = *(const v4u*)(PX + (size_t)(row0 + tok) * PXC + 512 + 64 * seg + 8 * j);
#pragma unroll
        for (int nb = 0; nb < 2; ++nb) { const int ch = F.wave * 64 + nb * 32 + ln;
#pragma unroll
            for (int mb = 0; mb < 2; ++mb)
#pragma unroll
                for (int hf = 0; hf < 2; ++hf) { const v4u ws = blk[nb][mb][0][hf], wf = blk[nb][mb][1][hf], wb = blk[nb][mb][2][hf];
                    const unsigned us[4] = {ws.x, ws.y, ws.z, ws.w}, uf[4] = {wf.x, wf.y, wf.z, wf.w}, ub[4] = {wb.x, wb.y, wb.z, wb.w};
#pragma unroll
                    for (int i = 0; i < 4; ++i) { const int r = 8 * hf + 2 * i;
                        const f32x2 sv = {bf2f(us[i] & 0xffffu), __builtin_bit_cast(float, us[i] & 0xffff0000u)}, pf = {bf2f(uf[i] & 0xffffu), __builtin_bit_cast(float, uf[i] & 0xffff0000u)}, pb = {bf2f(ub[i] & 0xffffu), __builtin_bit_cast(float, ub[i] & 0xffff0000u)};
                        const f32x2 h = sv + pf * cf[nb] + pb * cb[nb];
                        const unsigned w = pk2(h.x, h.y);
                        LAS bf16* p = ht + (32 * mb + 4 * hh + (r & 3) + 8 * (r >> 2)) * UT_STRIDE + ch;
                        p[0] = (bf16)(w & 0xffffu); p[UT_STRIDE] = (bf16)(w >> 16); } }
        }
        LDS_WAIT(); __syncthreads();
        {
            const LAS bf16* p = ht + tok * UT_STRIDE + 64 * seg;
            f32x2 yv[8][4]; float ss = 0.f;
#pragma unroll
            for (int j = 0; j < 8; ++j) { const v4u hw = *(const LAS v4u*)(p + 8 * j); const unsigned hu[4] = {hw.x, hw.y, hw.z, hw.w}, gu[4] = {gv[j].x, gv[j].y, gv[j].z, gv[j].w};
#pragma unroll
                for (int i = 0; i < 4; ++i) { const f32x2 h = {bf2f(hu[i] & 0xffffu), __builtin_bit_cast(float, hu[i] & 0xffff0000u)}, g = {bf2f(gu[i] & 0xffffu), __builtin_bit_cast(float, gu[i] & 0xffff0000u)};
                    const f32x2 t = g * ((g * g) * -0.10294324f + -2.3022082f);
                    const f32x2 d = (f32x2){__builtin_amdgcn_exp2f(t.x), __builtin_amdgcn_exp2f(t.y)} + 1.0f;
                    const f32x2 y = (h * g) * (f32x2){__builtin_amdgcn_rcpf(d.x), __builtin_amdgcn_rcpf(d.y)};
                    yv[j][i] = y; ss += y.x * y.x + y.y * y.y; } }
            ss += __shfl_xor(ss, 1); ss += __shfl_xor(ss, 2); ss += __shfl_xor(ss, 4);
            const float rstd = rsq_(ss * (1.0f / 512.0f) + EPS);
            const float* g = INP(I_GOUT) + l * 1024 + 64 * seg; bf16* op = Y + (size_t)(row0 + tok) * D + 64 * seg;
#pragma unroll
            for (int j = 0; j < 8; ++j) { const f32x4 g0 = *(const f32x4*)(g + 8 * j), g1 = *(const f32x4*)(g + 8 * j + 4);
                v4u w; w.x = pk2(yv[j][0].x * rstd * g0.x, yv[j][0].y * rstd * g0.y); w.y = pk2(yv[j][1].x * rstd * g0.z, yv[j][1].y * rstd * g0.w);
                w.z = pk2(yv[j][2].x * rstd * g1.x, yv[j][2].y * rstd * g1.y); w.w = pk2(yv[j][3].x * rstd * g1.z, yv[j][3].y * rstd * g1.w);
                *(v4u*)(op + 8 * j) = w; } }
        __syncthreads();
    }
}
struct ScWin { u16x8 pp[4], bv[2]; };
__device__ __forceinline__ void sc_issue(Frame& F, int hu, ScWin& w) {
    const bf16* PX = WSP(bf16, WS_REGA); const int cid = hu >> 1, row0 = hu * 32, c0 = 8 * (F.tid & 31), t0 = (F.tid >> 5) * 2; int lo, hi; lru_bounds(cid, lo, hi);
#pragma unroll
    for (int k = 0; k < 4; ++k) { const int r2 = row0 + t0 - 1 + k, rc = r2 < lo ? lo : (r2 >= hi ? hi - 1 : r2);
        w.pp[k] = *(const u16x8*)(PX + (size_t)rc * PXC + 1280 + c0); }
#pragma unroll
    for (int t = 0; t < 2; ++t) w.bv[t] = *(const u16x8*)(PX + (size_t)(row0 + t0 + t) * PXC + 1024 + c0);
}
__device__ __forceinline__ void sc_phase(Frame& F, int l, int nc, int wg0, int nwg) {
    relaunder(F);
    if (F.wg < wg0) return;
    bf16* Y = HXP();
    const int c0 = 8 * (F.tid & 31), t0 = (F.tid >> 5) * 2, nh = 2 * nc;
    f32x4 w[3][2], gg[2];
#pragma unroll
    for (int k = 0; k < 3; ++k) { w[k][0] = *(const f32x4*)(INP(I_SCW) + (l * 3 + k) * 256 + c0); w[k][1] = *(const f32x4*)(INP(I_SCW) + (l * 3 + k) * 256 + c0 + 4); }
    gg[0] = *(const f32x4*)(INP(I_GOUT) + l * 1024 + 512 + c0); gg[1] = *(const f32x4*)(INP(I_GOUT) + l * 1024 + 512 + c0 + 4);
    int hu = F.wg - wg0; ScWin cur;
    if (hu < nh) sc_issue(F, hu, cur);
    for (; hu < nh; hu += nwg) {
        ScWin nxt; const bool more = hu + nwg < nh;
        if (more) sc_issue(F, hu + nwg, nxt);
        const int row0 = hu * 32; int lo, hi; lru_bounds(hu >> 1, lo, hi);
        f32x4 p0[4], p1[4];
#pragma unroll
        for (int k = 0; k < 4; ++k) { const int r2 = row0 + t0 - 1 + k; const float ok = (r2 >= lo && r2 < hi) ? 1.0f : 0.0f;
            p0[k] = (f32x4){bf2f(cur.pp[k][0]), bf2f(cur.pp[k][1]), bf2f(cur.pp[k][2]), bf2f(cur.pp[k][3])} * ok;
            p1[k] = (f32x4){bf2f(cur.pp[k][4]), bf2f(cur.pp[k][5]), bf2f(cur.pp[k][6]), bf2f(cur.pp[k][7])} * ok; }
#pragma unroll
        for (int t = 0; t < 2; ++t) { const u16x8 bv = cur.bv[t];
            f32x4 a0 = (w[0][0] * p0[t] + w[1][0] * p0[t + 1] + w[2][0] * p0[t + 2]) * (f32x4){bf2f(bv[0]), bf2f(bv[1]), bf2f(bv[2]), bf2f(bv[3])};
            f32x4 a1 = (w[0][1] * p1[t] + w[1][1] * p1[t + 1] + w[2][1] * p1[t + 2]) * (f32x4){bf2f(bv[4]), bf2f(bv[5]), bf2f(bv[6]), bf2f(bv[7])};
            float ss = (a0.x * a0.x + a0.y * a0.y) + (a0.z * a0.z + a0.w * a0.w) + (a1.x * a1.x + a1.y * a1.y) + (a1.z * a1.z + a1.w * a1.w);
            ss += __shfl_xor(ss, 1); ss += __shfl_xor(ss, 2); ss += __shfl_xor(ss, 4); ss += __shfl_xor(ss, 8); ss += __shfl_xor(ss, 16);
            const float rstd = rsq_(ss * (1.0f / 256.0f) + EPS);
            a0 = a0 * rstd * gg[0]; a1 = a1 * rstd * gg[1];
            v4u wv; wv.x = pk2(a0.x, a0.y); wv.y = pk2(a0.z, a0.w); wv.z = pk2(a1.x, a1.y); wv.w = pk2(a1.z, a1.w);
            *(v4u*)(Y + (size_t)(row0 + t0 + t) * D + 512 + c0) = wv; }
        if (more) cur = nxt;
    }
}

__device__ __forceinline__ void s6_norm2_router(Frame& F, int l, int pair0, int npairs, int gw, int NGW) {
    LAS float* wP = (LAS float*)F.lds;
    for (int c = F.tid; c < 1024; c += NTHR) { const float* w = INP(I_WRT) + (size_t)l * 16384 + c * 16;
        const int h = c >> 9, ln = (c & 511) >> 3, q = (c >> 2) & 1, i = c & 3, base = (h * 2 + q) * 256 + 4 * ln + i;
        const f32x4 w0 = *(const f32x4*)w, w1 = *(const f32x4*)(w + 4), w2 = *(const f32x4*)(w + 8), w3 = *(const f32x4*)(w + 12);
        const float wv[16] = {w0.x, w0.y, w0.z, w0.w, w1.x, w1.y, w1.z, w1.w, w2.x, w2.y, w2.z, w2.w, w3.x, w3.y, w3.z, w3.w};
#pragma unroll
        for (int e = 0; e < 16; ++e) wP[e * 1024 + base] = wv[e]; }
    LDS_WAIT(); __syncthreads();
    const float* MS = WSP(float, WS_MODS) + (size_t)l * 5 * 6144; bf16* HX = HXP(); int* ENT = WSP(int, WS_ENT); const bf16* XB = XBP();
    const float* g2 = INP(I_GN2) + l * 1024;
    const bool up32 = (F.lane & 32) != 0, up16 = (F.lane & 16) != 0, up8 = (F.lane & 8) != 0, up4 = (F.lane & 4) != 0, up2 = (F.lane & 2) != 0;
    v4u ra_[2], rb_[2];
    if (pair0 + gw < npairs) { const bf16* xr = XB + (size_t)(2 * (pair0 + gw)) * D;
#pragma unroll
        for (int h = 0; h < 2; ++h) { ra_[h] = *(const v4u*)(xr + 8 * F.lane + 512 * h); rb_[h] = *(const v4u*)(xr + D + 8 * F.lane + 512 * h); } }
    for (int rp = pair0 + gw; rp < npairs; rp += NGW) {
        const int ra = 2 * rp; const bool more = rp + NGW < npairs;
        v4u na_[2], nb_[2];
        if (more) { const bf16* xr = XB + (size_t)(2 * (rp + NGW)) * D;
#pragma unroll
            for (int h = 0; h < 2; ++h) { na_[h] = *(const v4u*)(xr + 8 * F.lane + 512 * h); nb_[h] = *(const v4u*)(xr + D + 8 * F.lane + 512 * h); } }
        f32x4 va[4], vb[4];
#pragma unroll
        for (int h = 0; h < 2; ++h) {
            va[2 * h] = (f32x4){bf2f(ra_[h].x & 0xffffu), bf2f(ra_[h].x >> 16), bf2f(ra_[h].y & 0xffffu), bf2f(ra_[h].y >> 16)}; va[2 * h + 1] = (f32x4){bf2f(ra_[h].z & 0xffffu), bf2f(ra_[h].z >> 16), bf2f(ra_[h].w & 0xffffu), bf2f(ra_[h].w >> 16)};
            vb[2 * h] = (f32x4){bf2f(rb_[h].x & 0xffffu), bf2f(rb_[h].x >> 16), bf2f(rb_[h].y & 0xffffu), bf2f(rb_[h].y >> 16)}; vb[2 * h + 1] = (f32x4){bf2f(rb_[h].z & 0xffffu), bf2f(rb_[h].z >> 16), bf2f(rb_[h].w & 0xffffu), bf2f(rb_[h].w >> 16)}; }
        float sa = 0.f, sb = 0.f;
#pragma unroll
        for (int j = 0; j < 4; ++j) {
            sa += (va[j].x * va[j].x + va[j].y * va[j].y) + (va[j].z * va[j].z + va[j].w * va[j].w); sb += (vb[j].x * vb[j].x + vb[j].y * vb[j].y) + (vb[j].z * vb[j].z + vb[j].w * vb[j].w); }
        const float ra_std = rsq_(wave_sum_fast(sa) * (1.0f / D) + EPS), rb_std = rsq_(wave_sum_fast(sb) * (1.0f / D) + EPS);
        const float* m = MS + (size_t)row_set(ra) * 6144;
#pragma unroll
        for (int j = 0; j < 4; ++j) { const int c = ROWCOL(F.lane, j);
            const f32x4 gg = *(const f32x4*)(g2 + c), sh = *(const f32x4*)(m + 3 * 1024 + c), sc = *(const f32x4*)(m + 4 * 1024 + c) + 1.0f;
            va[j] = (va[j] * ra_std * gg) * sc + sh; vb[j] = (vb[j] * rb_std * gg) * sc + sh; }
        store_row8(HX + (size_t)ra * D, F.lane, va); store_row8(HX + (size_t)(ra + 1) * D, F.lane, vb);
        float lg[32];
#pragma unroll
        for (int e = 0; e < 16; ++e) { float a = 0.f, b = 0.f;
#pragma unroll
            for (int j = 0; j < 4; ++j) { const f32x4 w = *(const LAS f32x4*)(wP + e * 1024 + j * 256 + 4 * F.lane);
                a += (va[j].x * w.x + va[j].y * w.y) + (va[j].z * w.z + va[j].w * w.w); b += (vb[j].x * w.x + vb[j].y * w.y) + (vb[j].z * w.z + vb[j].w * w.w); }
            lg[e] = a; lg[16 + e] = b; }
#define RS_STEP(n, msk, up) _Pragma("unroll") for (int i = 0; i < (n) / 2; ++i) { const float keep = (up) ? lg[i + (n) / 2] : lg[i], send = (up) ? lg[i] : lg[i + (n) / 2]; lg[i] = keep + __shfl_xor(send, (msk)); }
        RS_STEP(32, 32, up32) RS_STEP(16, 16, up16) RS_STEP(8, 8, up8) RS_STEP(4, 4, up4) RS_STEP(2, 2, up2)
#undef RS_STEP
        float v = lg[0] + __shfl_xor(lg[0], 1);
        float mx = row_max16(v); mx = fmaxf(mx, __shfl_xor(mx, 16));
        const float ex = __expf(v - mx); float den = row_sum16(ex); den += __shfl_xor(den, 16);
        const float p = 2.0f * ex / den;
        if ((F.lane & 1) == 0) { const int row = ra + (F.lane >> 5), e = (F.lane >> 1) & 15;
            if (row < NLAT) WSP(float, WS_AFFL)[((size_t)((row >> 13) * 16 + e)) * SEQ + (row & (SEQ - 1))] = p;
            else { const int rc = row - NLAT; WSP(float, WS_AFFC)[((size_t)((rc >> 8) * 16 + e)) * CTXL + (rc & (CTXL - 1))] = p; }
            ENT[(size_t)row * 16 + e] = -1; }
        if (more) {
#pragma unroll
            for (int h = 0; h < 2; ++h) { ra_[h] = na_[h]; rb_[h] = nb_[h]; } }
    }
    __syncthreads();
}
__device__ __forceinline__ void s7_topk_problem(Frame& F, const float* aff, int n, int cap, int slab_base, int tokrow_base, int e) {
    LAS unsigned* keys = (LAS unsigned*)F.lds;
    LAS unsigned* hist = keys + 8192;
    LAS unsigned* wtot = hist + 256;
    LAS unsigned* ctl = wtot + 16;
    if (n == SEQ) {
        float kv[16];
#pragma unroll
        for (int i = 0; i < 16; ++i) kv[i] = aff[F.tid + NTHR * i];
#pragma unroll
        for (int i = 0; i < 16; ++i) keys[F.tid + NTHR * i] = __builtin_bit_cast(unsigned, kv[i]);
    } else for (int i = F.tid; i < n; i += NTHR) keys[i] = __builtin_bit_cast(unsigned, aff[i]);
    unsigned prefix = 0u, mask = 0u; int kk = cap;
    for (int pass = 0; pass < 4; ++pass) { const int shift = 24 - 8 * pass;
        if (F.tid < 256) hist[F.tid] = 0u;
        LDS_WAIT(); __syncthreads();
        for (int i = F.tid; i < n; i += NTHR) { const unsigned k = keys[i]; if ((k & mask) == prefix) atomicAdd((unsigned*)&hist[(k >> shift) & 255u], 1u); }
        LDS_WAIT(); __syncthreads();
        if (F.wave == 0) {
            const v4u c = *(const LAS v4u*)(hist + 4 * F.lane); const unsigned s4 = c.x + c.y + c.z + c.w; unsigned suf = s4;
#pragma unroll
            for (int d = 1; d < 64; d <<= 1) { const unsigned t = __shfl_down(suf, d); if (F.lane + d < 64) suf += t; }
            const unsigned above = suf - s4;
            if (above < (unsigned)kk && suf >= (unsigned)kk) { unsigned cum = above; int bin;
                if (cum + c.w >= (unsigned)kk) bin = 3; else { cum += c.w; if (cum + c.z >= (unsigned)kk) bin = 2; else { cum += c.z; if (cum + c.y >= (unsigned)kk) bin = 1; else { cum += c.y; bin = 0; } } }
                ctl[0] = (unsigned)(4 * F.lane + bin); ctl[1] = (unsigned)kk - cum; } }
        LDS_WAIT(); __syncthreads();
        prefix |= ctl[0] << shift; mask |= 0xFFu << shift; kk = (int)ctl[1];
        __syncthreads();
    }
    const unsigned T = prefix;
    const int per = (n + NTHR - 1) / NTHR, i0 = F.tid * per;
    unsigned ngt = 0u, neq = 0u;
    for (int i = i0; i < i0 + per && i < n; ++i) { const unsigned k = keys[i]; ngt += k > T; neq += k == T; }
    unsigned igt = ngt, ieq = neq;
#pragma unroll
    for (int d = 1; d < 64; d <<= 1) { const unsigned a = __shfl_up(igt, d), b = __shfl_up(ieq, d); if (F.lane >= d) { igt += a; ieq += b; } }
    if (F.lane == 63) { wtot[2 * F.wave] = igt; wtot[2 * F.wave + 1] = ieq; }
    LDS_WAIT(); __syncthreads();
    unsigned bgt = igt - ngt, beq = ieq - neq;
    for (int w = 0; w < F.wave; ++w) { bgt += wtot[2 * w]; beq += wtot[2 * w + 1]; }
    int* IDX = WSP(int, WS_IDX); float* GV = WSP(float, WS_GVAL); int* ENT = WSP(int, WS_ENT);
    for (int i = i0; i < i0 + per && i < n; ++i) { const unsigned k = keys[i];
        const bool sel = k > T || (k == T && (int)beq < kk);
        if (sel) { const int slot = (int)bgt + ((int)beq < kk ? (int)beq : kk); const int sr = slab_base + slot, tr = tokrow_base + i;
            IDX[sr] = tr; GV[sr] = __builtin_bit_cast(float, k); ENT[(size_t)tr * 16 + e] = sr; }
        bgt += k > T; beq += k == T; }
    __syncthreads();
}
__device__ __forceinline__ void s8_gather(Frame& F, bool do_ctx) {
    const int gw = F.wg * NWAVES + F.wave, NGW = F.G * NWAVES;
    const int* IDX = WSP(int, WS_IDX); const bf16* HX = HXP(); bf16* XE = WSP(bf16, WS_REGB);
    const int total = SLAB_L + (do_ctx ? NE * 128 : 0);
    for (int i = gw; i < total; i += NGW) {
        const int sr = i < SLAB_L ? i : SLAB_L + ((i - SLAB_L) >> 7) * 256 + ((i - SLAB_L) & 127);
        const int tr = IDX[sr];
        const v4u a = *(const v4u*)(HX + (size_t)tr * D + 8 * F.lane), b = *(const v4u*)(HX + (size_t)tr * D + 512 + 8 * F.lane);
        *(v4u*)(XE + (size_t)sr * D + 8 * F.lane) = a; *(v4u*)(XE + (size_t)sr * D + 512 + 8 * F.lane) = b; }
}
__device__ __forceinline__ void s11_finish_row(Frame& F, int l, int row, bf16* xr, f32x4 (&v)[4], const f32x4 (&acc)[4], bool last) {
    const float* MS = WSP(float, WS_MODS); const int s = row_set(row);
    const float* gate = MS + ((size_t)l * 5 + s) * 6144 + 5 * 1024;
#pragma unroll
    for (int j = 0; j < 4; ++j) v[j] += *(const f32x4*)(gate + ROWCOL(F.lane, j)) * acc[j];
    if (!last) {
        store_row8(xr, F.lane, v);
        const float* m = MS + ((size_t)(l + 1) * 5 + s) * 6144;
        norm_mod_store8(v, INP(I_GN1) + (l + 1) * 1024, m, m + 1024, HXP() + (size_t)row * D, F.lane);
    } else {
        float ss = 0.f;
#pragma unroll
        for (int j = 0; j < 4; ++j) ss += (v[j].x * v[j].x + v[j].y * v[j].y) + (v[j].z * v[j].z + v[j].w * v[j].w);
        const float rstd = rsq_(wave_sum_fast(ss) * (1.0f / D) + EPS);
#pragma unroll
        for (int j = 0; j < 4; ++j) *(f32x4*)(OUTP() + (size_t)row * D + ROWCOL(F.lane, j)) = v[j] * rstd * *(const f32x4*)(INP(I_GF) + ROWCOL(F.lane, j));
    }
}
__device__ __forceinline__ void s11_combine(Frame& F, int l, bool do_ctx, bool last) {
    const int gw = F.wg * NWAVES + F.wave, NGW = F.G * NWAVES;
    const bf16* YS = WSP(bf16, WS_REGB); const int* ENT = WSP(int, WS_ENT); bf16* XB = XBP();
    const int npairs = (do_ctx ? NROW : NLAT) / 2;
    v4u ra_[2], rb_[2]; int ent = -1;
    if (gw < npairs) { const bf16* xr = XB + (size_t)(2 * gw) * D;
#pragma unroll
        for (int h = 0; h < 2; ++h) { ra_[h] = *(const v4u*)(xr + 8 * F.lane + 512 * h); rb_[h] = *(const v4u*)(xr + D + 8 * F.lane + 512 * h); }
        ent = F.lane < 32 ? ENT[(size_t)(2 * gw) * 16 + F.lane] : -1; }
    for (int rp = gw; rp < npairs; rp += NGW) {
        const int ra = 2 * rp; bf16* xa = XB + (size_t)ra * D; bf16* xb = xa + D;
        f32x4 aa[4], ab[4]; v4u na_[2], nb_[2]; int nent = -1; const bool more = rp + NGW < npairs;
#pragma unroll
        for (int j = 0; j < 4; ++j) { aa[j] = (f32x4){0.f, 0.f, 0.f, 0.f}; ab[j] = (f32x4){0.f, 0.f, 0.f, 0.f}; }
        if (more) { const int rn = 2 * (rp + NGW); const bf16* xr = XB + (size_t)rn * D;
#pragma unroll
            for (int h = 0; h < 2; ++h) { na_[h] = *(const v4u*)(xr + 8 * F.lane + 512 * h); nb_[h] = *(const v4u*)(xr + D + 8 * F.lane + 512 * h); }
            nent = F.lane < 32 ? ENT[(size_t)rn * 16 + F.lane] : -1; }
        const unsigned long long bm = __ballot(ent >= 0);
        unsigned ma = (unsigned)bm & 0xffffu, mb = ((unsigned)bm >> 16) & 0xffffu;
        do {
            int sa[4], sb[4]; float wa[4], wb[4];
#pragma unroll
            for (int j = 0; j < 4; ++j) {
                if (ma) { const int e = __builtin_ctz(ma); ma &= ma - 1; sa[j] = __builtin_amdgcn_readlane(ent, e); wa[j] = 1.f; } else { sa[j] = 0; wa[j] = 0.f; }
                if (mb) { const int e = __builtin_ctz(mb); mb &= mb - 1; sb[j] = __builtin_amdgcn_readlane(ent, 16 + e); wb[j] = 1.f; } else { sb[j] = 0; wb[j] = 0.f; } }
            v4u ya[4][2], yb[4][2];
#pragma unroll
            for (int j = 0; j < 4; ++j)
#pragma unroll
                for (int h = 0; h < 2; ++h) { ya[j][h] = *(const v4u*)(YS + (size_t)sa[j] * D + 8 * F.lane + 512 * h); yb[j][h] = *(const v4u*)(YS + (size_t)sb[j] * D + 8 * F.lane + 512 * h); }
#pragma unroll
            for (int j = 0; j < 4; ++j)
#pragma unroll
                for (int h = 0; h < 2; ++h) {
                    aa[2 * h].x += wa[j] * bf2f(ya[j][h].x & 0xffffu); aa[2 * h].y += wa[j] * bf2f(ya[j][h].x >> 16); aa[2 * h].z += wa[j] * bf2f(ya[j][h].y & 0xffffu); aa[2 * h].w += wa[j] * bf2f(ya[j][h].y >> 16);
                    aa[2 * h + 1].x += wa[j] * bf2f(ya[j][h].z & 0xffffu); aa[2 * h + 1].y += wa[j] * bf2f(ya[j][h].z >> 16); aa[2 * h + 1].z += wa[j] * bf2f(ya[j][h].w & 0xffffu); aa[2 * h + 1].w += wa[j] * bf2f(ya[j][h].w >> 16);
                    ab[2 * h].x += wb[j] * bf2f(yb[j][h].x & 0xffffu); ab[2 * h].y += wb[j] * bf2f(yb[j][h].x >> 16); ab[2 * h].z += wb[j] * bf2f(yb[j][h].y & 0xffffu); ab[2 * h].w += wb[j] * bf2f(yb[j][h].y >> 16);
                    ab[2 * h + 1].x += wb[j] * bf2f(yb[j][h].z & 0xffffu); ab[2 * h + 1].y += wb[j] * bf2f(yb[j][h].z >> 16); ab[2 * h + 1].z += wb[j] * bf2f(yb[j][h].w & 0xffffu); ab[2 * h + 1].w += wb[j] * bf2f(yb[j][h].w >> 16); }
        } while (ma | mb);
        f32x4 va[4], vb[4];
#pragma unroll
        for (int h = 0; h < 2; ++h) {
            va[2 * h] = (f32x4){bf2f(ra_[h].x & 0xffffu), bf2f(ra_[h].x >> 16), bf2f(ra_[h].y & 0xffffu), bf2f(ra_[h].y >> 16)}; va[2 * h + 1] = (f32x4){bf2f(ra_[h].z & 0xffffu), bf2f(ra_[h].z >> 16), bf2f(ra_[h].w & 0xffffu), bf2f(ra_[h].w >> 16)};
            vb[2 * h] = (f32x4){bf2f(rb_[h].x & 0xffffu), bf2f(rb_[h].x >> 16), bf2f(rb_[h].y & 0xffffu), bf2f(rb_[h].y >> 16)}; vb[2 * h + 1] = (f32x4){bf2f(rb_[h].z & 0xffffu), bf2f(rb_[h].z >> 16), bf2f(rb_[h].w & 0xffffu), bf2f(rb_[h].w >> 16)}; }
        s11_finish_row(F, l, ra, xa, va, aa, last);
        s11_finish_row(F, l, ra + 1, xb, vb, ab, last);
        if (more) { ent = nent;
#pragma unroll
            for (int h = 0; h < 2; ++h) { ra_[h] = na_[h]; rb_[h] = nb_[h]; } }
    }
}

constexpr int N_PHASES = 26;
#define PH_IN(k) (lo <= (k) && (k) < hi)
#define PH_SEAM(k) do { if ((k) + 1 < hi) xcd_barrier(bar); } while (0)
#ifndef DUP_PHASE
#define DUP_PHASE (-1)
#endif
#ifndef DUP_N
#define DUP_N 1
#endif
#define PH_BEGIN(k) if (PH_IN(k)) { for (int rep_ = 0; rep_ < ((k) == DUP_PHASE ? DUP_N : 1); ++rep_) { if (rep_) xcd_barrier(bar); relaunder(F);
#define PH_END(k) } PH_SEAM(k); }
template <int l> __device__ __forceinline__ void layer_steps(Frame& F, const Args& args, const XcdBarrier& bar, const int lo, const int hi) {
    constexpr int P0 = l == 0 ? 3 : 15;
    constexpr bool last = l == 1, do_ctx = !last;
    PH_BEGIN(P0 + 0)
        pg8::Gemm g{(pg8::bf16_t*)HXP(), WSP(pg8::bf16_t, WS_WIN) + (size_t)l * INC * 1024, NROW, INC, D, nullptr};
        pg8::StaticOrder S; S.init(NROW, INC, F.G, F.wg);
        pg8::EpiInProj E{WSP(pg8::bf16_t, WS_REGA), PXC};
        pg8::gemm_phase<pg8::EpiInProj, pg8::StaticOrder, true, true>(F.lds, g, S, E);
        if (F.wg >= 164) filler(F, 3, -1);
        PH_END(P0 + 0)
    PH_BEGIN(P0 + 1)
        for (int u = F.wg; u < NB * 64; u += F.G) dft1_unit(F, u >> 6, u & 63);
        lru_a_phase(F, l);
        if (F.wg >= 32) filler(F, 1, -1);
        PH_END(P0 + 1)
    PH_BEGIN(P0 + 2)
        if (F.wg >= 192) s3_carries(F, (F.wg - 192) * NWAVES + F.wave);
        { LAS bf16* t2l = (LAS bf16*)(F.lds + 67584);
          const bf16* T2 = WSP(bf16, WS_T2M);
          for (int i = F.tid; i < 64 * 16; i += NTHR) { const int r = i >> 4, c = i & 15; *(LAS v4u*)(t2l + r * 136 + c * 8) = *(const v4u*)(T2 + r * 128 + c * 8); }
          LDS_WAIT(); __syncthreads();
          if (do_ctx && F.wg < 16) { const int b = F.wg >> 2, mq = F.wg & 3;
              dft2_unit(F, l, WSP(bf16, WS_TCM), 512, 64 * mq, 4, WSP(bf16, WS_REGA) + (size_t)(NLAT + CTXL * b) * PXC + PX_Z, PXC, (size_t)64 * PXC, 0.0078125f, NLAT + CTXL * b + 64 * mq, 1, nullptr);
          } else { const int w0 = do_ctx ? 16 : 0, nw = F.G - w0;
              for (int u = F.wg - w0; u < NB * 128; u += nw) { const int b = u >> 7, kp = u & 127;
                  dft2_unit(F, l, WSP(bf16, WS_T2M), 128, 0, 1, WSP(bf16, WS_T1) + (size_t)(b * 128 + kp) * 64 * 512, 512, 0, 0.001381067932004976f, b * SEQ + kp, 128, t2l); } } }
        PH_END(P0 + 2)
    PH_BEGIN(P0 + 3)
        const int nc = do_ctx ? NCHUNK : 512;
        if (do_ctx) sc_phase(F, l, nc, 16, F.G - 16); else sc_phase(F, l, nc, 0, F.G);
        lru_b_phase(F, l, nc);
        PH_END(P0 + 3)
    PH_BEGIN(P0 + 4)
        pg8::Gemm g{(pg8::bf16_t*)HXP(), WSP(pg8::bf16_t, WS_WOUT) + (size_t)l * 1024 * 1024, NLAT, D, D, nullptr};
        pg8::StaticOrder S; S.init(NLAT, D, F.G, F.wg);
        pg8::EpiResid E{INP(I_X), INP(I_CTX), (pg8::bf16_t*)XBP(), WSP(float, WS_MODS) + (size_t)l * 5 * 6144 + 2 * 1024, NLAT, l == 0};
        pg8::gemm_phase<pg8::EpiResid, pg8::StaticOrder, true, true>(F.lds, g, S, E);
        PH_END(P0 + 4)
    PH_BEGIN(P0 + 5)
        if (do_ctx) {
            int* IDX = WSP(int, WS_IDX); for (int i = F.wg * NTHR + F.tid; i < NE * 256; i += F.G * NTHR) IDX[SLAB_L + i] = NLAT;
            if (F.wg < 16) {
                pg8::Gemm g{(pg8::bf16_t*)HXP(), WSP(pg8::bf16_t, WS_WOUT) + (size_t)l * 1024 * 1024, NROW, D, D, nullptr};
                pg8::CtxOrder S{F.wg};
                pg8::EpiResid E{INP(I_X), INP(I_CTX), (pg8::bf16_t*)XBP(), WSP(float, WS_MODS) + (size_t)l * 5 * 6144 + 2 * 1024, NLAT, l == 0};
                pg8::gemm_phase<pg8::EpiResid, pg8::CtxOrder, true, true>(F.lds, g, S, E);
                VM_WAIT(); __syncthreads();
                if (F.tid == 0) { unsigned* ctr = WSP(unsigned, WS_CTL) + 192 + 64 * l;
                    __builtin_amdgcn_fence(__ATOMIC_RELEASE, "agent"); VM_WAIT();
                    __hip_atomic_fetch_add(ctr, 1u, __ATOMIC_RELAXED, __HIP_MEMORY_SCOPE_AGENT);
                    unsigned sp = 0; while (__hip_atomic_load(ctr, __ATOMIC_RELAXED, __HIP_MEMORY_SCOPE_AGENT) < 16u && ++sp < (1u << 22)) __builtin_amdgcn_s_sleep(2);
                    __builtin_amdgcn_fence(__ATOMIC_ACQUIRE, "agent"); VM_WAIT(); }
                __syncthreads();
                relaunder(F);
                s6_norm2_router(F, l, NLAT / 2, NROW / 2, F.wg * NWAVES + F.wave, 16 * NWAVES);
            } else s6_norm2_router(F, l, 0, NLAT / 2, (F.wg - 16) * NWAVES + F.wave, (F.G - 16) * NWAVES);
        } else s6_norm2_router(F, l, 0, NLAT / 2, F.wg * NWAVES + F.wave, F.G * NWAVES);
        PH_END(P0 + 5)
    PH_BEGIN(P0 + 6)
        const int np = do_ctx ? 128 : 64;
        if (F.wg >= np) filler(F, 4, -1);
        for (int p = F.wg; p < np; p += F.G) {
            if (p < 64) { const int b = p >> 4, e = p & 15; s7_topk_problem(F, WSP(float, WS_AFFL) + (size_t)p * SEQ, SEQ, CAP_L, (b * 16 + e) * CAP_L, b * SEQ, e); }
            else { const int q = p - 64, b = q >> 4, e = q & 15; s7_topk_problem(F, WSP(float, WS_AFFC) + (size_t)q * CTXL, CTXL, CAP_C, SLAB_L + e * 256 + b * CAP_C, NLAT + b * CTXL, e); } }
        filler(F, 0, l);
        PH_END(P0 + 6)
    PH_BEGIN(P0 + 8)
        pg8::Gemm g{(pg8::bf16_t*)HXP(), WSP(pg8::bf16_t, WS_WGU + (size_t)l * WS_WEXP_L), SLAB_ROWS, NE * 2048, D, WSP(int, WS_IDX)};
        pg8::MoeOrder1 S{F.wg, do_ctx};
        pg8::EpiSwiGLU E{WSP(pg8::bf16_t, WS_REGA), D};
        pg8::gemm_phase<pg8::EpiSwiGLU, pg8::MoeOrder1, true, true, true>(F.lds, g, S, E);
        if (do_ctx && F.wg >= 128) filler(F, 5, -1);
        PH_END(P0 + 8)
    PH_BEGIN(P0 + 9)
        pg8::Gemm g{WSP(pg8::bf16_t, WS_REGA), WSP(pg8::bf16_t, WS_WD + (size_t)l * WS_WEXP_L), SLAB_ROWS, NE * 1024, D, nullptr};
        pg8::MoeOrder2 S{F.wg, do_ctx};
        pg8::EpiScaleBf16 E{WSP(pg8::bf16_t, WS_REGB), D, WSP(float, WS_GVAL)};
        pg8::gemm_phase<pg8::EpiScaleBf16, pg8::MoeOrder2, true, true>(F.lds, g, S, E);
        if (do_ctx && F.wg >= 64) filler(F, 4, -1);
        PH_END(P0 + 9)
    PH_BEGIN(P0 + 10) s11_combine(F, l, do_ctx, last); PH_END(P0 + 10)
}
__global__ void __launch_bounds__(NTHR, 2) fwd(Args args) {
    extern __shared__ __attribute__((aligned(16))) unsigned char lds_raw[];
    Frame F;
    F.lds = (LAS unsigned char*)lds_raw;
    F.tid = threadIdx.x; F.lane = F.tid & 63; F.wave = __builtin_amdgcn_readfirstlane(F.tid >> 6);
    F.G = gridDim.x; F.wg = blockIdx.x;
    volatile LAS unsigned* MISC = (volatile LAS unsigned*)(F.lds + MISC_OFF);
    if (F.tid < 64) MISC[F.tid] = 0u;
    if (F.tid == 0) { LAS unsigned long long* PT = (LAS unsigned long long*)(F.lds + PT_OFF);
#pragma unroll
        for (int i = 0; i < N_IN; ++i) PT[i] = (unsigned long long)args.in[i];
        PT[N_IN] = (unsigned long long)args.out; PT[N_IN + 1] = (unsigned long long)args.ws; }
    LDS_WAIT(); __syncthreads();
    const int lo = args.ph_lo, hi = args.ph_hi;
    unsigned* barw = (unsigned*)(args.ws + WS_CTL) + CW_BAR + args.bar_region * XCD_BAR_WORDS;
    XcdBarrier bar; bar.bar = barw; bar.x = 0; bar.st = MISC + 8;
    if (hi - lo > 1) bar = xcd_barrier_post(barw, MISC + 8);
    PH_BEGIN(0) p0_prep(F); PH_END(0)
    PH_BEGIN(1) p0b_mods(F); PH_END(1)
    PH_BEGIN(2) s0_norm1(F); PH_END(2)
    layer_steps<0>(F, args, bar, lo, hi);
    layer_steps<1>(F, args, bar, lo, hi);
}

extern "C" void kernel_launch(void* const* d_in, const int* in_sizes, int n_in, void* d_out, int out_size, void* d_ws, size_t ws_size, hipStream_t stream) {
    static int grid = 0;
    if (grid == 0) {
        if (n_in != N_IN || out_size != NLAT * D || ws_size < WS_END) { fprintf(stderr, "kernel_launch: unexpected shapes (n_in %d, out %d, ws %zu, need %zu)\n", n_in, out_size, ws_size, (size_t)WS_END); grid = -1; return; }
        int dev = 0, cus = 0, per_cu = 0;
        if (hipGetDevice(&dev) != hipSuccess || hipDeviceGetAttribute(&cus, hipDeviceAttributeMultiprocessorCount, dev) != hipSuccess) { grid = -1; return; }
        if (hipFuncSetAttribute((const void*)fwd, hipFuncAttributeMaxDynamicSharedMemorySize, LDS_BYTES) != hipSuccess) { fprintf(stderr, "kernel_launch: hipFuncSetAttribute failed\n"); grid = -1; return; }
        if (hipOccupancyMaxActiveBlocksPerMultiprocessor(&per_cu, (const void*)fwd, NTHR, LDS_BYTES) != hipSuccess || per_cu < 1) { fprintf(stderr, "kernel_launch: occupancy query says %d\n", per_cu); }
        (void)hipGetLastError();
        grid = cus;
        if (grid != 256) { fprintf(stderr, "kernel_launch: needs a 256-CU device (got %d)\n", grid); grid = -1; return; }
    }
    if (grid < 0) return;
    (void)hipMemsetAsync((char*)d_ws + WS_CTL, 0, CTL_ZERO_BYTES, stream);
    Args a{};
    for (int i = 0; i < N_IN; ++i) a.in[i] = (const float*)d_in[i];
    a.out = (float*)d_out; a.ws = (unsigned char*)d_ws;
#ifndef ONE_LAUNCH
#define ONE_LAUNCH 1
#endif
#ifndef PROBE_K
#define PROBE_K (-1)
#endif
#ifndef PROBE_N
#define PROBE_N 1
#endif
    if (PROBE_K >= 0) {
        a.ph_lo = 0; a.ph_hi = PROBE_K + 1; a.bar_region = 0; hipLaunchKernelGGL(fwd, dim3(grid), dim3(NTHR), LDS_BYTES, stream, a);
        for (int r = 1; r < PROBE_N; ++r) { a.ph_lo = PROBE_K; a.ph_hi = PROBE_K + 1; hipLaunchKernelGGL(fwd, dim3(grid), dim3(NTHR), LDS_BYTES, stream, a); }
        if (PROBE_K + 1 < N_PHASES) { a.ph_lo = PROBE_K + 1; a.ph_hi = N_PHASES; a.bar_region = 1; hipLaunchKernelGGL(fwd, dim3(grid), dim3(NTHR), LDS_BYTES, stream, a); }
    } else if (ONE_LAUNCH) { a.ph_lo = 0; a.ph_hi = N_PHASES; hipLaunchKernelGGL(fwd, dim3(grid), dim3(NTHR), LDS_BYTES, stream, a); }
    else for (int ph = 0; ph < N_PHASES; ++ph) { a.ph_lo = ph; a.ph_hi = ph + 1; hipLaunchKernelGGL(fwd, dim3(grid), dim3(NTHR), LDS_BYTES, stream, a); }
}
```

```cpp
#include <hip/hip_runtime.h>
#include <cstdio>
#include <cstdint>
#define LAS __attribute__((address_space(3)))
namespace pg8 {
#define PG8_LAS __attribute__((address_space(3)))
typedef unsigned short bf16_t;
typedef short bf16x8 __attribute__((ext_vector_type(8)));
typedef float f32x4 __attribute__((ext_vector_type(4)));
typedef unsigned u32x4 __attribute__((ext_vector_type(4)));
constexpr int BM = 256, BK = 64, HALF = 128, HTB = HALF * BK * 2  , STAGE_BYTES = 8 * HTB, NXCD = 8, WGM = 8;

__host__ __device__ __forceinline__ int lds_byte(int r, int c) { const int st = (r >> 4) * 2 + (c >> 5), rr = r & 15, cc = c & 31, ob = rr * 64 + cc * 2; return st * 1024 + (ob ^ (((ob >> 9) & 1) << 5)); }
__host__ __device__ __forceinline__ void stage_rc(int b, int& R, int& C) { const int st = b / 1024, sb = b % 1024, swz = sb ^ (((sb >> 9) & 1) << 5); R = (st >> 1) * 16 + swz / 64; C = (st & 1) * 32 + (swz % 64) / 2; }
__host__ __device__ __forceinline__ int perm32(int rho) { const int n = rho >> 4, i = rho & 15; return 8 * (i >> 2) + 4 * n + (i & 3); }

struct Unit { int pm, pn; };
struct Gemm { const bf16_t* A; const bf16_t* Bt; int M, N, K; const int* gidx; };

struct StaticOrder {
    int nM, nN, nwg, G, c;
    __host__ __device__ void init(int M, int N, int G_, int c_) { nM = M / BM; nN = N / BM; nwg = nM * nN; G = G_; c = c_; }
    __host__ __device__ bool next(int i, Unit& u) const {
        const long L = (long)i * G + c; if (L >= nwg) return false;
        int wgid = (int)L; { const int q = nwg / NXCD, r = nwg % NXCD, xcd = wgid % NXCD, off = wgid / NXCD; wgid = (xcd < r ? xcd * (q + 1) : r * (q + 1) + (xcd - r) * q) + off; }
        const int nig = WGM * nN, gid = wgid / nig, fm = gid * WGM, gsz = (nM - fm) < WGM ? (nM - fm) : WGM;
        u.pm = fm + ((wgid % nig) % gsz); u.pn = (wgid % nig) / gsz; return true;
    }
    __device__ __forceinline__ void a_ready(const Unit&) const {}
    __device__ __forceinline__ void done(const Unit&) const {}
};


__device__ __forceinline__ unsigned cvt_pk_bf16(float lo, float hi) { unsigned r; asm volatile("v_cvt_pk_bf16_f32 %0, %1, %2" : "=v"(r) : "v"(lo), "v"(hi)); return r; }

struct EpiBf16Plain {
    static constexpr bool PERM = true, AFTER_DRAIN = false, HAS_PRE = false;
    bf16_t* O; int ldc;
    __device__ __forceinline__ void operator()(const f32x4 (&acc)[2][2][4][2], const Unit& u, int wr, int wc, int fr, int fq) const {
        const int row0 = u.pm * BM + wr * 64 + fr; const int col0 = u.pn * BM + wc * 32 + 8 * fq;
#pragma unroll
        for (int ai = 0; ai < 2; ++ai)
#pragma unroll
            for (int m = 0; m < 4; ++m) { bf16_t* rowp = O + (size_t)(row0 + ai * HALF + m * 16) * ldc + col0;
#pragma unroll
                for (int bj = 0; bj < 2; ++bj) { const f32x4 v0 = acc[ai][bj][m][0], v1 = acc[ai][bj][m][1];
                    u32x4 w; w.x = cvt_pk_bf16(v0[0], v0[1]); w.y = cvt_pk_bf16(v0[2], v0[3]); w.z = cvt_pk_bf16(v1[0], v1[1]); w.w = cvt_pk_bf16(v1[2], v1[3]);
                    *(u32x4*)(rowp + bj * HALF) = w; } }
    }
};
struct EpiInProj {
    static constexpr bool PERM = true, AFTER_DRAIN = false, HAS_PRE = false;
    bf16_t* O; int ldc; bf16_t* ZB;
    __device__ __forceinline__ void operator()(const f32x4 (&acc)[2][2][4][2], const Unit& u, int wr, int wc, int fr, int fq) const {
        const int row0 = u.pm * BM + wr * 64 + fr;
        if (u.pn == 5 || u.pn == 6) { const int col0 = 1280 + (u.pn - 5) * HALF + wc * 32 + 8 * fq;
#pragma unroll
            for (int ai = 0; ai < 2; ++ai)
#pragma unroll
                for (int m = 0; m < 4; ++m) { const f32x4 v0 = acc[ai][0][m][0] * acc[ai][1][m][0], v1 = acc[ai][0][m][1] * acc[ai][1][m][1];
                    u32x4 w; w.x = cvt_pk_bf16(v0[0], v0[1]); w.y = cvt_pk_bf16(v0[2], v0[3]); w.z = cvt_pk_bf16(v1[0], v1[1]); w.w = cvt_pk_bf16(v1[2], v1[3]);
                    *(u32x4*)(O + (size_t)(row0 + ai * HALF + m * 16) * ldc + col0) = w; }
        } else if (u.pn >= 7 && u.pm < 128) {
            const int col0 = (u.pn - 7) * BM + wc * 32 + 8 * fq;
#pragma unroll
            for (int ai = 0; ai < 2; ++ai)
#pragma unroll
                for (int m = 0; m < 4; ++m) { const int r = row0 + ai * HALF + m * 16, t = r & 8191, zr = (((r >> 13) * 64 + (t & 63)) * 128 + (t >> 6)); bf16_t* rowp = ZB + (size_t)zr * 512 + col0;
#pragma unroll
                    for (int bj = 0; bj < 2; ++bj) { const f32x4 v0 = acc[ai][bj][m][0], v1 = acc[ai][bj][m][1];
                        u32x4 w; w.x = cvt_pk_bf16(v0[0], v0[1]); w.y = cvt_pk_bf16(v0[2], v0[3]); w.z = cvt_pk_bf16(v1[0], v1[1]); w.w = cvt_pk_bf16(v1[2], v1[3]);
                        *(u32x4*)(rowp + bj * HALF) = w; } }
        } else { const int col0 = (u.pn < 5 ? u.pn : u.pn - 1) * BM + wc * 32 + 8 * fq;
#pragma unroll
            for (int ai = 0; ai < 2; ++ai)
#pragma unroll
                for (int m = 0; m < 4; ++m) { bf16_t* rowp = O + (size_t)(row0 + ai * HALF + m * 16) * ldc + col0;
#pragma unroll
                    for (int bj = 0; bj < 2; ++bj) { const f32x4 v0 = acc[ai][bj][m][0], v1 = acc[ai][bj][m][1];
                        u32x4 w; w.x = cvt_pk_bf16(v0[0], v0[1]); w.y = cvt_pk_bf16(v0[2], v0[3]); w.z = cvt_pk_bf16(v1[0], v1[1]); w.w = cvt_pk_bf16(v1[2], v1[3]);
                        *(u32x4*)(rowp + bj * HALF) = w; } }
        }
    }
};
struct EpiSwiGLU {
    static constexpr bool PERM = true, AFTER_DRAIN = false, HAS_PRE = false;
    bf16_t* H; int ldc;
    __device__ __forceinline__ void operator()(const f32x4 (&acc)[2][2][4][2], const Unit& u, int wr, int wc, int fr, int fq) const {
        const int row0 = u.pm * BM + wr * 64 + fr; const int col0 = (u.pn & 7) * HALF + wc * 32 + 8 * fq;
#pragma unroll
        for (int ai = 0; ai < 2; ++ai)
#pragma unroll
            for (int m = 0; m < 4; ++m) { bf16_t* rowp = H + (size_t)(row0 + ai * HALF + m * 16) * ldc + col0;
                float o[8];
#pragma unroll
                for (int n = 0; n < 2; ++n)
#pragma unroll
                    for (int i = 0; i < 4; ++i) { const float g = acc[ai][0][m][n][i], up = acc[ai][1][m][n][i];
                        o[n * 4 + i] = g * __builtin_amdgcn_rcpf(1.0f + __expf(-g)) * up; }
                u32x4 w; w.x = cvt_pk_bf16(o[0], o[1]); w.y = cvt_pk_bf16(o[2], o[3]); w.z = cvt_pk_bf16(o[4], o[5]); w.w = cvt_pk_bf16(o[6], o[7]);
                *(u32x4*)rowp = w; }
    }
};
struct EpiScaleBf16 {
    static constexpr bool PERM = true, AFTER_DRAIN = false, HAS_PRE = true;
    struct Pre { float g[2][4]; };
    bf16_t* Y; int ldc; const float* gval;
    __device__ __forceinline__ void pre(Pre& p, const Unit& u, int wr, int wc, int fr, int fq) const {
        const int row0 = u.pm * BM + wr * 64 + fr;
#pragma unroll
        for (int ai = 0; ai < 2; ++ai)
#pragma unroll
            for (int m = 0; m < 4; ++m) p.g[ai][m] = gval[row0 + ai * HALF + m * 16];
    }
    __device__ __forceinline__ void operator()(const f32x4 (&acc)[2][2][4][2], const Unit& u, int wr, int wc, int fr, int fq, const Pre& p) const {
        const int row0 = u.pm * BM + wr * 64 + fr; const int col0 = (u.pn & 3) * BM + wc * 32 + 8 * fq;
#pragma unroll
        for (int ai = 0; ai < 2; ++ai)
#pragma unroll
            for (int m = 0; m < 4; ++m) { const int row = row0 + ai * HALF + m * 16; const float g = p.g[ai][m]; bf16_t* rowp = Y + (size_t)row * ldc + col0;
#pragma unroll
                for (int bj = 0; bj < 2; ++bj) { const f32x4 v0 = acc[ai][bj][m][0] * g, v1 = acc[ai][bj][m][1] * g;
                    u32x4 w; w.x = cvt_pk_bf16(v0[0], v0[1]); w.y = cvt_pk_bf16(v0[2], v0[3]); w.z = cvt_pk_bf16(v1[0], v1[1]); w.w = cvt_pk_bf16(v1[2], v1[3]);
                    *(u32x4*)(rowp + bj * HALF) = w; } }
    }
};
struct EpiResid {
    static constexpr bool PERM = true, AFTER_DRAIN = false, HAS_PRE = true;
    struct Pre { u32x4 w[2][2]; };
    const float* xin_lat; const float* xin_ctx; bf16_t* xb; const float* gate  ; int nlat; bool in_f32;
    __device__ __forceinline__ void pre(Pre& p, const Unit& u, int wr, int wc, int fr, int fq) const {
        const int row0 = u.pm * BM + wr * 64 + fr, col0 = u.pn * BM + wc * 32 + 8 * fq;
        if (in_f32) { const float* xin = (u.pm * BM >= nlat) ? xin_ctx - (size_t)nlat * 1024 : xin_lat;
#pragma unroll
            for (int bj = 0; bj < 2; ++bj) { p.w[0][bj] = *(const u32x4*)(xin + (size_t)row0 * 1024 + col0 + bj * HALF); p.w[1][bj] = *(const u32x4*)(xin + (size_t)row0 * 1024 + col0 + bj * HALF + 4); }
            return; }
#pragma unroll
        for (int m = 0; m < 2; ++m)
#pragma unroll
            for (int bj = 0; bj < 2; ++bj) p.w[m][bj] = *(const u32x4*)(xb + (size_t)(row0 + m * 16) * 1024 + col0 + bj * HALF);
    }
    __device__ __forceinline__ void operator()(const f32x4 (&acc)[2][2][4][2], const Unit& u, int wr, int wc, int fr, int fq, const Pre& p) const {
        const int trow = u.pm * BM; const bool isctx = trow >= nlat;
        const int s = isctx ? 4 : (trow >> 13);
        const float* xin = isctx ? xin_ctx - (size_t)nlat * 1024 : xin_lat;
        const float* gp = gate + (size_t)s * 6144;
        const int row0 = trow + wr * 64 + fr, col0 = u.pn * BM + wc * 32 + 8 * fq;
        f32x4 gv[2][2];
#pragma unroll
        for (int bj = 0; bj < 2; ++bj)
#pragma unroll
            for (int n = 0; n < 2; ++n) gv[bj][n] = *(const f32x4*)(gp + col0 + bj * HALF + 4 * n);
#pragma unroll
        for (int ai = 0; ai < 2; ++ai)
#pragma unroll
            for (int m = 0; m < 4; ++m) { const size_t off = (size_t)(row0 + ai * HALF + m * 16) * 1024 + col0;
#pragma unroll
                for (int bj = 0; bj < 2; ++bj) { f32x4 x0, x1;
                    if (in_f32) { if (ai == 0 && m == 0) { x0 = __builtin_bit_cast(f32x4, p.w[0][bj]); x1 = __builtin_bit_cast(f32x4, p.w[1][bj]); } else { x0 = *(const f32x4*)(xin + off + bj * HALF); x1 = *(const f32x4*)(xin + off + bj * HALF + 4); } }
                    else { u32x4 w; if (ai == 0 && m < 2) w = p.w[m][bj]; else w = *(const u32x4*)(xb + off + bj * HALF);
                        x0 = (f32x4){__builtin_bit_cast(float, w.x << 16), __builtin_bit_cast(float, w.x & 0xffff0000u), __builtin_bit_cast(float, w.y << 16), __builtin_bit_cast(float, w.y & 0xffff0000u)};
                        x1 = (f32x4){__builtin_bit_cast(float, w.z << 16), __builtin_bit_cast(float, w.z & 0xffff0000u), __builtin_bit_cast(float, w.w << 16), __builtin_bit_cast(float, w.w & 0xffff0000u)}; }
                    x0 += gv[bj][0] * acc[ai][bj][m][0]; x1 += gv[bj][1] * acc[ai][bj][m][1];
                    u32x4 o; o.x = cvt_pk_bf16(x0[0], x0[1]); o.y = cvt_pk_bf16(x0[2], x0[3]); o.z = cvt_pk_bf16(x1[0], x1[1]); o.w = cvt_pk_bf16(x1[2], x1[3]);
                    *(u32x4*)(xb + off + bj * HALF) = o; } }
    }
};
struct MoeOrder1 {
    int c; bool ctx;
    __device__ __forceinline__ bool next(int i, Unit& u) const {
        if (i < 8) { const int P = i * 8 + (c & 7), j = c >> 3, e = P >> 2, b = P & 3; u.pm = (b * 16 + e) * 4 + (j >> 3); u.pn = e * 8 + (j & 7); return true; }
        if (i == 8 && ctx && c < 128) { const int e = c >> 3; u.pm = 256 + e; u.pn = e * 8 + (c & 7); return true; }
        return false;
    }
    __device__ __forceinline__ void a_ready(const Unit&) const {}
    __device__ __forceinline__ void done(const Unit&) const {}
};
struct CtxOrder {
    int c;
    __device__ __forceinline__ bool next(int i, Unit& u) const { if (i != 0 || c >= 16) return false; u.pm = 128 + (c >> 2); u.pn = c & 3; return true; }
    __device__ __forceinline__ void a_ready(const Unit&) const {}
    __device__ __forceinline__ void done(const Unit&) const {}
};
struct MoeOrder2 {
    int c; bool ctx;
    __device__ __forceinline__ bool next(int i, Unit& u) const {
        if (i < 4) { const int j = c >> 3, P = 63 - (i * 16 + (c & 7) * 2 + (j >> 4))  , e = P >> 2, b = P & 3; u.pm = (b * 16 + e) * 4 + ((j >> 2) & 3); u.pn = e * 4 + (j & 3); return true; }
        if (i == 4 && ctx && c < 64) { const int e = c >> 2; u.pm = 256 + e; u.pn = e * 4 + (c & 3); return true; }
        return false;
    }
    __device__ __forceinline__ void a_ready(const Unit&) const {}
    __device__ __forceinline__ void done(const Unit&) const {}
};

template <class Epi, bool HAS> struct PreOf { };
template <class Epi> struct PreOf<Epi, true> { typename Epi::Pre v; };
template <class Epi, class Sched, bool ALIGN_EPI = false, bool SP2 = false, bool GATHER = false, int HALF_FROM_PM = (1 << 30)>
__device__ __forceinline__ void gemm_phase(PG8_LAS unsigned char* lds, const Gemm g, const Sched& S, const Epi& E) {
    const int tid = threadIdx.x, wid = __builtin_amdgcn_readfirstlane(tid >> 6), lane = tid & 63, wr = wid >> 2, wc = wid & 3, fr = lane & 15, fq = lane >> 4;
    const int K = g.K, nt = K / BK;
    unsigned voffA[2], voffB[2]; int rowA[2]; unsigned colA2[2];
#pragma unroll
    for (int i = 0; i < 2; ++i) { int R, C; stage_rc(tid * 16 + i * 8192, R, C); const int Rb = Epi::PERM ? ((R & ~31) + perm32(R & 31)) : R;
        voffA[i] = (unsigned)(R * K + C) * 2u; voffB[i] = (unsigned)(Rb * K + C) * 2u; rowA[i] = R; colA2[i] = (unsigned)C * 2u; }
    unsigned gA[2][2], gN[2][2], gS[2][2], gRaw[2][2];
#define PG8_VA(h) (GATHER ? gA[h] : voffA)
#define PG8_VS(h) (GATHER ? gS[h] : voffA)
#define PG8_IDX_ISSUE(u) do { _Pragma("unroll") for (int _h = 0; _h < 2; ++_h) _Pragma("unroll") for (int _i = 0; _i < 2; ++_i) { const int* _p = g.gidx + (u).pm * BM + _h * HALF + rowA[_i]; \
        asm volatile("global_load_dword %0, %1, off" : "=v"(gRaw[_h][_i]) : "v"(_p) : "memory"); } } while (0)
#define PG8_IDX_TAKE(dst) do { _Pragma("unroll") for (int _h = 0; _h < 2; ++_h) _Pragma("unroll") for (int _i = 0; _i < 2; ++_i) { asm volatile("" : "+v"(gRaw[_h][_i])); dst[_h][_i] = gRaw[_h][_i] * (unsigned)(K * 2) + colA2[_i]; } } while (0)
    const size_t kstep = (size_t)(BK * 2);
    const size_t hstep = (size_t)HALF * K * 2;
    const size_t hstepA = GATHER ? 0 : hstep;
    const size_t tstep = 2 * hstep;
    const unsigned ldsw = (unsigned)wid * 1024u;
    const int aoff = lds_byte(wr * 64 + fr, fq * 8), boff = lds_byte(wc * 32 + fr, fq * 8);
#define PG8_SA(b, h) (((b) * 2 + (h)) * HTB)
#define PG8_SB(b, h) ((4 + (b) * 2 + (h)) * HTB)
#define PG8_STAGE(bufoff, gbase, voff) do { _Pragma("unroll") for (int _i = 0; _i < 2; ++_i) \
        __builtin_amdgcn_global_load_lds((const unsigned*)((const char*)(gbase) + (voff)[_i]), (PG8_LAS unsigned*)(lds + (bufoff) + ldsw + _i * 8192), 16, 0, 0); } while (0)
#define PG8_LDA(dst, b, h) do { _Pragma("unroll") for (int m = 0; m < 4; ++m) _Pragma("unroll") for (int k = 0; k < 2; ++k) dst[m][k] = *(const PG8_LAS bf16x8*)(lds + PG8_SA(b, h) + aoff + m * 2048 + k * 1024); } while (0)
#define PG8_LDB(dst, b, h) do { _Pragma("unroll") for (int n = 0; n < 2; ++n) _Pragma("unroll") for (int k = 0; k < 2; ++k) dst[n][k] = *(const PG8_LAS bf16x8*)(lds + PG8_SB(b, h) + boff + n * 2048 + k * 1024); } while (0)
#define PG8_MMA(ai, bj, At, Bt) do { __builtin_amdgcn_s_setprio(1); _Pragma("unroll") for (int m = 0; m < 4; ++m) _Pragma("unroll") for (int n = 0; n < 2; ++n) _Pragma("unroll") for (int k = 0; k < 2; ++k) \
        acc[ai][bj][m][n] = __builtin_amdgcn_mfma_f32_16x16x32_bf16(Bt[n][k], At[m][k], acc[ai][bj][m][n], 0, 0, 0); __builtin_amdgcn_s_setprio(0); } while (0)
#define PG8_WAIT_V(n) asm volatile("s_waitcnt vmcnt(" #n ")" ::: "memory")
#define PG8_WAIT_L(n) asm volatile("s_waitcnt lgkmcnt(" #n ")" ::: "memory")
#define PG8_BAR __builtin_amdgcn_s_barrier()
#define PG8_SCHED __builtin_amdgcn_sched_barrier(0)
    Unit cur, nxt; int ui = 0;
    if (!S.next(0, cur)) return;
    f32x4 acc[2][2][4][2];
#pragma unroll
    for (int a = 0; a < 2; ++a)
#pragma unroll
        for (int b = 0; b < 2; ++b)
#pragma unroll
            for (int m = 0; m < 4; ++m)
#pragma unroll
                for (int n = 0; n < 2; ++n) acc[a][b][m][n] = (f32x4){0.f, 0.f, 0.f, 0.f};
    bf16x8 At[4][2], B0[2][2], B1[2][2];
    const char* cA = (const char*)g.A + (GATHER ? (size_t)0 : (size_t)cur.pm * tstep); const char* cB = (const char*)g.Bt + (size_t)cur.pn * tstep;
    S.a_ready(cur);
    PreOf<Epi, Epi::HAS_PRE> pre;
    if constexpr (Epi::HAS_PRE) E.pre(pre.v, cur, wr, wc, fr, fq);
    if constexpr (GATHER) { PG8_IDX_ISSUE(cur); asm volatile("s_waitcnt vmcnt(0)" ::: "memory"); PG8_IDX_TAKE(gA); }
    if constexpr (SP2) {
        PG8_STAGE(PG8_SB(0, 0), cB, voffB); PG8_STAGE(PG8_SB(0, 1), cB + hstep, voffB); PG8_STAGE(PG8_SA(0, 0), cA, PG8_VA(0)); PG8_STAGE(PG8_SA(0, 1), cA + hstepA, PG8_VA(1));
        if (wr == 1) PG8_BAR;
        PG8_WAIT_V(2); PG8_BAR;
        PG8_STAGE(PG8_SB(1, 0), cB + kstep, voffB); PG8_STAGE(PG8_SA(1, 0), cA + kstep, PG8_VA(0)); PG8_STAGE(PG8_SB(1, 1), cB + hstep + kstep, voffB);
        PG8_WAIT_V(6); PG8_BAR;
    } else {
        PG8_STAGE(PG8_SB(0, 0), cB, voffB); PG8_STAGE(PG8_SA(0, 0), cA, PG8_VA(0)); PG8_STAGE(PG8_SB(0, 1), cB + hstep, voffB); PG8_STAGE(PG8_SA(0, 1), cA + hstepA, PG8_VA(1));
        if (wr == 1) PG8_BAR;
        PG8_WAIT_V(4); PG8_BAR;
        PG8_STAGE(PG8_SB(1, 0), cB + kstep, voffB); PG8_STAGE(PG8_SA(1, 0), cA + kstep, PG8_VA(0)); PG8_STAGE(PG8_SB(1, 1), cB + hstep + kstep, voffB);
        PG8_WAIT_V(6); PG8_BAR;
    }
    for (;;) {
        const bool has_next = S.next(ui + 1, nxt);
        const char* nA = (has_next && !GATHER) ? (const char*)g.A + (size_t)nxt.pm * tstep : cA; const char* nB = has_next ? (const char*)g.Bt + (size_t)nxt.pn * tstep : cB;
        if constexpr (GATHER) { if (has_next) PG8_IDX_ISSUE(nxt); }
        for (int t = 0; t < nt; t += 2) {
            const bool last = (t == nt - 2);
            const char* a1 = cA + (size_t)(t + 1) * kstep;
            const char* a2 = last ? nA : cA + (size_t)(t + 2) * kstep; const char* b2 = last ? nB : cB + (size_t)(t + 2) * kstep;
            const char* a3 = a2 + kstep; const char* b3 = b2 + kstep;
            if (last && has_next) S.a_ready(nxt);
            if constexpr (GATHER) { if (last) { if (has_next) PG8_IDX_TAKE(gN); else { _Pragma("unroll") for (int _h = 0; _h < 2; ++_h) _Pragma("unroll") for (int _i = 0; _i < 2; ++_i) gN[_h][_i] = gA[_h][_i]; } }
                _Pragma("unroll") for (int _h = 0; _h < 2; ++_h) _Pragma("unroll") for (int _i = 0; _i < 2; ++_i) gS[_h][_i] = last ? gN[_h][_i] : gA[_h][_i]; }
            if constexpr (SP2) {
            PG8_LDB(B0, 0, 0); PG8_LDB(B1, 0, 1); PG8_SCHED; PG8_LDA(At, 0, 0); PG8_STAGE(PG8_SA(1, 1), a1 + hstepA, PG8_VA(1));
            PG8_WAIT_V(8); PG8_WAIT_L(0); PG8_BAR; PG8_MMA(0, 0, At, B0); PG8_MMA(0, 1, At, B1); PG8_BAR; PG8_SCHED;
            PG8_LDA(At, 0, 1); PG8_STAGE(PG8_SB(0, 0), b2, voffB); PG8_STAGE(PG8_SB(0, 1), b2 + hstep, voffB); PG8_STAGE(PG8_SA(0, 0), a2, PG8_VS(0));
            PG8_WAIT_V(8); PG8_WAIT_L(0); PG8_BAR; if (HALF_FROM_PM == (1 << 30) || cur.pm < HALF_FROM_PM) { PG8_MMA(1, 0, At, B0); PG8_MMA(1, 1, At, B1); } PG8_BAR; PG8_SCHED;
            PG8_LDB(B0, 1, 0); PG8_LDB(B1, 1, 1); PG8_SCHED; PG8_LDA(At, 1, 0); PG8_STAGE(PG8_SA(0, 1), a2 + hstepA, PG8_VS(1));
            PG8_WAIT_V(8); PG8_WAIT_L(0); PG8_BAR; PG8_MMA(0, 0, At, B0); PG8_MMA(0, 1, At, B1); PG8_BAR; PG8_SCHED;
            PG8_LDA(At, 1, 1); PG8_STAGE(PG8_SB(1, 0), b3, voffB); PG8_STAGE(PG8_SB(1, 1), b3 + hstep, voffB); PG8_STAGE(PG8_SA(1, 0), a3, PG8_VS(0));
            PG8_WAIT_V(8); PG8_WAIT_L(0); PG8_BAR; if (HALF_FROM_PM == (1 << 30) || cur.pm < HALF_FROM_PM) { PG8_MMA(1, 0, At, B0); PG8_MMA(1, 1, At, B1); } PG8_BAR; PG8_SCHED;
            } else {
            PG8_LDB(B0, 0, 0); PG8_SCHED; PG8_LDA(At, 0, 0); PG8_STAGE(PG8_SA(1, 1), a1 + hstepA, PG8_VA(1));
            PG8_WAIT_L(8); PG8_BAR; PG8_WAIT_L(0); PG8_MMA(0, 0, At, B0); PG8_BAR; PG8_SCHED;
            PG8_LDB(B1, 0, 1); PG8_STAGE(PG8_SB(0, 0), b2, voffB);
            PG8_BAR; PG8_WAIT_L(0); PG8_MMA(0, 1, At, B1); PG8_BAR;
            PG8_LDA(At, 0, 1); PG8_STAGE(PG8_SA(0, 0), a2, PG8_VS(0));
            PG8_BAR; PG8_WAIT_L(0); PG8_MMA(1, 0, At, B0); PG8_BAR; PG8_SCHED;
            PG8_STAGE(PG8_SB(0, 1), b2 + hstep, voffB);
            PG8_WAIT_V(6); PG8_BAR; PG8_MMA(1, 1, At, B1); PG8_BAR;
            PG8_LDB(B0, 1, 0); PG8_SCHED; PG8_LDA(At, 1, 0); PG8_STAGE(PG8_SA(0, 1), a2 + hstepA, PG8_VS(1));
            PG8_WAIT_L(8); PG8_BAR; PG8_WAIT_L(0); PG8_MMA(0, 0, At, B0); PG8_BAR; PG8_SCHED;
            PG8_LDB(B1, 1, 1); PG8_STAGE(PG8_SB(1, 0), b3, voffB);
            PG8_BAR; PG8_WAIT_L(0); PG8_MMA(0, 1, At, B1); PG8_BAR;
            PG8_LDA(At, 1, 1); PG8_STAGE(PG8_SA(1, 0), a3, PG8_VS(0));
            PG8_BAR; PG8_WAIT_L(0); PG8_MMA(1, 0, At, B0); PG8_BAR; PG8_SCHED;
            PG8_STAGE(PG8_SB(1, 1), b3 + hstep, voffB);
            PG8_WAIT_V(6); PG8_BAR; PG8_MMA(1, 1, At, B1); PG8_BAR;
            }
        }
        if constexpr (ALIGN_EPI) { if (wr == 0) PG8_BAR; }
        if constexpr (!Epi::AFTER_DRAIN) { if constexpr (Epi::HAS_PRE) E(acc, cur, wr, wc, fr, fq, pre.v); else E(acc, cur, wr, wc, fr, fq); S.done(cur); }
        if (!has_next) break;
#pragma unroll
        for (int a = 0; a < 2; ++a)
#pragma unroll
            for (int b = 0; b < 2; ++b)
#pragma unroll
                for (int m = 0; m < 4; ++m)
#pragma unroll
                    for (int n = 0; n < 2; ++n) acc[a][b][m][n] = (f32x4){0.f, 0.f, 0.f, 0.f};
        cur = nxt; cA = nA; cB = nB; ++ui;
        if constexpr (Epi::HAS_PRE) E.pre(pre.v, cur, wr, wc, fr, fq);
        if constexpr (GATHER) { _Pragma("unroll") for (int _h = 0; _h < 2; ++_h) _Pragma("unroll") for (int _i = 0; _i < 2; ++_i) gA[_h][_i] = gN[_h][_i]; }
        if constexpr (ALIGN_EPI) { if (wr == 1) PG8_BAR; }
    }
    PG8_WAIT_V(0);
    if constexpr (!ALIGN_EPI) { if (wr == 0) PG8_BAR; }
    PG8_BAR;
    if constexpr (Epi::AFTER_DRAIN) { E.fused(acc, cur, wr, wc, fr, fq, lds, wid, lane); S.done(cur); }
#undef PG8_SA
#undef PG8_VA
#undef PG8_VS
#undef PG8_IDX_ISSUE
#undef PG8_IDX_TAKE
#undef PG8_SB
#undef PG8_STAGE
#undef PG8_LDA
#undef PG8_LDB
#undef PG8_MMA
#undef PG8_WAIT_V
#undef PG8_WAIT_L
#undef PG8_BAR
#undef PG8_SCHED
}
}
#define XB_TMO      128
#define XB_XCNT(j)  (256  + 64 * (j))
#define XB_XSUB(j)  (1280 + 64 * (j))
#define XB_XGEN(j)  (2304 + 64 * (j))
#define XB_TOP      3328
#define XB_TOPGEN   3392
#define XCD_BAR_WORDS 3456
#define XB_SPIN_CAP (1u << 18)

__device__ __forceinline__ unsigned xb_ld(unsigned* p)              { return __hip_atomic_load(p, __ATOMIC_RELAXED, __HIP_MEMORY_SCOPE_AGENT); }
__device__ __forceinline__ unsigned xb_add(unsigned* p, unsigned v) { return __hip_atomic_fetch_add(p, v, __ATOMIC_RELAXED, __HIP_MEMORY_SCOPE_AGENT); }
__device__ __forceinline__ unsigned xb_xcc_id() { return (unsigned)__builtin_amdgcn_s_getreg((3 << 11) | 20) & 0xFu; }
#define XB_SPIN(cond, bar) do { unsigned _sp = 0; while (cond) { __builtin_amdgcn_s_sleep(1); \
    if ((++_sp & 255u) == 0u) { if (xb_ld(&(bar)[XB_TMO])) break; if (_sp > XB_SPIN_CAP) { atomicAdd(&(bar)[XB_TMO], 1u); break; } } } } while (0)

struct XcdBarrier {
    unsigned* bar; unsigned x;
    volatile LAS unsigned* st;
};

__device__ __forceinline__ XcdBarrier xcd_barrier_post(unsigned* bar, volatile LAS unsigned* st) {
    XcdBarrier b; b.bar = bar; b.x = xb_xcc_id(); b.st = st;
    if (threadIdx.x == 0) (void)xb_add(&bar[XB_XCNT(b.x)], 1u);
    return b;
}
__device__ __forceinline__ void xcd_barrier_complete(unsigned* bar, unsigned x, unsigned& nloc, unsigned& nx) {
    const unsigned G = gridDim.x * gridDim.y * gridDim.z;
    unsigned sum, cnt, mine, sp = 0u;
    for (;;) {
        sum = 0u; cnt = 0u; mine = 0u;
#pragma unroll
        for (unsigned j = 0; j < 16; ++j) { const unsigned c = xb_ld(&bar[XB_XCNT(j)]); sum += c; cnt += (c > 0u) ? 1u : 0u; mine = (j == x) ? c : mine; }
        if (sum == G) break;
        __builtin_amdgcn_s_sleep(1);
        if ((++sp & 255u) == 0u) { if (xb_ld(&bar[XB_TMO])) break; if (sp > XB_SPIN_CAP) { atomicAdd(&bar[XB_TMO], 1u); break; } }
    }
    nloc = mine > 0u ? mine : 1u; nx = cnt > 0u ? cnt : 1u;
}

__device__ __forceinline__ void xcd_barrier(const XcdBarrier& b) {
    asm volatile("s_waitcnt vmcnt(0)" ::: "memory");
    __syncthreads();
    if (threadIdx.x == 0) {
        unsigned* bar = b.bar;
        __builtin_amdgcn_s_waitcnt(0);
        unsigned nloc = b.st[0], nx = b.st[1];
        if (nloc == 0u) { xcd_barrier_complete(bar, b.x, nloc, nx); b.st[0] = nloc; b.st[1] = nx; }
        const unsigned old = xb_add(&bar[XB_XSUB(b.x)], 1u);
        const unsigned gen = old / nloc;
        if (old + 1u == (gen + 1u) * nloc) {
            __builtin_amdgcn_fence(__ATOMIC_RELEASE, "agent");
            asm volatile("s_waitcnt vmcnt(0)" ::: "memory");
            const unsigned og = xb_add(&bar[XB_TOP], 1u);
            const unsigned tg = og / nx;
            if (og + 1u == (tg + 1u) * nx) xb_add(&bar[XB_TOPGEN], 1u);
            else XB_SPIN(xb_ld(&bar[XB_TOPGEN]) == tg, bar);
            __builtin_amdgcn_fence(__ATOMIC_ACQUIRE, "agent");
            xb_add(&bar[XB_XGEN(b.x)], 1u);
            asm volatile("s_waitcnt vmcnt(0)" ::: "memory");
        } else {
            XB_SPIN(xb_ld(&bar[XB_XGEN(b.x)]) == gen, bar);
            __builtin_amdgcn_fence(__ATOMIC_ACQUIRE, "agent");
            asm volatile("s_waitcnt vmcnt(0)" ::: "memory");
        }
    }
    __syncthreads();
}

typedef unsigned short bf16;
typedef unsigned v4u __attribute__((ext_vector_type(4)));
typedef unsigned v2u __attribute__((ext_vector_type(2)));
typedef float f32x4 __attribute__((ext_vector_type(4)));
typedef float f32x16 __attribute__((ext_vector_type(16)));
typedef short bf16x8 __attribute__((ext_vector_type(8)));
typedef unsigned short u16x8 __attribute__((ext_vector_type(8)));
#define LDS_WAIT() asm volatile("s_waitcnt lgkmcnt(0)" ::: "memory")
#define VM_WAIT() asm volatile("s_waitcnt vmcnt(0)" ::: "memory")

constexpr int NWAVES = 8, NTHR = 512;
constexpr int D = 1024, NB = 4, SEQ = 8192, CTXL = 256, NLAT = NB * SEQ, NCTX = NB * CTXL, NROW = NLAT + NCTX;
constexpr int INC = 2304;
constexpr int PXC = 2048;
constexpr int PX_Z = 1536;
constexpr int NE = 16, CAP_L = 1024, CAP_C = 32;
constexpr int SLAB_L = NB * NE * CAP_L;
constexpr int SLAB_ROWS = SLAB_L + NE * 256;
constexpr int NCHUNK = NROW / 64;
constexpr float EPS = 1e-6f;

enum { I_X = 0, I_C, I_CTX, I_CCTX, I_WADA, I_BADA, I_GN1, I_WIN, I_LCW, I_LCB, I_LWR, I_LBR, I_LWI, I_LBI, I_LAM, I_SCW, I_GOUT, I_WOUT, I_GN2, I_WRT, I_WG, I_WU, I_WD, I_GF, N_IN };

constexpr size_t MiB = 1u << 20;
constexpr size_t WS_CTL = 0, CTL_ZERO_BYTES = 64 * 1024;
constexpr size_t WS_MODP_OLD = 1 * MiB;
constexpr size_t WS_RIMG = WS_MODP_OLD;
constexpr size_t WS_MODS = WS_MODP_OLD + 2 * MiB;
constexpr size_t WS_SP8 = WS_MODS + 256 * 1024;
constexpr size_t WS_TW = WS_SP8 + 8 * 1024;
constexpr size_t WS_C128 = WS_TW + 64 * 1024;
constexpr size_t WS_S128 = WS_C128 + 32 * 1024;
constexpr size_t WS_T2M = WS_S128 + 32 * 1024;
constexpr size_t WS_TCM = WS_T2M + 16 * 1024;
constexpr size_t WS_WGL = WS_TCM + 256 * 1024;
constexpr size_t WS_WIN = 5 * MiB;
constexpr size_t WS_WOUT = WS_WIN + 9 * MiB;
constexpr size_t WS_WGU = WS_WOUT + 4 * MiB;
constexpr size_t WS_WD = WS_WGU + 64 * MiB;
constexpr size_t WS_WEXP_L = 96 * MiB;
constexpr size_t WS_XB = WS_WGU + 2 * WS_WEXP_L;
constexpr size_t WS_HX = WS_XB;
constexpr size_t WS_REGA = WS_HX + 66 * MiB;
constexpr size_t WS_REGB = WS_REGA + 149 * MiB;
constexpr size_t WS_T1 = WS_REGB, WS_SP = WS_REGB + 32 * MiB;
constexpr size_t WS_MODP = WS_REGB;
constexpr size_t WS_CTXX = WS_REGB + 136 * MiB;
constexpr size_t WS_AFFL = WS_CTXX + 4 * MiB;
constexpr size_t WS_AFFC = WS_AFFL + 2 * MiB;
constexpr size_t WS_ENT = WS_AFFC + 1 * MiB;
constexpr size_t WS_IDX = WS_ENT + 3 * MiB;
constexpr size_t WS_GVAL = WS_IDX + 1 * MiB;
constexpr size_t WS_SUMM = WS_GVAL + 1 * MiB;
constexpr size_t WS_CARRY = WS_SUMM + 5 * MiB;
constexpr size_t WS_END = WS_CARRY + 3 * MiB;
static_assert(WS_WGL + 2 * 8 * 256 * 64 * 2 <= WS_WIN, "ws map");
static_assert((size_t)NROW * INC * 2 <= 149 * MiB && (size_t)SLAB_ROWS * 1024 * 2 <= 136 * MiB && 32 * MiB + (size_t)NCHUNK * 8 * 2 * 3 * 2 * 1024 * 2 <= 136 * MiB, "ws map");

constexpr int CW_BAR = 1024;

constexpr int LDS_BYTES = 147456;
constexpr int RING_BYTES = 146432;
constexpr int MISC_OFF = RING_BYTES;

__device__ __forceinline__ unsigned f2bf(float f) { unsigned u = __builtin_bit_cast(unsigned, f); return (u + 0x7fffu + ((u >> 16) & 1u)) >> 16; }
__device__ __forceinline__ unsigned pk2(float lo, float hi) { unsigned r; asm volatile("v_cvt_pk_bf16_f32 %0, %1, %2" : "=v"(r) : "v"(lo), "v"(hi)); return r; }
__device__ __forceinline__ float bf2f(unsigned h) { return __builtin_bit_cast(float, h << 16); }
__device__ __forceinline__ float sigmoidf_(float x) { return __builtin_amdgcn_rcpf(1.0f + __builtin_amdgcn_exp2f(-1.4426950408889634f * x)); }
__device__ __forceinline__ float rsq_(float x) { return __builtin_amdgcn_rsqf(x); }
__device__ __forceinline__ float wave_sum(float v) {
#pragma unroll
    for (int o = 1; o < 64; o <<= 1) v += __shfl_xor(v, o);
    return v;
}

struct Args { const float* in[N_IN]; float* out; unsigned char* ws; int ph_lo, ph_hi, bar_region, pad_; };
template <int CTRL> __device__ __forceinline__ float dpp_(float v) { return __builtin_bit_cast(float, __builtin_amdgcn_update_dpp(0, __builtin_bit_cast(int, v), CTRL, 0xf, 0xf, false)); }
__device__ __forceinline__ float row_sum16(float v) { v += dpp_<0xB1>(v); v += dpp_<0x4E>(v); v += dpp_<0x141>(v); v += dpp_<0x140>(v); return v; }
__device__ __forceinline__ float row_max16(float v) { v = fmaxf(v, dpp_<0xB1>(v)); v = fmaxf(v, dpp_<0x4E>(v)); v = fmaxf(v, dpp_<0x141>(v)); v = fmaxf(v, dpp_<0x140>(v)); return v; }
__device__ __forceinline__ float wave_sum_fast(float v) { v = row_sum16(v);
    const int i = __builtin_bit_cast(int, v);
    return (__builtin_bit_cast(float, __builtin_amdgcn_readlane(i, 0)) + __builtin_bit_cast(float, __builtin_amdgcn_readlane(i, 16))) + (__builtin_bit_cast(float, __builtin_amdgcn_readlane(i, 32)) + __builtin_bit_cast(float, __builtin_amdgcn_readlane(i, 48))); }
struct Frame {
    LAS unsigned char* lds;
    int tid, lane, wave, wg, G;
};
constexpr int PT_OFF = 146432 + 256;
__device__ __forceinline__ unsigned long long ptab_(LAS unsigned char* lds, int i) { const unsigned long long v = ((const LAS unsigned long long*)(lds + PT_OFF))[i];
    const unsigned lo = __builtin_amdgcn_readfirstlane((unsigned)v), hi = __builtin_amdgcn_readfirstlane((unsigned)(v >> 32)); return ((unsigned long long)hi << 32) | lo; }
#define GAS __attribute__((address_space(1)))
template <class T> __device__ __forceinline__ T* as_global_(unsigned long long v) { return (T*)(GAS T*)v; }
#define INP(i) as_global_<const float>(ptab_(F.lds, (i)))
#define OUTP() as_global_<float>(ptab_(F.lds, N_IN))
#define HXP() as_global_<bf16>(ptab_(F.lds, N_IN))
#define XBP() WSP(bf16, WS_XB)
#define ZBP() (HXP() + (size_t)NROW * D)
__device__ __forceinline__ void relaunder(Frame& F) { int t_ = threadIdx.x; asm volatile("" : "+v"(t_)); F.tid = t_; F.lane = t_ & 63; F.wave = __builtin_amdgcn_readfirstlane(t_ >> 6); }
#define WSP(T, off) as_global_<T>(ptab_(F.lds, N_IN + 1) + (off))

__device__ __forceinline__ void transpose_item(const float* __restrict__ W, int ldw, int k0, int n0, bf16* __restrict__ WT, int ldk, int drow0, LAS float* scr, int lane) {
#pragma unroll 8
    for (int i = 0; i < 32; ++i) { const int kk = 2 * i + (lane >> 5); scr[kk * 33 + (lane & 31)] = W[(size_t)(k0 + kk) * ldw + n0 + (lane & 31)]; }
    LDS_WAIT(); asm volatile("" ::: "memory");
    const int c = lane & 7;
#pragma unroll
    for (int j = 0; j < 4; ++j) { const int n = (lane >> 3) + 8 * j; const LAS float* s = scr + (8 * c) * 33 + n;
        v4u o; o.x = pk2(s[0 * 33], s[1 * 33]); o.y = pk2(s[2 * 33], s[3 * 33]); o.z = pk2(s[4 * 33], s[5 * 33]); o.w = pk2(s[6 * 33], s[7 * 33]);
        *(v4u*)(WT + (size_t)(drow0 + n) * ldk + k0 + 8 * c) = o; }
    LDS_WAIT(); asm volatile("" ::: "memory");
}
__device__ __forceinline__ void transpose_item64x2(const float* __restrict__ Wa, const float* __restrict__ Wb, int ldw, bf16* __restrict__ Ta, bf16* __restrict__ Tb, int ldk, LAS float* scr, int lane) {
    const int q = lane & 15, kr = lane >> 4, c = lane & 7;
    f32x4 va[16], vb[16];
#pragma unroll
    for (int i = 0; i < 16; ++i) va[i] = __builtin_nontemporal_load((const f32x4*)(Wa + (size_t)(4 * i + kr) * ldw + 4 * q));
#pragma unroll
    for (int i = 0; i < 16; ++i) vb[i] = __builtin_nontemporal_load((const f32x4*)(Wb + (size_t)(4 * i + kr) * ldw + 4 * q));
#pragma unroll
    for (int t = 0; t < 2; ++t) {
#pragma unroll
        for (int i = 0; i < 16; ++i) { LAS float* d = scr + (4 * i + kr) * 65 + 4 * q; const f32x4 v = t ? vb[i] : va[i]; d[0] = v.x; d[1] = v.y; d[2] = v.z; d[3] = v.w; }
        LDS_WAIT(); asm volatile("" ::: "memory");
        bf16* WT = t ? Tb : Ta;
#pragma unroll
        for (int j = 0; j < 8; ++j) { const int n = (lane >> 3) + 8 * j; const LAS float* sp = scr + (8 * c) * 65 + n;
            v4u o; o.x = pk2(sp[0 * 65], sp[1 * 65]); o.y = pk2(sp[2 * 65], sp[3 * 65]); o.z = pk2(sp[4 * 65], sp[5 * 65]); o.w = pk2(sp[6 * 65], sp[7 * 65]);
            *(v4u*)(WT + (size_t)n * ldk + 8 * c) = o; }
        LDS_WAIT(); asm volatile("" ::: "memory");
    }
}
__device__ __forceinline__ void transpose_item64(const float* __restrict__ W, int ldw, int k0, int n0, bf16* __restrict__ WT, int ldk, int drow0, LAS float* scr, int lane) {
    const int q = lane & 15, kr = lane >> 4;
    f32x4 v[16];
#pragma unroll
    for (int i = 0; i < 16; ++i) v[i] = __builtin_nontemporal_load((const f32x4*)(W + (size_t)(k0 + 4 * i + kr) * ldw + n0 + 4 * q));
#pragma unroll
    for (int i = 0; i < 16; ++i) { LAS float* d = scr + (4 * i + kr) * 65 + 4 * q; d[0] = v[i].x; d[1] = v[i].y; d[2] = v[i].z; d[3] = v[i].w; }
    LDS_WAIT(); asm volatile("" ::: "memory");
    const int c = lane & 7;
#pragma unroll
    for (int j = 0; j < 8; ++j) { const int n = (lane >> 3) + 8 * j; const LAS float* s = scr + (8 * c) * 65 + n;
        v4u o; o.x = pk2(s[0 * 65], s[1 * 65]); o.y = pk2(s[2 * 65], s[3 * 65]); o.z = pk2(s[4 * 65], s[5 * 65]); o.w = pk2(s[6 * 65], s[7 * 65]);
        *(v4u*)(WT + (size_t)(drow0 + n) * ldk + k0 + 8 * c) = o; }
    LDS_WAIT(); asm volatile("" ::: "memory");
}
constexpr int N_EXP_ITEMS = 3 * 16 * 256;
constexpr int CW_FILL = 64;
__device__ __forceinline__ void convert_ptrs(Frame& F, int l, int it, const float*& src, bf16*& dst) {
    bf16* WGU = WSP(bf16, WS_WGU + (size_t)l * WS_WEXP_L); bf16* WD = WSP(bf16, WS_WD + (size_t)l * WS_WEXP_L);
    const int mat = it / (16 * 256), r = it % (16 * 256), e = r >> 8, t = r & 255, kb = t >> 4, nb = t & 15, k0 = kb * 64, n0 = nb * 64;
    const size_t eoff = ((size_t)l * 16 + e) * 1024 * 1024;
    const float* W = mat == 0 ? INP(I_WG) : mat == 1 ? INP(I_WU) : INP(I_WD);
    src = W + eoff + (size_t)k0 * 1024 + n0;
    if (mat == 0)      dst = WGU + (size_t)e * 2048 * 1024 + (size_t)((n0 >> 7) * 256 + (n0 & 127)) * 1024 + k0;
    else if (mat == 1) dst = WGU + (size_t)e * 2048 * 1024 + (size_t)((n0 >> 7) * 256 + 128 + (n0 & 127)) * 1024 + k0;
    else               dst = WD + (size_t)e * 1024 * 1024 + (size_t)n0 * 1024 + k0;
}
__device__ __forceinline__ void convert_item2(Frame& F, int l, int it) {
    if (it >= N_EXP_ITEMS) return;
    LAS float* scr = (LAS float*)(F.lds + F.wave * 16640);
    const float* sa; const float* sb; bf16* da; bf16* db;
    convert_ptrs(F, l, it, sa, da); convert_ptrs(F, l, it + 1, sb, db);
    transpose_item64x2(sa, sb, 1024, da, db, 1024, scr, F.lane);
}
__device__ __forceinline__ void filler(Frame& F, int budget, int only_l, int limit = N_EXP_ITEMS) {
    volatile LAS unsigned* MISC = (volatile LAS unsigned*)(F.lds + MISC_OFF);
    unsigned* ctr = WSP(unsigned, WS_CTL) + CW_FILL;
    int l = only_l >= 0 ? only_l : 0;
    for (int g = 0; only_l >= 0 || g < budget; ++g) {
        __syncthreads();
        if (F.tid == 0) { unsigned base = (unsigned)N_EXP_ITEMS;
            if (only_l < 0 || __hip_atomic_load(ctr + 64 * l, __ATOMIC_RELAXED, __HIP_MEMORY_SCOPE_AGENT) < (unsigned)limit) base = __hip_atomic_fetch_add(ctr + 64 * l, 16u, __ATOMIC_RELAXED, __HIP_MEMORY_SCOPE_AGENT);
            if (base >= (unsigned)N_EXP_ITEMS && only_l < 0 && l == 0) { base = __hip_atomic_fetch_add(ctr + 64, 16u, __ATOMIC_RELAXED, __HIP_MEMORY_SCOPE_AGENT) | 0x80000000u; }
            MISC[20] = base; }
        LDS_WAIT(); __syncthreads();
        unsigned base = MISC[20]; int ll = l;
        if (base & 0x80000000u) { base &= 0x7fffffffu; ll = 1; l = 1; }
        if (base >= (unsigned)N_EXP_ITEMS) break;
        convert_item2(F, ll, (int)base + 2 * F.wave);
    }
    __syncthreads();
}
__device__ __forceinline__ void convert_item1(Frame& F, int l, int it) {
    if (it >= N_EXP_ITEMS) return;
    LAS float* scr = (LAS float*)(F.lds + F.wave * 16640);
    const float* sa; bf16* da; convert_ptrs(F, l, it, sa, da);
    transpose_item64(sa, 1024, 0, 0, da, 1024, 0, scr, F.lane);
}
__device__ __forceinline__ void xcd_barrier_fill(const XcdBarrier& b, Frame& F, bool fill) {
    volatile LAS unsigned* MISC = (volatile LAS unsigned*)(F.lds + MISC_OFF);
    asm volatile("s_waitcnt vmcnt(0)" ::: "memory");
    __syncthreads();
    if (threadIdx.x == 0) {
        unsigned* bar = b.bar;
        __builtin_amdgcn_s_waitcnt(0);
        unsigned nloc = b.st[0], nx = b.st[1];
        if (nloc == 0u) { xcd_barrier_complete(bar, b.x, nloc, nx); b.st[0] = nloc; b.st[1] = nx; }
        const unsigned old = xb_add(&bar[XB_XSUB(b.x)], 1u);
        const unsigned gen = old / nloc;
        unsigned mode = 0u;
        if (old + 1u == (gen + 1u) * nloc) {
            __builtin_amdgcn_fence(__ATOMIC_RELEASE, "agent");
            asm volatile("s_waitcnt vmcnt(0)" ::: "memory");
            const unsigned og = xb_add(&bar[XB_TOP], 1u);
            const unsigned tg = og / nx;
            if (og + 1u == (tg + 1u) * nx) xb_add(&bar[XB_TOPGEN], 1u);
            else XB_SPIN(xb_ld(&bar[XB_TOPGEN]) == tg, bar);
            __builtin_amdgcn_fence(__ATOMIC_ACQUIRE, "agent");
            xb_add(&bar[XB_XGEN(b.x)], 1u);
            asm volatile("s_waitcnt vmcnt(0)" ::: "memory");
        } else {
            mode = (fill && (old - gen * nloc) < (nloc >> 2)) ? 2u : 1u;
            if (mode == 2u) { const unsigned base = __hip_atomic_fetch_add(WSP(unsigned, WS_CTL) + CW_FILL + 64, 8u, __ATOMIC_RELAXED, __HIP_MEMORY_SCOPE_AGENT); MISC[20] = base; if (base >= (unsigned)N_EXP_ITEMS) mode = 1u; }
        }
        MISC[21] = mode; MISC[22] = gen;
    }
    LDS_WAIT(); __syncthreads();
    const unsigned mode = MISC[21];
    if (mode == 2u) { convert_item1(F, 1, (int)MISC[20] + F.wave); asm volatile("s_waitcnt vmcnt(0)" ::: "memory"); __syncthreads(); }
    if (mode != 0u && threadIdx.x == 0) {
        unsigned* bar = b.bar; const unsigned gen = MISC[22];
        XB_SPIN(xb_ld(&bar[XB_XGEN(b.x)]) == gen, bar);
        __builtin_amdgcn_fence(__ATOMIC_ACQUIRE, "agent");
        asm volatile("s_waitcnt vmcnt(0)" ::: "memory");
    }
    __syncthreads();
}
__device__ __forceinline__ void p0_prep(Frame& F) {
    const int gw = F.wg * NWAVES + F.wave, NGW = F.G * NWAVES;
    LAS float* sil = (LAS float*)(F.lds + 8 * 8448);
    for (int i = F.tid; i < 5 * 1024; i += NTHR) { const int s = i >> 10, k = i & 1023; const float cv = s < 4 ? INP(I_C)[s * 1024 + k] : INP(I_CCTX)[k]; sil[i] = cv * sigmoidf_(cv); }
    LAS float* cst = (LAS float*)(F.lds + 8 * 8448 + 5 * 1024 * 4);
    if (F.tid < 64) { cst[F.tid] = cospif((float)F.tid / 32.0f); cst[64 + F.tid] = sinpif((float)F.tid / 32.0f); }
    LDS_WAIT(); __syncthreads();
    unsigned pf_ = 0;
    { const size_t gt0 = (size_t)F.wg * NTHR + F.tid;
      if (gt0 < 32768) { const char* p = (const char*)INP(I_X) + (gt0 << 12); asm volatile("global_load_dword %0, %1, off" : "=v"(pf_) : "v"(p) : "memory"); }
      else if (gt0 < 32768 + 1024) { const char* p = (const char*)INP(I_CTX) + ((gt0 - 32768) << 12); asm volatile("global_load_dword %0, %1, off" : "=v"(pf_) : "v"(p) : "memory"); } }
    constexpr int N_ADA = 16 * 24, N_FOLD = 256, N_IN_ITEMS = 16 * 56, N_OUT_ITEMS = 16 * 32, N_LRU = 32;
    constexpr int PER_L = N_ADA + N_FOLD + N_IN_ITEMS + N_OUT_ITEMS + N_LRU;
    LAS float* scr = (LAS float*)(F.lds + F.wave * 8448);
    for (int it = gw; it < 2 * PER_L; it += NGW) {
        const int l = it & 1; int r = it >> 1;
        if (r < N_ADA) {
            const int kq = r / 24, cb = r % 24, j0 = cb * 256 + 4 * F.lane;
            const float* W = INP(I_WADA) + (size_t)l * 1024 * 6144 + j0;
            f32x4 acc[5];
#pragma unroll
            for (int s = 0; s < 5; ++s) acc[s] = (f32x4){0.f, 0.f, 0.f, 0.f};
            for (int kb = 0; kb < 4; ++kb) { f32x4 w[16];
#pragma unroll
                for (int i = 0; i < 16; ++i) w[i] = __builtin_nontemporal_load((const f32x4*)(W + (size_t)(kq * 64 + kb * 16 + i) * 6144));
#pragma unroll
                for (int i = 0; i < 16; ++i)
#pragma unroll
                    for (int s = 0; s < 5; ++s) acc[s] += w[i] * sil[s * 1024 + kq * 64 + kb * 16 + i]; }
            float* MP = WSP(float, WS_MODP);
#pragma unroll
            for (int s = 0; s < 5; ++s) *(f32x4*)(MP + ((size_t)(kq * 2 + l) * 5 + s) * 6144 + j0) = acc[s];
            continue; }
        r -= N_ADA;
        if (r < N_FOLD) {
            const int kb = r >> 4, g = (r >> 2) & 3, mq = r & 3, k = kb * 64 + F.lane;
            const float* Wr = INP(I_WIN) + (size_t)l * 1024 * 2048 + (size_t)k * 2048 + 1792 + 64 * g;
            float wrow[64];
#pragma unroll
            for (int c4 = 0; c4 < 16; ++c4) { const f32x4 t = *(const f32x4*)(Wr + 4 * c4); wrow[4 * c4] = t.x; wrow[4 * c4 + 1] = t.y; wrow[4 * c4 + 2] = t.z; wrow[4 * c4 + 3] = t.w; }
            bf16* WT = WSP(bf16, WS_WIN) + (size_t)l * INC * 1024;
            for (int m = 16 * mq; m < 16 * mq + 16; ++m) { float re = 0.f, im = 0.f;
#pragma unroll
                for (int c = 0; c < 64; ++c) { const int a = (m * c) & 63; re += wrow[c] * cst[a]; im -= wrow[c] * cst[64 + a]; }
                WT[(size_t)(1792 + 64 * g + m) * 1024 + k] = (bf16)f2bf(re);
                WT[(size_t)(2048 + 64 * g + m) * 1024 + k] = (bf16)f2bf(im); }
            continue; }
        r -= N_FOLD;
        if (r < N_IN_ITEMS) {
            const int kb = r / 56, nb = r % 56;
            const int n0 = nb * 32, j = n0 < 1536 ? n0 - 1280 : n0 - 1536;
            const int drow = n0 < 1280 ? n0 : 1280 + (j >> 7) * 256 + (n0 < 1536 ? 0 : 128) + (j & 127);
            transpose_item(INP(I_WIN) + (size_t)l * 1024 * 2048, 2048, kb * 64, n0, WSP(bf16, WS_WIN) + (size_t)l * INC * 1024, 1024, drow, scr, F.lane); continue; }
        r -= N_IN_ITEMS;
        if (r < N_OUT_ITEMS) { const int kb = r >> 5, nb = r & 31;
            transpose_item(INP(I_WOUT) + (size_t)l * 1024 * 1024, 1024, kb * 64, nb * 32, WSP(bf16, WS_WOUT) + (size_t)l * 1024 * 1024, 1024, nb * 32, scr, F.lane); continue; }
        r -= N_OUT_ITEMS;
        {
            const int dir = r >> 4, gate = (r >> 3) & 1, h = r & 7;
            const float* W = INP(gate ? I_LWI : I_LWR) + ((size_t)(l * 2 + dir) * 8 + h) * 4096;
            bf16* WT = WSP(bf16, WS_WGL) + ((size_t)l * 8 + h) * 256 * 64 + (size_t)(dir * 2 + gate) * 64 * 64;
            for (int i = 0; i < 64; ++i) WT[F.lane * 64 + i] = (bf16)f2bf(W[i * 64 + F.lane]);
        }
    }
    VM_WAIT(); asm volatile("" :: "v"(pf_));
    const int gt = F.wg * NTHR + F.tid, NGT = F.G * NTHR;
    float* TW = WSP(float, WS_TW); bf16* C128 = WSP(bf16, WS_C128); bf16* S128 = WSP(bf16, WS_S128); bf16* T2M = WSP(bf16, WS_T2M); bf16* TCM = WSP(bf16, WS_TCM); float* SP8 = WSP(float, WS_SP8);
    for (int i = gt; i < 8192; i += NGT) { TW[2 * i] = cospif((float)i / 4096.0f); TW[2 * i + 1] = sinpif((float)i / 4096.0f); }
    for (int i = gt; i < 128 * 128; i += NGT) { const int k = i >> 7, n = i & 127, a = (k * n) & 127; C128[i] = (bf16)f2bf(cospif((float)a / 64.0f)); S128[i] = (bf16)f2bf(sinpif((float)a / 64.0f)); }
    for (int i = gt; i < 64 * 128; i += NGT) { const int k = i >> 7, nq = (i & 127) >> 1, ri = i & 1, a = (k * nq) & 63; T2M[i] = (bf16)f2bf(ri ? sinpif((float)a / 32.0f) : cospif((float)a / 32.0f)); }
    for (int i = gt; i < 256 * 512; i += NGT) { const int k = i >> 9, n = (i & 511) >> 1, ri = i & 1, a = (k * n) & 255; TCM[i] = (bf16)f2bf(ri ? sinpif((float)a / 128.0f) : cospif((float)a / 128.0f)); }
    for (int i = gt; i < 2048; i += NGT) { const float lam = INP(I_LAM)[i]; SP8[i] = 8.0f * log1pf(expf(-lam)); }
    for (int i = gt; i < 2 * 2048; i += NGT) { const int l = i >> 11, sg = (i >> 6) & 31, ln = i & 63; const float* w = INP(I_WRT) + (size_t)l * 16384 + (32 * sg + 8 * (ln >> 4)) * 16 + (ln & 15);
        float v[8];
#pragma unroll
        for (int j = 0; j < 8; ++j) v[j] = w[j * 16];
        unsigned h[4], lo[4];
#pragma unroll
        for (int p = 0; p < 4; ++p) { h[p] = pk2(v[2 * p], v[2 * p + 1]); lo[p] = pk2(v[2 * p] - bf2f(h[p] & 0xffffu), v[2 * p + 1] - __builtin_bit_cast(float, h[p] & 0xffff0000u)); }
        v4u* RI = WSP(v4u, WS_RIMG) + (size_t)l * 4096;
        RI[(sg * 2 + 0) * 64 + ln] = (v4u){h[0], h[1], h[2], h[3]}; RI[(sg * 2 + 1) * 64 + ln] = (v4u){lo[0], lo[1], lo[2], lo[3]}; }
}
__device__ __forceinline__ void p0b_mods(Frame& F) {
    const int gt = F.wg * NTHR + F.tid, NGT = F.G * NTHR;
    const float* MP = WSP(float, WS_MODP); float* MS = WSP(float, WS_MODS);
    for (int i = gt; i < 2 * 5 * 6144; i += NGT) { const int l = i / (5 * 6144), r = i % (5 * 6144), s = r / 6144, j = r % 6144;
        float a = INP(I_BADA)[l * 6144 + j];
#pragma unroll
        for (int kq = 0; kq < 16; ++kq) a += MP[((size_t)(kq * 2 + l) * 5 + s) * 6144 + j];
        MS[i] = a; }
}

__device__ __forceinline__ int row_set(int row) { return row < NLAT ? (row >> 13) : 4; }
__device__ __forceinline__ void norm_mod_store(const f32x4 (&v)[4], const float* g, const float* shift, const float* scale, bf16* orow, int lane) {
    float ss = 0.f;
#pragma unroll
    for (int j = 0; j < 4; ++j) ss += (v[j].x * v[j].x + v[j].y * v[j].y) + (v[j].z * v[j].z + v[j].w * v[j].w);
    const float rstd = rsq_(wave_sum_fast(ss) * (1.0f / D) + EPS);
    unsigned long long* o8 = (unsigned long long*)orow + lane;
#pragma unroll
    for (int j = 0; j < 4; ++j) { const int c = 4 * lane + 256 * j;
        const f32x4 gg = *(const f32x4*)(g + c), sh = *(const f32x4*)(shift + c), sc = *(const f32x4*)(scale + c);
        const f32x4 o = (v[j] * rstd * gg) * (sc + 1.0f) + sh;
        o8[64 * j] = (unsigned long long)pk2(o.x, o.y) | ((unsigned long long)pk2(o.z, o.w) << 32); }
}
#define ROWCOL(lane, j) (8 * (lane) + 512 * ((j) >> 1) + 4 * ((j) & 1))
__device__ __forceinline__ void norm_mod_store8(const f32x4 (&v)[4], const float* g, const float* shift, const float* scale, bf16* orow, int lane) {
    float ss = 0.f;
#pragma unroll
    for (int j = 0; j < 4; ++j) ss += (v[j].x * v[j].x + v[j].y * v[j].y) + (v[j].z * v[j].z + v[j].w * v[j].w);
    const float rstd = rsq_(wave_sum_fast(ss) * (1.0f / D) + EPS);
#pragma unroll
    for (int h = 0; h < 2; ++h) { const int c = 8 * lane + 512 * h; f32x4 o[2];
#pragma unroll
        for (int q = 0; q < 2; ++q) { const f32x4 gg = *(const f32x4*)(g + c + 4 * q), sh = *(const f32x4*)(shift + c + 4 * q), sc = *(const f32x4*)(scale + c + 4 * q);
            o[q] = (v[2 * h + q] * rstd * gg) * (sc + 1.0f) + sh; }
        v4u w; w.x = pk2(o[0].x, o[0].y); w.y = pk2(o[0].z, o[0].w); w.z = pk2(o[1].x, o[1].y); w.w = pk2(o[1].z, o[1].w);
        *(v4u*)(orow + c) = w; }
}
__device__ __forceinline__ void load_row8(const bf16* row, int lane, f32x4 (&v)[4]) {
#pragma unroll
    for (int h = 0; h < 2; ++h) { const v4u w = *(const v4u*)(row + 8 * lane + 512 * h);
        v[2 * h] = (f32x4){bf2f(w.x & 0xffffu), bf2f(w.x >> 16), bf2f(w.y & 0xffffu), bf2f(w.y >> 16)}; v[2 * h + 1] = (f32x4){bf2f(w.z & 0xffffu), bf2f(w.z >> 16), bf2f(w.w & 0xffffu), bf2f(w.w >> 16)}; }
}
__device__ __forceinline__ void store_row8(bf16* row, int lane, const f32x4 (&v)[4]) {
#pragma unroll
    for (int h = 0; h < 2; ++h) { v4u w; w.x = pk2(v[2 * h].x, v[2 * h].y); w.y = pk2(v[2 * h].z, v[2 * h].w); w.z = pk2(v[2 * h + 1].x, v[2 * h + 1].y); w.w = pk2(v[2 * h + 1].z, v[2 * h + 1].w);
        *(v4u*)(row + 8 * lane + 512 * h) = w; }
}
__device__ __forceinline__ void s0_norm1(Frame& F) {
    const int gw = F.wg * NWAVES + F.wave, NGW = F.G * NWAVES;
    const float* MS = WSP(float, WS_MODS); bf16* HX = HXP();
    const int npairs = NROW / 2;
    f32x4 va[4], vb[4];
    const int nfull = npairs / NGW, left = npairs - nfull * NGW, xw = (left + F.G - 1) / F.G;
    const int xp = nfull * NGW + F.wg * xw + F.wave, ntrips = nfull + ((F.wave < xw && xp < npairs) ? 1 : 0);
#define TRIP_PAIR(k) ((k) < nfull ? gw + (k) * NGW : xp)
    if (ntrips > 0) { const int ra = 2 * TRIP_PAIR(0); const float* xr = ra < NLAT ? INP(I_X) + (size_t)ra * D : INP(I_CTX) + (size_t)(ra - NLAT) * D;
#pragma unroll
        for (int j = 0; j < 4; ++j) { va[j] = *(const f32x4*)(xr + 4 * F.lane + 256 * j); vb[j] = *(const f32x4*)(xr + D + 4 * F.lane + 256 * j); } }
    for (int k = 0; k < ntrips; ++k) {
        const int rp = TRIP_PAIR(k);
        const int ra = 2 * rp; f32x4 na[4], nb[4]; const bool more = k + 1 < ntrips;
        if (more) { const int rn = 2 * TRIP_PAIR(k + 1); const float* xr = rn < NLAT ? INP(I_X) + (size_t)rn * D : INP(I_CTX) + (size_t)(rn - NLAT) * D;
#pragma unroll
            for (int j = 0; j < 4; ++j) { na[j] = *(const f32x4*)(xr + 4 * F.lane + 256 * j); nb[j] = *(const f32x4*)(xr + D + 4 * F.lane + 256 * j); } }
        const float* m = MS + (size_t)row_set(ra) * 6144;
        norm_mod_store(va, INP(I_GN1), m, m + 1024, HX + (size_t)ra * D, F.lane);
        norm_mod_store(vb, INP(I_GN1), m, m + 1024, HX + (size_t)(ra + 1) * D, F.lane);
        if (more) {
#pragma unroll
            for (int j = 0; j < 4; ++j) { va[j] = na[j]; vb[j] = nb[j]; } }
    }
#undef TRIP_PAIR
}

#define MFMA32(a, b, c) __builtin_amdgcn_mfma_f32_32x32x16_bf16((a), (b), (c), 0, 0, 0)
__device__ __forceinline__ bf16x8 ldsB_frag(const LAS bf16* t, int stride, int k0, int col, int lane) {
    const LAS bf16* p = t + (k0 + 8 * (lane >> 5)) * stride + col; bf16x8 r;
#pragma unroll
    for (int j = 0; j < 8; ++j) r[j] = (short)p[j * stride];
    return r;
}
__device__ __forceinline__ bf16x8 neg_frag(bf16x8 a) { v4u u = __builtin_bit_cast(v4u, a); u ^= 0x80008000u; return __builtin_bit_cast(bf16x8, u); }
__device__ __forceinline__ int rowmap(int r, int hh) { return (r & 3) + 8 * (r >> 2) + 4 * hh; }

constexpr int D1_STRIDE = 520;
constexpr int D2_STRIDE = 264;
constexpr int D1M_STRIDE = 136;
__device__ __forceinline__ void dft1_unit(Frame& F, int b, int nq) {
    relaunder(F);
    LAS bf16* MC = (LAS bf16*)F.lds; LAS bf16* MS = MC + 128 * D1M_STRIDE; LAS bf16* tile = MS + 128 * D1M_STRIDE;
    const bf16* ZB = ZBP(); bf16* T1 = WSP(bf16, WS_T1);
    for (int i = 0; i < 32; ++i) { const int idx = F.tid + NTHR * i, kp = idx >> 7, np = idx & 127; const float fr = (float)((kp * (64 * np + nq)) & 8191) * (1.0f / 8192.0f);
        MC[kp * D1M_STRIDE + np] = (bf16)f2bf(__builtin_amdgcn_cosf(fr)); MS[kp * D1M_STRIDE + np] = (bf16)f2bf(__builtin_amdgcn_sinf(fr)); }
    const int hh = F.lane >> 5, ln = F.lane & 31;
    for (int h = 0; h < 2; ++h) {
#pragma unroll
        for (int i = 0; i < 8; ++i) { const int q = F.tid + NTHR * i, row = q >> 5, c = q & 31;
            const v4u v = *(const v4u*)(ZB + ((size_t)(b * 64 + nq) * 128 + row) * 512 + (c < 16 ? 128 * h + 8 * c : 256 + 128 * h + 8 * (c - 16)));
            *(LAS v4u*)(tile + row * D2_STRIDE + c * 8) = v; }
        LDS_WAIT(); __syncthreads();
        const int c1 = ln < 16 ? 16 * F.wave + ln : 128 + 16 * F.wave + (ln - 16), c2 = ln < 16 ? 128 + 16 * F.wave + ln : 16 * F.wave + (ln - 16);
        const unsigned sgn = ln < 16 ? 0u : 0x80008000u;
        f32x16 acc[4];
#pragma unroll
        for (int mb = 0; mb < 4; ++mb)
#pragma unroll
            for (int r = 0; r < 16; ++r) acc[mb][r] = 0.f;
#pragma unroll 2
        for (int ks = 0; ks < 8; ++ks) {
            const bf16x8 x1 = ldsB_frag(tile, D2_STRIDE, 16 * ks, c1, F.lane); bf16x8 x2 = ldsB_frag(tile, D2_STRIDE, 16 * ks, c2, F.lane);
            { v4u u = __builtin_bit_cast(v4u, x2); u ^= sgn; x2 = __builtin_bit_cast(bf16x8, u); }
#pragma unroll
            for (int mb = 0; mb < 4; ++mb) { const bf16x8 cf = *(const LAS bf16x8*)(MC + (32 * mb + ln) * D1M_STRIDE + 16 * ks + 8 * hh), sf = *(const LAS bf16x8*)(MS + (32 * mb + ln) * D1M_STRIDE + 16 * ks + 8 * hh);
                acc[mb] = MFMA32(cf, x1, acc[mb]); acc[mb] = MFMA32(sf, x2, acc[mb]); }
        }
        __syncthreads();
        { const int ri = ln >> 4, col = 16 * F.wave + (ln & 15);
#pragma unroll
          for (int mb = 0; mb < 4; ++mb)
#pragma unroll
            for (int r = 0; r < 16; ++r) { const int kp = 32 * mb + rowmap(r, hh); tile[(kp * 2 + ri) * 136 + col] = (bf16)f2bf(acc[mb][r]); } }
        LDS_WAIT(); __syncthreads();
#pragma unroll
        for (int i = 0; i < 8; ++i) { const int q = F.tid + NTHR * i, orow = q >> 4, ch = q & 15;
            const v4u v = *(const LAS v4u*)(tile + orow * 136 + ch * 8);
            *(v4u*)(T1 + ((size_t)((b * 128 + (orow >> 1)) * 64 + nq) * 2 + (orow & 1)) * 256 + 128 * h + ch * 8) = v; }
        __syncthreads();
    }
}
__device__ __forceinline__ void dft2_unit(Frame& F, int l, const bf16* Amat, int lda, int m0, int nchunks, const bf16* dbase, size_t tokstride, size_t chunkstride, float scale, int orow0, int ostride, const LAS bf16* Alds) {
    relaunder(F);
    LAS bf16* tile = (LAS bf16*)F.lds;
    const int hh = F.lane >> 5, ln = F.lane & 31, cw = 32 * F.wave + ln;
    f32x16 acc[2];
#pragma unroll
    for (int mb = 0; mb < 2; ++mb)
#pragma unroll
        for (int r = 0; r < 16; ++r) acc[mb][r] = 0.f;
    for (int ck = 0; ck < nchunks; ++ck) {
        const bf16* dsrc = dbase + (size_t)ck * chunkstride;
        { v4u dv[8];
#pragma unroll
          for (int i = 0; i < 8; ++i) { const int q = F.tid + NTHR * i, krow = q >> 5, ch = q & 31;
              dv[i] = *(const v4u*)(dsrc + (size_t)(krow >> 1) * tokstride + (krow & 1) * 256 + ch * 8); }
#pragma unroll
          for (int i = 0; i < 8; ++i) { const int q = F.tid + NTHR * i, krow = q >> 5, ch = q & 31; *(LAS v4u*)(tile + krow * D2_STRIDE + ch * 8) = dv[i]; } }
        LDS_WAIT(); __syncthreads();
        for (int ks = 0; ks < 8; ++ks) {
            const bf16x8 xf = ldsB_frag(tile, D2_STRIDE, 16 * ks, cw, F.lane);
#pragma unroll
            for (int mb = 0; mb < 2; ++mb) { const bf16x8 af = Alds ? *(const LAS bf16x8*)(Alds + (32 * mb + ln) * 136 + 16 * ks + 8 * hh) : *(const bf16x8*)(Amat + (size_t)(m0 + 32 * mb + ln) * lda + ck * 128 + 16 * ks + 8 * hh);
                acc[mb] = MFMA32(af, xf, acc[mb]); }
        }
        __syncthreads();
    }
    LAS float* yt = (LAS float*)F.lds;
#pragma unroll
    for (int mb = 0; mb < 2; ++mb)
#pragma unroll
        for (int r = 0; r < 16; ++r) yt[(32 * mb + rowmap(r, hh)) * 260 + cw] = acc[mb][r] * scale;
    LDS_WAIT(); __syncthreads();
    { const int m = F.tid >> 3, seg = F.tid & 7; const LAS float* p = yt + m * 260 + 32 * seg;
        f32x4 v[8]; float ss = 0.f;
#pragma unroll
        for (int j = 0; j < 8; ++j) { v[j] = *(const LAS f32x4*)(p + 4 * j); ss += (v[j].x * v[j].x + v[j].y * v[j].y) + (v[j].z * v[j].z + v[j].w * v[j].w); }
        ss += __shfl_xor(ss, 1); ss += __shfl_xor(ss, 2); ss += __shfl_xor(ss, 4);
        const float rstd = rsq_(ss * (1.0f / 256.0f) + EPS);
        const float* g = INP(I_GOUT) + l * 1024 + 768 + 32 * seg;
        bf16* o = HXP() + (size_t)(orow0 + m * ostride) * D + 768 + 32 * seg;
#pragma unroll
        for (int j = 0; j < 4; ++j) { const f32x4 g0 = *(const f32x4*)(g + 8 * j), g1 = *(const f32x4*)(g + 8 * j + 4); const f32x4 a = v[2 * j] * rstd * g0, c = v[2 * j + 1] * rstd * g1;
            v4u w; w.x = pk2(a.x, a.y); w.y = pk2(a.z, a.w); w.z = pk2(c.x, c.y); w.w = pk2(c.z, c.w); *(v4u*)(o + 8 * j) = w; } }
    __syncthreads();
}

__device__ __forceinline__ void dft2_latent_loop(Frame& F, int l, int u0, int nw, int nu, const LAS bf16* Alds) {
    relaunder(F);
    LAS bf16* tile = (LAS bf16*)F.lds;
    const int hh = F.lane >> 5, ln = F.lane & 31, cw = 32 * F.wave + ln;
    const bf16* T1 = WSP(bf16, WS_T1);
    v4u dv[8];
#define D2_ISSUE(u_) { const bf16* dsrc = T1 + (size_t)(u_) * 64 * 512; _Pragma("unroll") for (int i = 0; i < 8; ++i) { const int q = F.tid + NTHR * i, krow = q >> 5, ch = q & 31; dv[i] = *(const v4u*)(dsrc + (size_t)(krow >> 1) * 512 + (krow & 1) * 256 + ch * 8); } }
    if (u0 < nu) D2_ISSUE(u0)
    for (int u = u0; u < nu; u += nw) {
        const int b = u >> 7, kp = u & 127, orow0 = b * SEQ + kp;
#pragma unroll
        for (int i = 0; i < 8; ++i) { const int q = F.tid + NTHR * i, krow = q >> 5, ch = q & 31; *(LAS v4u*)(tile + krow * D2_STRIDE + ch * 8) = dv[i]; }
        LDS_WAIT(); __syncthreads();
        if (u + nw < nu) D2_ISSUE(u + nw)
        f32x16 acc[2];
#pragma unroll
        for (int mb = 0; mb < 2; ++mb)
#pragma unroll
            for (int r = 0; r < 16; ++r) acc[mb][r] = 0.f;
#pragma unroll
        for (int ks = 0; ks < 8; ++ks) {
            const bf16x8 xf = ldsB_frag(tile, D2_STRIDE, 16 * ks, cw, F.lane);
#pragma unroll
            for (int mb = 0; mb < 2; ++mb) { const bf16x8 af = *(const LAS bf16x8*)(Alds + (32 * mb + ln) * 136 + 16 * ks + 8 * hh); acc[mb] = MFMA32(af, xf, acc[mb]); } }
        __syncthreads();
        LAS float* yt = (LAS float*)F.lds;
#pragma unroll
        for (int mb = 0; mb < 2; ++mb)
#pragma unroll
            for (int r = 0; r < 16; ++r) yt[(32 * mb + rowmap(r, hh)) * 260 + cw] = acc[mb][r] * 0.001381067932004976f;
        LDS_WAIT(); __syncthreads();
        { const int m = F.tid >> 3, seg = F.tid & 7; const LAS float* p = yt + m * 260 + 32 * seg;
            f32x4 v[8]; float ss = 0.f;
#pragma unroll
            for (int j = 0; j < 8; ++j) { v[j] = *(const LAS f32x4*)(p + 4 * j); ss += (v[j].x * v[j].x + v[j].y * v[j].y) + (v[j].z * v[j].z + v[j].w * v[j].w); }
            ss += __shfl_xor(ss, 1); ss += __shfl_xor(ss, 2); ss += __shfl_xor(ss, 4);
            const float rstd = rsq_(ss * (1.0f / 256.0f) + EPS);
            const float* g = INP(I_GOUT) + l * 1024 + 768 + 32 * seg;
            bf16* o = HXP() + (size_t)(orow0 + m * 128) * D + 768 + 32 * seg;
#pragma unroll
            for (int j = 0; j < 4; ++j) { const f32x4 g0 = *(const f32x4*)(g + 8 * j), g1 = *(const f32x4*)(g + 8 * j + 4); const f32x4 a = v[2 * j] * rstd * g0, c = v[2 * j + 1] * rstd * g1;
                v4u w; w.x = pk2(a.x, a.y); w.y = pk2(a.z, a.w); w.z = pk2(c.x, c.y); w.w = pk2(c.z, c.w); *(v4u*)(o + 8 * j) = w; } }
        __syncthreads();
    }
#undef D2_ISSUE
}

constexpr int UT_STRIDE = 520;
constexpr int UT_BYTES = 64 * UT_STRIDE * 2;
struct UWin { u16x8 rows[11]; };
__device__ __forceinline__ void lru_bounds(int cid, int& lo, int& hi) { if (cid < 512) { lo = cid * 64; hi = lo + 64; } else { lo = NLAT + ((cid - 512) >> 2) * CTXL; hi = lo + CTXL; } }
__device__ __forceinline__ void lru_issue_u(Frame& F, int cid, UWin& w) {
    const bf16* PX = WSP(bf16, WS_REGA);
    const int row0 = cid * 64; int lo, hi; lru_bounds(cid, lo, hi);
    const int ch0 = (F.tid & 63) * 8, t0 = (F.tid >> 6) * 8;
#pragma unroll
    for (int k = 0; k < 11; ++k) { const int rr = row0 + t0 - 1 + k, rc = rr < lo ? lo : (rr >= hi ? hi - 1 : rr);
        w.rows[k] = *(const u16x8*)(PX + (size_t)rc * PXC + ch0); }
}
__device__ __forceinline__ void lru_finish_u(Frame& F, int l, int cid, UWin& win, LAS bf16* ut) {
    const int row0 = cid * 64; int lo, hi; lru_bounds(cid, lo, hi);
    const int ch0 = (F.tid & 63) * 8, t0 = (F.tid >> 6) * 8;
    f32x4 w[4][2], bias[2];
#pragma unroll
    for (int k = 0; k < 4; ++k) { w[k][0] = *(const f32x4*)(INP(I_LCW) + (l * 4 + k) * 512 + ch0); w[k][1] = *(const f32x4*)(INP(I_LCW) + (l * 4 + k) * 512 + ch0 + 4); }
    bias[0] = *(const f32x4*)(INP(I_LCB) + l * 512 + ch0); bias[1] = *(const f32x4*)(INP(I_LCB) + l * 512 + ch0 + 4);
#pragma unroll
    for (int k = 0; k < 11; ++k) { const int rr = row0 + t0 - 1 + k; if (rr < lo || rr >= hi) win.rows[k] = (u16x8){0, 0, 0, 0, 0, 0, 0, 0}; }
#pragma unroll
    for (int t = 0; t < 8; ++t) { f32x4 a0 = bias[0], a1 = bias[1];
#pragma unroll
        for (int k = 0; k < 4; ++k) { const u16x8 v = win.rows[t + k];
            a0 += w[k][0] * (f32x4){bf2f(v[0]), bf2f(v[1]), bf2f(v[2]), bf2f(v[3])}; a1 += w[k][1] * (f32x4){bf2f(v[4]), bf2f(v[5]), bf2f(v[6]), bf2f(v[7])}; }
        v4u o; o.x = pk2(a0.x, a0.y); o.y = pk2(a0.z, a0.w); o.z = pk2(a1.x, a1.y); o.w = pk2(a1.z, a1.w);
        *(LAS v4u*)(ut + (t0 + t) * UT_STRIDE + ch0) = o; }
}
struct LruOps { bf16x8 fr[2][4], fi[2][4]; float b_r[2], b_i[2], sp[2]; };
template <int dir> __device__ __forceinline__ void lru_load_ops(Frame& F, int l, int nb, LruOps& o) {
    const int hd = F.wave, hh = F.lane >> 5, ln = F.lane & 31, ch = hd * 64 + nb * 32 + ln;
    const bf16* WG = WSP(bf16, WS_WGL) + ((size_t)l * 8 + hd) * 256 * 64;
#pragma unroll
    for (int ks = 0; ks < 4; ++ks) {
        o.fr[dir][ks] = *(const bf16x8*)(WG + (size_t)((dir * 2 + 0) * 64 + nb * 32 + ln) * 64 + 16 * ks + 8 * hh);
        o.fi[dir][ks] = *(const bf16x8*)(WG + (size_t)((dir * 2 + 1) * 64 + nb * 32 + ln) * 64 + 16 * ks + 8 * hh); }
    o.b_r[dir] = -1.4426950408889634f * INP(I_LBR)[(l * 2 + dir) * 512 + ch]; o.b_i[dir] = -1.4426950408889634f * INP(I_LBI)[(l * 2 + dir) * 512 + ch]; o.sp[dir] = -1.4426950408889634f * WSP(float, WS_SP8)[(l * 2 + dir) * 512 + ch];
}
template <int dir> __device__ __forceinline__ void lru_gates(Frame& F, const LruOps& o, const LAS bf16* ut, int mb, f32x16& a, f32x16& bb) {
    const int hd = F.wave, hh = F.lane >> 5, ln = F.lane & 31;
#pragma unroll
    for (int r = 0; r < 16; ++r) { a[r] = 0.f; bb[r] = 0.f; }
#pragma unroll
    for (int ks = 0; ks < 4; ++ks) {
        const bf16x8 af = *(const LAS bf16x8*)(ut + (32 * mb + ln) * UT_STRIDE + hd * 64 + 16 * ks + 8 * hh);
        a = MFMA32(af, o.fr[dir][ks], a); bb = MFMA32(af, o.fi[dir][ks], bb);
    }
}
template <int dir> __device__ __forceinline__ void lru_elem(Frame& F, const LruOps& o, const LAS bf16* ut, int nb, int mb, f32x16& a, f32x16& bb) {
    const int hd = F.wave, hh = F.lane >> 5, ln = F.lane & 31, ch = hd * 64 + nb * 32 + ln;
    typedef float f32x2 __attribute__((ext_vector_type(2)));
    const float nb_r = o.b_r[dir], nb_i = o.b_i[dir], spl = o.sp[dir];
    const LAS bf16* ub = ut + (32 * mb + 4 * hh) * UT_STRIDE + ch;
#pragma unroll
    for (int r = 0; r < 16; r += 2) {
        const f32x2 pa = {a[r], a[r + 1]}, pb = {bb[r], bb[r + 1]};
        const f32x2 xr = pa * -1.4426950408889634f + nb_r, xi = pb * -1.4426950408889634f + nb_i;
        const f32x2 dr = (f32x2){__builtin_amdgcn_exp2f(xr.x), __builtin_amdgcn_exp2f(xr.y)} + 1.0f, di = (f32x2){__builtin_amdgcn_exp2f(xi.x), __builtin_amdgcn_exp2f(xi.y)} + 1.0f;
        const f32x2 rr = {__builtin_amdgcn_rcpf(dr.x), __builtin_amdgcn_rcpf(dr.y)}, ii = {__builtin_amdgcn_rcpf(di.x), __builtin_amdgcn_rcpf(di.y)};
        const f32x2 z = rr * spl;
        const f32x2 av = {__builtin_amdgcn_exp2f(z.x), __builtin_amdgcn_exp2f(z.y)};
        const f32x2 om = 1.0f - av * av;
        const f32x2 mult = {__builtin_amdgcn_sqrtf(om.x), __builtin_amdgcn_sqrtf(om.y)};
        const f32x2 uv = {bf2f(ub[((r & 3) + 8 * (r >> 2)) * UT_STRIDE]), bf2f(ub[(((r + 1) & 3) + 8 * ((r + 1) >> 2)) * UT_STRIDE])};
        const f32x2 bv = (mult * ii) * uv;
        a[r] = av.x; a[r + 1] = av.y; bb[r] = bv.x; bb[r + 1] = bv.y; }
}
#define MEMFENCE() asm volatile("" ::: "memory")
template <int dir> __device__ __forceinline__ float lru_scan(int lane, float hin, const f32x16& a, f32x16& bb, float* Atot) {
    const bool hi = (lane >> 5) != 0;
    const bool own_first = dir == 0 ? !hi : hi;
    float oA[4], oB[4];
#pragma unroll
    for (int q = 0; q < 4; ++q) {
        const float a0 = a[4 * q], a1 = a[4 * q + 1], a2 = a[4 * q + 2], a3 = a[4 * q + 3];
        const float b0 = bb[4 * q], b1 = bb[4 * q + 1], b2 = bb[4 * q + 2], b3 = bb[4 * q + 3];
        oA[q] = (a0 * a1) * (a2 * a3);
        oB[q] = dir == 0 ? ((b0 * a1 + b1) * a2 + b2) * a3 + b3 : ((b3 * a2 + b2) * a1 + b1) * a0 + b0; }
    float h = hin, At = 1.0f; float cin[4];
#pragma unroll
    for (int s = 0; s < 4; ++s) { const int q = dir == 0 ? s : 3 - s;
        const float pA = __shfl_xor(oA[q], 32), pB = __shfl_xor(oB[q], 32);
        const float A1 = own_first ? oA[q] : pA, B1 = own_first ? oB[q] : pB, A2 = own_first ? pA : oA[q], B2 = own_first ? pB : oB[q];
        const float h1 = A1 * h + B1, h2 = A2 * h1 + B2;
        cin[q] = own_first ? h : h1; h = h2; At *= A1 * A2; }
#pragma unroll
    for (int q = 0; q < 4; ++q) { float x = cin[q];
        if (dir == 0) {
#pragma unroll
            for (int j = 0; j < 4; ++j) { x = a[4 * q + j] * x + bb[4 * q + j]; bb[4 * q + j] = x; }
        } else {
#pragma unroll
            for (int j = 3; j >= 0; --j) { x = a[4 * q + j] * x + bb[4 * q + j]; bb[4 * q + j] = x; }
        } }
    *Atot = At; return h;
}
template <int dir> __device__ __forceinline__ float lru_scanP(int lane, float hin, float pin, f32x16& a, f32x16& bb, float* Pend) {
    const bool hi = (lane >> 5) != 0;
    const bool own_first = dir == 0 ? !hi : hi;
    float oA[4], oB[4];
#pragma unroll
    for (int q = 0; q < 4; ++q) {
        const float a0 = a[4 * q], a1 = a[4 * q + 1], a2 = a[4 * q + 2], a3 = a[4 * q + 3];
        const float b0 = bb[4 * q], b1 = bb[4 * q + 1], b2 = bb[4 * q + 2], b3 = bb[4 * q + 3];
        oA[q] = (a0 * a1) * (a2 * a3);
        oB[q] = dir == 0 ? ((b0 * a1 + b1) * a2 + b2) * a3 + b3 : ((b3 * a2 + b2) * a1 + b1) * a0 + b0; }
    float h = hin, pr = pin; float cin[4], cinP[4];
#pragma unroll
    for (int s = 0; s < 4; ++s) { const int q = dir == 0 ? s : 3 - s;
        const float pA = __shfl_xor(oA[q], 32), pB = __shfl_xor(oB[q], 32);
        const float A1 = own_first ? oA[q] : pA, B1 = own_first ? oB[q] : pB, A2 = own_first ? pA : oA[q], B2 = own_first ? pB : oB[q];
        const float h1 = A1 * h + B1, h2 = A2 * h1 + B2, p1 = pr * A1, p2 = p1 * A2;
        cin[q] = own_first ? h : h1; cinP[q] = own_first ? pr : p1; h = h2; pr = p2; }
#pragma unroll
    for (int q = 0; q < 4; ++q) { float x = cin[q], p = cinP[q];
        if (dir == 0) {
#pragma unroll
            for (int j = 0; j < 4; ++j) { const float av = a[4 * q + j]; x = av * x + bb[4 * q + j]; p *= av; bb[4 * q + j] = x; a[4 * q + j] = p; }
        } else {
#pragma unroll
            for (int j = 3; j >= 0; --j) { const float av = a[4 * q + j]; x = av * x + bb[4 * q + j]; p *= av; bb[4 * q + j] = x; a[4 * q + j] = p; }
        } }
    *Pend = pr; return h;
}
__device__ __forceinline__ void store_blk(bf16* blk, int lane, const f32x16& v) {
    v4u w0, w1;
    w0.x = pk2(v[0], v[1]); w0.y = pk2(v[2], v[3]); w0.z = pk2(v[4], v[5]); w0.w = pk2(v[6], v[7]);
    w1.x = pk2(v[8], v[9]); w1.y = pk2(v[10], v[11]); w1.z = pk2(v[12], v[13]); w1.w = pk2(v[14], v[15]);
    *(v4u*)(blk + lane * 8) = w0; *(v4u*)(blk + 512 + lane * 8) = w1;
}
__device__ __forceinline__ size_t sp_block(int cid, int head, int nb, int arr, int mb) { return ((size_t)((((cid * 8 + head) * 2 + nb) * 3 + arr) * 2 + mb)) * 1024; }
__device__ __forceinline__ void lru_a_phase(Frame& F, int l) {
    relaunder(F);
    LAS bf16* ut = (LAS bf16*)F.lds;
    float* SM = WSP(float, WS_SUMM);
    constexpr int NUNIT = 512 + 2 * (NCHUNK - 512);
    int un = F.wg; UWin win;
    if (un < NUNIT) lru_issue_u(F, un < 512 ? un : 512 + ((un - 512) >> 1), win);
    for (; un < NUNIT; un += F.G) {
        const int cid = un < 512 ? un : 512 + ((un - 512) >> 1), nbsel = un < 512 ? -1 : ((un - 512) & 1);
        LruOps o; lru_load_ops<0>(F, l, nbsel < 0 ? 0 : nbsel, o);
        lru_finish_u(F, l, cid, win, ut);
        LDS_WAIT(); __syncthreads();
        if (un + F.G < NUNIT) { const int u2 = un + F.G; lru_issue_u(F, u2 < 512 ? u2 : 512 + ((u2 - 512) >> 1), win); }
#pragma unroll
        for (int nb = 0; nb < 2; ++nb) { const int ch = F.wave * 64 + nb * 32 + (F.lane & 31);
            if (nbsel >= 0 && nb != nbsel) continue;
            f32x16 a, bb, S0, S1; float A0, A1; bf16* SP = WSP(bf16, WS_SP);
            lru_gates<0>(F, o, ut, 0, a, bb); lru_elem<0>(F, o, ut, nb, 0, a, bb); const float B0 = lru_scanP<0>(F.lane, 0.0f, 1.0f, a, bb, &A0); S0 = bb; store_blk(SP + sp_block(cid, F.wave, nb, 1, 0), F.lane, a);
            lru_gates<0>(F, o, ut, 1, a, bb); MEMFENCE(); lru_load_ops<1>(F, l, nb, o); MEMFENCE();
            lru_elem<0>(F, o, ut, nb, 1, a, bb); const float B1 = lru_scanP<0>(F.lane, B0, A0, a, bb, &A1); S1 = bb; store_blk(SP + sp_block(cid, F.wave, nb, 1, 1), F.lane, a);
            if (F.lane < 32) { SM[((size_t)(cid * 2 + 0) * 2 + 0) * 512 + ch] = A1; SM[((size_t)(cid * 2 + 0) * 2 + 1) * 512 + ch] = B1; }
            lru_gates<1>(F, o, ut, 1, a, bb); lru_elem<1>(F, o, ut, nb, 1, a, bb); const float C1 = lru_scanP<1>(F.lane, 0.0f, 1.0f, a, bb, &A1); S1 += bb;
            store_blk(SP + sp_block(cid, F.wave, nb, 2, 1), F.lane, a); store_blk(SP + sp_block(cid, F.wave, nb, 0, 1), F.lane, S1);
            lru_gates<1>(F, o, ut, 0, a, bb);
            lru_elem<1>(F, o, ut, nb, 0, a, bb); const float C0 = lru_scanP<1>(F.lane, C1, A1, a, bb, &A0); S0 += bb;
            store_blk(SP + sp_block(cid, F.wave, nb, 2, 0), F.lane, a); store_blk(SP + sp_block(cid, F.wave, nb, 0, 0), F.lane, S0);
            if (F.lane < 32) { SM[((size_t)(cid * 2 + 1) * 2 + 0) * 512 + ch] = A0; SM[((size_t)(cid * 2 + 1) * 2 + 1) * 512 + ch] = C0; }
            if (nb == 0 && nbsel < 0) { MEMFENCE(); lru_load_ops<0>(F, l, 1, o); MEMFENCE(); }
        }
        __syncthreads();
    }
}
__device__ __forceinline__ int carry_cid(int b, int dir, int st) { return dir == 0 ? (st < 4 ? 512 + 4 * b + st : 128 * b + st - 4) : (st < 4 ? 512 + 4 * b + 3 - st : 128 * b + 131 - st); }
__device__ __forceinline__ void s3_carries(Frame& F, int wv  ) {
    const int part = F.lane >> 3, seq = wv * 8 + (F.lane & 7), b = seq >> 10, dir = (seq >> 9) & 1, ch = seq & 511;
    const int s0 = part * 16 + (part < 4 ? part : 4), len = part < 4 ? 17 : 16;
    const float* __restrict__ SM = WSP(float, WS_SUMM); float* __restrict__ CR = WSP(float, WS_CARRY);
    float A[17], B[17];
#pragma unroll
    for (int j = 0; j < 17; ++j) { const int st = s0 + (j < len ? j : 0), cid = carry_cid(b, dir, st);
        A[j] = SM[((size_t)(cid * 2 + dir) * 2 + 0) * 512 + ch]; B[j] = SM[((size_t)(cid * 2 + dir) * 2 + 1) * 512 + ch]; }
    float At = 1.f, Bt = 0.f;
#pragma unroll
    for (int j = 0; j < 17; ++j) if (j < len) { Bt = A[j] * Bt + B[j]; At *= A[j]; }
#pragma unroll
    for (int d = 8; d < 64; d <<= 1) { const float pA = __shfl_up(At, d), pB = __shfl_up(Bt, d); if (F.lane >= d) { Bt = At * pB + Bt; At = At * pA; } }
    float h = __shfl_up(Bt, 8); if (part == 0) h = 0.f;
#pragma unroll
    for (int j = 0; j < 17; ++j) if (j < len) { const int cid = carry_cid(b, dir, s0 + j); CR[(size_t)(cid * 2 + dir) * 512 + ch] = h; h = A[j] * h + B[j]; }
}
__device__ __forceinline__ float gelu_tanh(float x) { const float u = x * x, t = x * __builtin_fmaf(u, -0.10294324f, -2.3022082f);
    return x * __builtin_amdgcn_rcpf(1.0f + __builtin_amdgcn_exp2f(t)); }
__device__ __forceinline__ void lru_b_issue_g(Frame& F, int cid, v4u (&gv)[8]) {
    const bf16* PX = WSP(bf16, WS_REGA); const int row0 = cid * 64;
#pragma unroll
    for (int i = 0; i < 8; ++i) { const int q = F.tid + NTHR * i, tok = q >> 6, cg = q & 63; gv[i] = *(const v4u*)(PX + (size_t)(row0 + tok) * PXC + 512 + cg * 8); }
}
__device__ __forceinline__ void unpack8(const v4u w, float (&f)[8]) {
    f[0] = bf2f(w.x & 0xffffu); f[1] = bf2f(w.x >> 16); f[2] = bf2f(w.y & 0xffffu); f[3] = bf2f(w.y >> 16); f[4] = bf2f(w.z & 0xffffu); f[5] = bf2f(w.z >> 16); f[6] = bf2f(w.w & 0xffffu); f[7] = bf2f(w.w >> 16); }
__device__ __forceinline__ void lru_b_phase(Frame& F, int l, int nc) {
    typedef float f32x2 __attribute__((ext_vector_type(2)));
    relaunder(F);
    LAS bf16* ht = (LAS bf16*)F.lds;
    const float* CR = WSP(float, WS_CARRY); bf16* Y = HXP(); const bf16* SP = WSP(bf16, WS_SP); const bf16* PX = WSP(bf16, WS_REGA);
    const int hh = F.lane >> 5, ln = F.lane & 31;
    for (int cid = F.wg; cid < nc; cid += F.G) {
        const int row0 = cid * 64, tok = F.tid >> 3, seg = F.tid & 7;
        v4u blk[2][2][3][2]; float cf[2], cb[2];
#pragma unroll
        for (int nb = 0; nb < 2; ++nb) { const int ch = F.wave * 64 + nb * 32 + ln;
            cf[nb] = CR[(size_t)(cid * 2 + 0) * 512 + ch]; cb[nb] = CR[(size_t)(cid * 2 + 1) * 512 + ch];
#pragma unroll
            for (int mb = 0; mb < 2; ++mb)
#pragma unroll
                for (int arr = 0; arr < 3; ++arr) { const bf16* p = SP + sp_block(cid, F.wave, nb, arr, mb);
                    blk[nb][mb][arr][0] = *(const v4u*)(p + F.lane * 8); blk[nb][mb][arr][1] = *(const v4u*)(p + 512 + F.lane * 8); } }
        v4u gv[8];
#pragma unroll
        for (int j = 0; j < 8; ++j) gv[j] = *(const v4u*)(PX + (size_t)(row0 + tok) * PXC + 512 + 64 * seg + 8 * j);
#pragma unroll
        for (int nb = 0; nb < 2; ++nb) { const int ch = F.wave * 64 + nb * 32 + ln;
#pragma unroll
            for (int mb = 0; mb < 2; ++mb)
#pragma unroll
                for (int hf = 0; hf < 2; ++hf) { const v4u ws = blk[nb][mb][0][hf], wf = blk[nb][mb][1][hf], wb = blk[nb][mb][2][hf];
                    const unsigned us[4] = {ws.x, ws.y, ws.z, ws.w}, uf[4] = {wf.x, wf.y, wf.z, wf.w}, ub[4] = {wb.x, wb.y, wb.z, wb.w};
#pragma unroll
                    for (int i = 0; i < 4; ++i) { const int r = 8 * hf + 2 * i;
                        const f32x2 sv = {bf2f(us[i] & 0xffffu), __builtin_bit_cast(float, us[i] & 0xffff0000u)}, pf = {bf2f(uf[i] & 0xffffu), __builtin_bit_cast(float, uf[i] & 0xffff0000u)}, pb = {bf2f(ub[i] & 0xffffu), __builtin_bit_cast(float, ub[i] & 0xffff0000u)};
                        const f32x2 h = sv + pf * cf[nb] + pb * cb[nb];
                        const unsigned w = pk2(h.x, h.y);
                        LAS bf16* p = ht + (32 * mb + 4 * hh + (r & 3) + 8 * (r >> 2)) * UT_STRIDE + ch;
                        p[0] = (bf16)(w & 0xffffu); p[UT_STRIDE] = (bf16)(w >> 16); } }
        }
        LDS_WAIT(); __syncthreads();
        {
            const LAS bf16* p = ht + tok * UT_STRIDE + 64 * seg;
            f32x2 yv[8][4]; float ss = 0.f;
#pragma unroll
            for (int j = 0; j < 8; ++j) { const v4u hw = *(const LAS v4u*)(p + 8 * j); const unsigned hu[4] = {hw.x, hw.y, hw.z, hw.w}, gu[4] = {gv[j].x, gv[j].y, gv[j].z, gv[j].w};
#pragma unroll
                for (int i = 0; i < 4; ++i) { const f32x2 h = {bf2f(hu[i] & 0xffffu), __builtin_bit_cast(float, hu[i] & 0xffff0000u)}, g = {bf2f(gu[i] & 0xffffu), __builtin_bit_cast(float, gu[i] & 0xffff0000u)};
                    const f32x2 t = g * ((g * g) * -0.10294324f + -2.3022082f);
                    const f32x2 d = (f32x2){__builtin_amdgcn_exp2f(t.x), __builtin_amdgcn_exp2f(t.y)} + 1.0f;
                    const f32x2 y = (h * g) * (f32x2){__builtin_amdgcn_rcpf(d.x), __builtin_amdgcn_rcpf(d.y)};
                    yv[j][i] = y; ss += y.x * y.x + y.y * y.y; } }
            ss += __shfl_xor(ss, 1); ss += __shfl_xor(ss, 2); ss += __shfl_xor(ss, 4);
            const float rstd = rsq_(ss * (1.0f / 512.0f) + EPS);
            const float* g = INP(I_GOUT) + l * 1024 + 64 * seg; bf16* op = Y + (size_t)(row0 + tok) * D + 64 * seg;
#pragma unroll
            for (int j = 0; j < 8; ++j) { const f32x4 g0 = *(const f32x4*)(g + 8 * j), g1 = *(const f32x4*)(g + 8 * j + 4);
                v4u w; w.x = pk2(yv[j][0].x * rstd * g0.x, yv[j][0].y * rstd * g0.y); w.y = pk2(yv[j][1].x * rstd * g0.z, yv[j][1].y * rstd * g0.w);
                w.z = pk2(yv[j][2].x * rstd * g1.x, yv[j][2].y * rstd * g1.y); w.w = pk2(yv[j][3].x * rstd * g1.z, yv[j][3].y * rstd * g1.w);
                *(v4u*)(op + 8 * j) = w; } }
        __syncthreads();
    }
}
struct ScWin { u16x8 pp[4], bv[2]; };
__device__ __forceinline__ void sc_issue(Frame& F, int hu, ScWin& w) {
    const bf16* PX = WSP(bf16, WS_REGA); const int cid = hu >> 1, row0 = hu * 32, c0 = 8 * (F.tid & 31), t0 = (F.tid >> 5) * 2; int lo, hi; lru_bounds(cid, lo, hi);
#pragma unroll
    for (int k = 0; k < 4; ++k) { const int r2 = row0 + t0 - 1 + k, rc = r2 < lo ? lo : (r2 >= hi ? hi - 1 : r2);
        w.pp[k] = *(const u16x8*)(PX + (size_t)rc * PXC + 1280 + c0); }
#pragma unroll
    for (int t = 0; t < 2; ++t) w.bv[t] = *(const u16x8*)(PX + (size_t)(row0 + t0 + t) * PXC + 1024 + c0);
}
__device__ __forceinline__ void sc_phase(Frame& F, int l, int nc, int wg0, int nwg) {
    relaunder(F);
    if (F.wg < wg0) return;
    bf16* Y = HXP();
    const int c0 = 8 * (F.tid & 31), t0 = (F.tid >> 5) * 2, nh = 2 * nc;
    f32x4 w[3][2], gg[2];
#pragma unroll
    for (int k = 0; k < 3; ++k) { w[k][0] = *(const f32x4*)(INP(I_SCW) + (l * 3 + k) * 256 + c0); w[k][1] = *(const f32x4*)(INP(I_SCW) + (l * 3 + k) * 256 + c0 + 4); }
    gg[0] = *(const f32x4*)(INP(I_GOUT) + l * 1024 + 512 + c0); gg[1] = *(const f32x4*)(INP(I_GOUT) + l * 1024 + 512 + c0 + 4);
    int hu = F.wg - wg0; ScWin cur;
    if (hu < nh) sc_issue(F, hu, cur);
    for (; hu < nh; hu += nwg) {
        ScWin nxt; const bool more = hu + nwg < nh;
        if (more) sc_issue(F, hu + nwg, nxt);
        const int row0 = hu * 32; int lo, hi; lru_bounds(hu >> 1, lo, hi);
        f32x4 p0[4], p1[4];
#pragma unroll
        for (int k = 0; k < 4; ++k) { const int r2 = row0 + t0 - 1 + k; const float ok = (r2 >= lo && r2 < hi) ? 1.0f : 0.0f;
            p0[k] = (f32x4){bf2f(cur.pp[k][0]), bf2f(cur.pp[k][1]), bf2f(cur.pp[k][2]), bf2f(cur.pp[k][3])} * ok;
            p1[k] = (f32x4){bf2f(cur.pp[k][4]), bf2f(cur.pp[k][5]), bf2f(cur.pp[k][6]), bf2f(cur.pp[k][7])} * ok; }
#pragma unroll
        for (int t = 0; t < 2; ++t) { const u16x8 bv = cur.bv[t];
            f32x4 a0 = (w[0][0] * p0[t] + w[1][0] * p0[t + 1] + w[2][0] * p0[t + 2]) * (f32x4){bf2f(bv[0]), bf2f(bv[1]), bf2f(bv[2]), bf2f(bv[3])};
            f32x4 a1 = (w[0][1] * p1[t] + w[1][1] * p1[t + 1] + w[2][1] * p1[t + 2]) * (f32x4){bf2f(bv[4]), bf2f(bv[5]), bf2f(bv[6]), bf2f(bv[7])};
            float ss = (a0.x * a0.x + a0.y * a0.y) + (a0.z * a0.z + a0.w * a0.w) + (a1.x * a1.x + a1.y * a1.y) + (a1.z * a1.z + a1.w * a1.w);
            ss += __shfl_xor(ss, 1); ss += __shfl_xor(ss, 2); ss += __shfl_xor(ss, 4); ss += __shfl_xor(ss, 8); ss += __shfl_xor(ss, 16);
            const float rstd = rsq_(ss * (1.0f / 256.0f) + EPS);
            a0 = a0 * rstd * gg[0]; a1 = a1 * rstd * gg[1];
            v4u wv; wv.x = pk2(a0.x, a0.y); wv.y = pk2(a0.z, a0.w); wv.z = pk2(a1.x, a1.y); wv.w = pk2(a1.z, a1.w);
            *(v4u*)(Y + (size_t)(row0 + t0 + t) * D + 512 + c0) = wv; }
        if (more) cur = nxt;
    }
}

__device__ __forceinline__ void ctx_outproj_tile(Frame& F, int l) {
    constexpr int RS = 1040;
    const int rt = F.wg >> 4, ct = F.wg & 15, rg = F.wave >> 1, cg0 = 2 * (F.wave & 1), fr = F.lane & 15, fq = F.lane >> 4;
    const bf16* ybase = HXP() + (size_t)(NLAT + 64 * rt) * D;
    const bf16* wbase = WSP(bf16, WS_WOUT) + (size_t)l * 1024 * 1024 + (size_t)(64 * ct) * 1024;
    pg8::f32x4 acc[2] = {{0.f, 0.f, 0.f, 0.f}, {0.f, 0.f, 0.f, 0.f}};
    const LAS unsigned char* xl = F.lds + (16 * rg + fr) * RS + 16 * fq;
    const LAS unsigned char* wl = F.lds + (64 + 16 * cg0 + fr) * RS + 16 * fq;
    const int row = NLAT + 64 * rt + 16 * rg + fr;
    const float* gp = WSP(float, WS_MODS) + (size_t)l * 5 * 6144 + 2 * 1024 + (size_t)4 * 6144;
    bf16* XB = XBP();
    v4u st[16], st2[16];
#define CTX_LD(dst, h_) _Pragma("unroll") for (int i = 0; i < 16; ++i) { const int p = F.tid + NTHR * i, r = p >> 6, c = p & 63; \
        dst[i] = *(const v4u*)((r < 64 ? ybase + (size_t)r * D : wbase + (size_t)(r - 64) * 1024) + (h_) * 512 + 8 * c); }
#define CTX_ST(src) _Pragma("unroll") for (int i = 0; i < 16; ++i) { const int p = F.tid + NTHR * i, r = p >> 6, c = p & 63; *(LAS v4u*)(F.lds + r * RS + 16 * c) = src[i]; }
#define CTX_MM() _Pragma("unroll") for (int s = 0; s < 16; ++s) { const v4u x = *(const LAS v4u*)(xl + 64 * s), w0 = *(const LAS v4u*)(wl + 64 * s), w1 = *(const LAS v4u*)(wl + 16 * RS + 64 * s); \
        acc[0] = __builtin_amdgcn_mfma_f32_16x16x32_bf16(__builtin_bit_cast(pg8::bf16x8, w0), __builtin_bit_cast(pg8::bf16x8, x), acc[0], 0, 0, 0); \
        acc[1] = __builtin_amdgcn_mfma_f32_16x16x32_bf16(__builtin_bit_cast(pg8::bf16x8, w1), __builtin_bit_cast(pg8::bf16x8, x), acc[1], 0, 0, 0); }
    CTX_LD(st, 0) CTX_LD(st2, 1)
    f32x4 gv[2], xv[2];
#pragma unroll
    for (int c = 0; c < 2; ++c) { const int col = 64 * ct + 16 * (cg0 + c) + 4 * fq; const size_t off = (size_t)row * 1024 + col;
        gv[c] = *(const f32x4*)(gp + col);
        if (l == 0) xv[c] = *(const f32x4*)(INP(I_CTX) + (size_t)(row - NLAT) * 1024 + col);
        else { const uint2 w = *(const uint2*)(XB + off); xv[c] = (f32x4){bf2f(w.x & 0xffffu), __builtin_bit_cast(float, w.x & 0xffff0000u), bf2f(w.y & 0xffffu), __builtin_bit_cast(float, w.y & 0xffff0000u)}; } }
    CTX_ST(st) LDS_WAIT(); __syncthreads();
    CTX_MM()
    __syncthreads();
    CTX_ST(st2) LDS_WAIT(); __syncthreads();
    CTX_MM()
#undef CTX_LD
#undef CTX_ST
#undef CTX_MM
#pragma unroll
    for (int c = 0; c < 2; ++c) { const int col = 64 * ct + 16 * (cg0 + c) + 4 * fq; const size_t off = (size_t)row * 1024 + col;
        f32x4 x = xv[c]; const f32x4 g = gv[c];
        x.x += g.x * acc[c][0]; x.y += g.y * acc[c][1]; x.z += g.z * acc[c][2]; x.w += g.w * acc[c][3];
        const unsigned long long o = (unsigned long long)pk2(x.x, x.y) | ((unsigned long long)pk2(x.z, x.w) << 32);
        __hip_atomic_store((unsigned long long*)(XB + off), o, __ATOMIC_RELAXED, __HIP_MEMORY_SCOPE_AGENT); }
    __syncthreads();
}

__device__ __forceinline__ void s6_norm2_router(Frame& F, int l, int tile0, int ntiles, int wgi, int nwg, unsigned* extra_ctr, unsigned extra_want) {
    typedef float f32x2 __attribute__((ext_vector_type(2)));
    LAS v4u* WI = (LAS v4u*)F.lds;
    LAS float* MAB = (LAS float*)(F.lds + 65536);
    { const v4u* RI = WSP(v4u, WS_RIMG) + (size_t)l * 4096;
#pragma unroll
      for (int i = 0; i < 8; ++i) WI[F.tid + NTHR * i] = RI[F.tid + NTHR * i]; }
    const float* MS = WSP(float, WS_MODS) + (size_t)l * 5 * 6144; bf16* HX = HXP(); int* ENT = WSP(int, WS_ENT); const bf16* XB = XBP();
    const float* g2 = INP(I_GN2) + l * 1024;
    const int fr = F.lane & 15, fq = F.lane >> 4;
    const int ngroups = (ntiles - tile0) >> 3, nmain = ngroups < nwg ? ngroups : nwg, nextra = (ngroups - nmain) * 8;
    const int main_tile = tile0 + wgi * 8 + F.wave, extra_tile = tile0 + nmain * 8 + wgi;
    const bool has_main = wgi < nmain, has_extra = wgi < nextra;
    if (has_main) {
#pragma unroll
        for (int k = 0; k < 2; ++k) { const float* m = MS + (size_t)row_set((k ? extra_tile : tile0 + wgi * 8) * 16) * 6144;
            if (k == 0 || has_extra) for (int c = F.tid; c < 1024; c += NTHR) { MAB[k * 2048 + c] = g2[c] * (m[4 * 1024 + c] + 1.0f); MAB[k * 2048 + 1024 + c] = m[3 * 1024 + c]; } } }
    LDS_WAIT(); __syncthreads();
    const int nk = !has_main ? 0 : (has_extra && F.wave == 0) ? 2 : 1;
    for (int k = 0; k < nk; ++k) {
        const LAS float* MA = MAB + k * 2048; const LAS float* MB = MA + 1024;
        if (k == 1 && extra_ctr) {
            if (F.lane == 0) { unsigned sp = 0; while (__hip_atomic_load(extra_ctr, __ATOMIC_RELAXED, __HIP_MEMORY_SCOPE_AGENT) < extra_want && ++sp < (1u << 22)) __builtin_amdgcn_s_sleep(2); }
            __builtin_amdgcn_fence(__ATOMIC_ACQUIRE, "agent"); VM_WAIT(); }
        const int row = (k ? extra_tile : main_tile) * 16 + fr;
        const bf16* xr = XB + (size_t)row * D + 8 * fq; bf16* hxr = HX + (size_t)row * D + 8 * fq;
        v4u xv[32];
#pragma unroll
        for (int s = 0; s < 32; ++s) xv[s] = *(const v4u*)(xr + 32 * s);
        f32x2 q2[4] = {{0.f, 0.f}, {0.f, 0.f}, {0.f, 0.f}, {0.f, 0.f}};
#pragma unroll
        for (int s = 0; s < 32; ++s) { const unsigned d[4] = {xv[s].x, xv[s].y, xv[s].z, xv[s].w};
#pragma unroll
            for (int p = 0; p < 4; ++p) { const f32x2 v = {bf2f(d[p] & 0xffffu), __builtin_bit_cast(float, d[p] & 0xffff0000u)}; q2[p] += v * v; } }
#pragma unroll
        for (int s = 0; s < 32; ++s) asm volatile("" : "+v"(xv[s]));
        const f32x2 qq = (q2[0] + q2[1]) + (q2[2] + q2[3]);
        float ss = qq.x + qq.y; ss += __shfl_xor(ss, 16); ss += __shfl_xor(ss, 32);
        const float rstd = rsq_(ss * (1.0f / D) + EPS);
        pg8::f32x4 acc = {0.f, 0.f, 0.f, 0.f};
#pragma unroll
        for (int s = 0; s < 32; ++s) { const unsigned d[4] = {xv[s].x, xv[s].y, xv[s].z, xv[s].w};
            const f32x4 a0 = *(const LAS f32x4*)(MA + 32 * s + 8 * fq), a1 = *(const LAS f32x4*)(MA + 32 * s + 8 * fq + 4), b0 = *(const LAS f32x4*)(MB + 32 * s + 8 * fq), b1 = *(const LAS f32x4*)(MB + 32 * s + 8 * fq + 4);
            const f32x2 av[4] = {{a0.x, a0.y}, {a0.z, a0.w}, {a1.x, a1.y}, {a1.z, a1.w}}, bv[4] = {{b0.x, b0.y}, {b0.z, b0.w}, {b1.x, b1.y}, {b1.z, b1.w}};
            unsigned h[4], lo[4];
#pragma unroll
            for (int p = 0; p < 4; ++p) { const f32x2 x = {bf2f(d[p] & 0xffffu), __builtin_bit_cast(float, d[p] & 0xffff0000u)};
                const f32x2 xn = (x * rstd) * av[p] + bv[p];
                h[p] = pk2(xn.x, xn.y);
                const f32x2 r = xn - (f32x2){bf2f(h[p] & 0xffffu), __builtin_bit_cast(float, h[p] & 0xffff0000u)};
                lo[p] = pk2(r.x, r.y); }
            const v4u hv = {h[0], h[1], h[2], h[3]}, lv = {lo[0], lo[1], lo[2], lo[3]};
            *(v4u*)(hxr + 32 * s) = hv;
            const v4u wh = WI[(s * 2 + 0) * 64 + F.lane], wl = WI[(s * 2 + 1) * 64 + F.lane];
            acc = __builtin_amdgcn_mfma_f32_16x16x32_bf16(__builtin_bit_cast(pg8::bf16x8, wh), __builtin_bit_cast(pg8::bf16x8, hv), acc, 0, 0, 0);
            acc = __builtin_amdgcn_mfma_f32_16x16x32_bf16(__builtin_bit_cast(pg8::bf16x8, wh), __builtin_bit_cast(pg8::bf16x8, lv), acc, 0, 0, 0);
            acc = __builtin_amdgcn_mfma_f32_16x16x32_bf16(__builtin_bit_cast(pg8::bf16x8, wl), __builtin_bit_cast(pg8::bf16x8, hv), acc, 0, 0, 0);
            if (s & 1) __builtin_amdgcn_sched_barrier(0); }
        float mx = fmaxf(fmaxf(acc[0], acc[1]), fmaxf(acc[2], acc[3])); mx = fmaxf(mx, __shfl_xor(mx, 16)); mx = fmaxf(mx, __shfl_xor(mx, 32));
        const float e0 = __expf(acc[0] - mx), e1 = __expf(acc[1] - mx), e2 = __expf(acc[2] - mx), e3 = __expf(acc[3] - mx);
        float den = (e0 + e1) + (e2 + e3); den += __shfl_xor(den, 16); den += __shfl_xor(den, 32);
        const float rden = 1.0f / den;
        if (row < NLAT) { float* af = WSP(float, WS_AFFL) + ((size_t)((row >> 13) * 16 + 4 * fq)) * SEQ + (row & (SEQ - 1));
            af[0] = e0 * rden; af[SEQ] = e1 * rden; af[2 * SEQ] = e2 * rden; af[3 * SEQ] = e3 * rden; }
        else { const int rc = row - NLAT; float* af = WSP(float, WS_AFFC) + ((size_t)((rc >> 8) * 16 + 4 * fq)) * CTXL + (rc & (CTXL - 1));
            af[0] = e0 * rden; af[CTXL] = e1 * rden; af[2 * CTXL] = e2 * rden; af[3 * CTXL] = e3 * rden; }
        *(v4u*)(ENT + (size_t)row * 16 + 4 * fq) = (v4u){0xffffffffu, 0xffffffffu, 0xffffffffu, 0xffffffffu};
    }
    __syncthreads();
}
__device__ __forceinline__ void s7_topk_problem(Frame& F, const float* aff, int n, int cap, int slab_base, int tokrow_base, int e) {
    LAS unsigned* keys = (LAS unsigned*)F.lds;
    LAS unsigned* hist = keys + 8192;
    LAS unsigned* wtot = hist + 256;
    LAS unsigned* ctl = wtot + 16;
    if (n == SEQ) {
        float kv[16];
#pragma unroll
        for (int i = 0; i < 16; ++i) kv[i] = aff[F.tid + NTHR * i];
#pragma unroll
        for (int i = 0; i < 16; ++i) keys[F.tid + NTHR * i] = __builtin_bit_cast(unsigned, kv[i]);
    } else for (int i = F.tid; i < n; i += NTHR) keys[i] = __builtin_bit_cast(unsigned, aff[i]);
    unsigned prefix = 0u, mask = 0u; int kk = cap;
    for (int pass = 0; pass < 4; ++pass) { const int shift = 24 - 8 * pass;
        if (F.tid < 256) hist[F.tid] = 0u;
        LDS_WAIT(); __syncthreads();
        for (int i = F.tid; i < n; i += NTHR) { const unsigned k = keys[i]; if ((k & mask) == prefix) atomicAdd((unsigned*)&hist[(k >> shift) & 255u], 1u); }
        LDS_WAIT(); __syncthreads();
        if (F.wave == 0) {
            const v4u c = *(const LAS v4u*)(hist + 4 * F.lane); const unsigned s4 = c.x + c.y + c.z + c.w; unsigned suf = s4;
#pragma unroll
            for (int d = 1; d < 64; d <<= 1) { const unsigned t = __shfl_down(suf, d); if (F.lane + d < 64) suf += t; }
            const unsigned above = suf - s4;
            if (above < (unsigned)kk && suf >= (unsigned)kk) { unsigned cum = above; int bin;
                if (cum + c.w >= (unsigned)kk) bin = 3; else { cum += c.w; if (cum + c.z >= (unsigned)kk) bin = 2; else { cum += c.z; if (cum + c.y >= (unsigned)kk) bin = 1; else { cum += c.y; bin = 0; } } }
                ctl[0] = (unsigned)(4 * F.lane + bin); ctl[1] = (unsigned)kk - cum; } }
        LDS_WAIT(); __syncthreads();
        prefix |= ctl[0] << shift; mask |= 0xFFu << shift; kk = (int)ctl[1];
        __syncthreads();
    }
    const unsigned T = prefix;
    const int per = (n + NTHR - 1) / NTHR, i0 = F.tid * per;
    unsigned ngt = 0u, neq = 0u;
    for (int i = i0; i < i0 + per && i < n; ++i) { const unsigned k = keys[i]; ngt += k > T; neq += k == T; }
    unsigned igt = ngt, ieq = neq;
#pragma unroll
    for (int d = 1; d < 64; d <<= 1) { const unsigned a = __shfl_up(igt, d), b = __shfl_up(ieq, d); if (F.lane >= d) { igt += a; ieq += b; } }
    if (F.lane == 63) { wtot[2 * F.wave] = igt; wtot[2 * F.wave + 1] = ieq; }
    LDS_WAIT(); __syncthreads();
    unsigned bgt = igt - ngt, beq = ieq - neq;
    for (int w = 0; w < F.wave; ++w) { bgt += wtot[2 * w]; beq += wtot[2 * w + 1]; }
    int* IDX = WSP(int, WS_IDX); float* GV = WSP(float, WS_GVAL); int* ENT = WSP(int, WS_ENT);
    for (int i = i0; i < i0 + per && i < n; ++i) { const unsigned k = keys[i];
        const bool sel = k > T || (k == T && (int)beq < kk);
        if (sel) { const int slot = (int)bgt + ((int)beq < kk ? (int)beq : kk); const int sr = slab_base + slot, tr = tokrow_base + i;
            IDX[sr] = tr; GV[sr] = __builtin_bit_cast(float, k); ENT[(size_t)tr * 16 + e] = sr; }
        bgt += k > T; beq += k == T; }
    __syncthreads();
}
__device__ __forceinline__ void s8_gather(Frame& F, bool do_ctx) {
    const int gw = F.wg * NWAVES + F.wave, NGW = F.G * NWAVES;
    const int* IDX = WSP(int, WS_IDX); const bf16* HX = HXP(); bf16* XE = WSP(bf16, WS_REGB);
    const int total = SLAB_L + (do_ctx ? NE * 128 : 0);
    for (int i = gw; i < total; i += NGW) {
        const int sr = i < SLAB_L ? i : SLAB_L + ((i - SLAB_L) >> 7) * 256 + ((i - SLAB_L) & 127);
        const int tr = IDX[sr];
        const v4u a = *(const v4u*)(HX + (size_t)tr * D + 8 * F.lane), b = *(const v4u*)(HX + (size_t)tr * D + 512 + 8 * F.lane);
        *(v4u*)(XE + (size_t)sr * D + 8 * F.lane) = a; *(v4u*)(XE + (size_t)sr * D + 512 + 8 * F.lane) = b; }
}
__device__ __forceinline__ void s11_finish_row(Frame& F, int l, int row, bf16* xr, f32x4 (&v)[4], const f32x4 (&acc)[4], bool last) {
    const float* MS = WSP(float, WS_MODS); const int s = row_set(row);
    const float* gate = MS + ((size_t)l * 5 + s) * 6144 + 5 * 1024;
#pragma unroll
    for (int j = 0; j < 4; ++j) v[j] += *(const f32x4*)(gate + ROWCOL(F.lane, j)) * acc[j];
    if (!last) {
        store_row8(xr, F.lane, v);
        const float* m = MS + ((size_t)(l + 1) * 5 + s) * 6144;
        norm_mod_store8(v, INP(I_GN1) + (l + 1) * 1024, m, m + 1024, HXP() + (size_t)row * D, F.lane);
    } else {
        float ss = 0.f;
#pragma unroll
        for (int j = 0; j < 4; ++j) ss += (v[j].x * v[j].x + v[j].y * v[j].y) + (v[j].z * v[j].z + v[j].w * v[j].w);
        const float rstd = rsq_(wave_sum_fast(ss) * (1.0f / D) + EPS);
#pragma unroll
        for (int j = 0; j < 4; ++j) *(f32x4*)(OUTP() + (size_t)row * D + ROWCOL(F.lane, j)) = v[j] * rstd * *(const f32x4*)(INP(I_GF) + ROWCOL(F.lane, j));
    }
}
__device__ __forceinline__ void s11_combine(Frame& F, int l, bool do_ctx, bool last) {
    const int gw = F.wg * NWAVES + F.wave, NGW = F.G * NWAVES;
    const bf16* YS = WSP(bf16, WS_REGB); const int* ENT = WSP(int, WS_ENT); bf16* XB = XBP();
    const int npairs = (do_ctx ? NROW : NLAT) / 2;
    v4u ra_[2], rb_[2]; int ent = -1;
    const int nfull = npairs / NGW, left = npairs - nfull * NGW, xw = (left + F.G - 1) / F.G;
    const int xp = nfull * NGW + F.wg * xw + F.wave, ntrips = nfull + ((F.wave < xw && xp < npairs) ? 1 : 0);
#define TRIP_PAIR(k) ((k) < nfull ? gw + (k) * NGW : xp)
    if (ntrips > 0) { const bf16* xr = XB + (size_t)(2 * TRIP_PAIR(0)) * D;
#pragma unroll
        for (int h = 0; h < 2; ++h) { ra_[h] = *(const v4u*)(xr + 8 * F.lane + 512 * h); rb_[h] = *(const v4u*)(xr + D + 8 * F.lane + 512 * h); }
        ent = F.lane < 32 ? ENT[(size_t)(2 * TRIP_PAIR(0)) * 16 + F.lane] : -1; }
    for (int k = 0; k < ntrips; ++k) {
        const int rp = TRIP_PAIR(k);
        const int ra = 2 * rp; bf16* xa = XB + (size_t)ra * D; bf16* xb = xa + D;
        f32x4 aa[4], ab[4]; v4u na_[2], nb_[2]; int nent = -1; const bool more = k + 1 < ntrips;
#pragma unroll
        for (int j = 0; j < 4; ++j) { aa[j] = (f32x4){0.f, 0.f, 0.f, 0.f}; ab[j] = (f32x4){0.f, 0.f, 0.f, 0.f}; }
        if (more) { const int rn = 2 * TRIP_PAIR(k + 1); const bf16* xr = XB + (size_t)rn * D;
#pragma unroll
            for (int h = 0; h < 2; ++h) { na_[h] = *(const v4u*)(xr + 8 * F.lane + 512 * h); nb_[h] = *(const v4u*)(xr + D + 8 * F.lane + 512 * h); }
            nent = F.lane < 32 ? ENT[(size_t)rn * 16 + F.lane] : -1; }
        const unsigned long long bm = __ballot(ent >= 0);
        unsigned ma = (unsigned)bm & 0xffffu, mb = ((unsigned)bm >> 16) & 0xffffu;
        do {
            int sa[4], sb[4]; float wa[4], wb[4];
#pragma unroll
            for (int j = 0; j < 4; ++j) {
                if (ma) { const int e = __builtin_ctz(ma); ma &= ma - 1; sa[j] = __builtin_amdgcn_readlane(ent, e); wa[j] = 1.f; } else { sa[j] = 0; wa[j] = 0.f; }
                if (mb) { const int e = __builtin_ctz(mb); mb &= mb - 1; sb[j] = __builtin_amdgcn_readlane(ent, 16 + e); wb[j] = 1.f; } else { sb[j] = 0; wb[j] = 0.f; } }
            v4u ya[4][2], yb[4][2];
#pragma unroll
            for (int j = 0; j < 4; ++j)
#pragma unroll
                for (int h = 0; h < 2; ++h) { ya[j][h] = *(const v4u*)(YS + (size_t)sa[j] * D + 8 * F.lane + 512 * h); yb[j][h] = *(const v4u*)(YS + (size_t)sb[j] * D + 8 * F.lane + 512 * h); }
#pragma unroll
            for (int j = 0; j < 4; ++j)
#pragma unroll
                for (int h = 0; h < 2; ++h) {
                    aa[2 * h].x += wa[j] * bf2f(ya[j][h].x & 0xffffu); aa[2 * h].y += wa[j] * bf2f(ya[j][h].x >> 16); aa[2 * h].z += wa[j] * bf2f(ya[j][h].y & 0xffffu); aa[2 * h].w += wa[j] * bf2f(ya[j][h].y >> 16);
                    aa[2 * h + 1].x += wa[j] * bf2f(ya[j][h].z & 0xffffu); aa[2 * h + 1].y += wa[j] * bf2f(ya[j][h].z >> 16); aa[2 * h + 1].z += wa[j] * bf2f(ya[j][h].w & 0xffffu); aa[2 * h + 1].w += wa[j] * bf2f(ya[j][h].w >> 16);
                    ab[2 * h].x += wb[j] * bf2f(yb[j][h].x & 0xffffu); ab[2 * h].y += wb[j] * bf2f(yb[j][h].x >> 16); ab[2 * h].z += wb[j] * bf2f(yb[j][h].y & 0xffffu); ab[2 * h].w += wb[j] * bf2f(yb[j][h].y >> 16);
                    ab[2 * h + 1].x += wb[j] * bf2f(yb[j][h].z & 0xffffu); ab[2 * h + 1].y += wb[j] * bf2f(yb[j][h].z >> 16); ab[2 * h + 1].z += wb[j] * bf2f(yb[j][h].w & 0xffffu); ab[2 * h + 1].w += wb[j] * bf2f(yb[j][h].w >> 16); }
        } while (ma | mb);
        f32x4 va[4], vb[4];
#pragma unroll
        for (int h = 0; h < 2; ++h) {
            va[2 * h] = (f32x4){bf2f(ra_[h].x & 0xffffu), bf2f(ra_[h].x >> 16), bf2f(ra_[h].y & 0xffffu), bf2f(ra_[h].y >> 16)}; va[2 * h + 1] = (f32x4){bf2f(ra_[h].z & 0xffffu), bf2f(ra_[h].z >> 16), bf2f(ra_[h].w & 0xffffu), bf2f(ra_[h].w >> 16)};
            vb[2 * h] = (f32x4){bf2f(rb_[h].x & 0xffffu), bf2f(rb_[h].x >> 16), bf2f(rb_[h].y & 0xffffu), bf2f(rb_[h].y >> 16)}; vb[2 * h + 1] = (f32x4){bf2f(rb_[h].z & 0xffffu), bf2f(rb_[h].z >> 16), bf2f(rb_[h].w & 0xffffu), bf2f(rb_[h].w >> 16)}; }
        s11_finish_row(F, l, ra, xa, va, aa, last);
        s11_finish_row(F, l, ra + 1, xb, vb, ab, last);
        if (more) { ent = nent;
#pragma unroll
            for (int h = 0; h < 2; ++h) { ra_[h] = na_[h]; rb_[h] = nb_[h]; } }
    }
#undef TRIP_PAIR
}

constexpr int N_PHASES = 26;
#define PH_IN(k) (lo <= (k) && (k) < hi)
#define PH_FILL_OK(k) ((k) == 3 || (k) == 4 || (k) == 5 || (k) == 6 || (k) == 8 || (k) == 9 || (k) == 12 || (k) == 15 || (k) == 16 || (k) == 17 || (k) == 18)
#define PH_SEAM(k) do { if ((k) + 1 < hi) { if (PH_FILL_OK(k)) xcd_barrier_fill(bar, F, true); else xcd_barrier(bar); } } while (0)
#ifndef DUP_PHASE
#define DUP_PHASE (-1)
#endif
#ifndef DUP_N
#define DUP_N 1
#endif
#define PH_BEGIN(k) if (PH_IN(k)) { for (int rep_ = 0; rep_ < ((k) == DUP_PHASE ? DUP_N : 1); ++rep_) { if (rep_) xcd_barrier(bar); relaunder(F);
#define PH_END(k) } PH_SEAM(k); }
template <int l> __device__ __forceinline__ void layer_steps(Frame& F, const Args& args, const XcdBarrier& bar, const int lo, const int hi) {
    constexpr int P0 = l == 0 ? 3 : 15;
    constexpr bool last = l == 1, do_ctx = !last;
    PH_BEGIN(P0 + 0)
        pg8::Gemm g{(pg8::bf16_t*)HXP(), WSP(pg8::bf16_t, WS_WIN) + (size_t)l * INC * 1024, NROW, INC, D, nullptr};
        pg8::StaticOrder S; S.init(NROW, INC, F.G, F.wg);
        pg8::EpiInProj E{WSP(pg8::bf16_t, WS_REGA), PXC, (pg8::bf16_t*)ZBP()};
        pg8::gemm_phase<pg8::EpiInProj, pg8::StaticOrder, true, true>(F.lds, g, S, E);
        if (F.wg >= 164) filler(F, do_ctx ? 2 : 1, -1);
        PH_END(P0 + 0)
    PH_BEGIN(P0 + 1)
        for (int u = F.wg; u < NB * 64; u += F.G) dft1_unit(F, u >> 6, u & 63);
        lru_a_phase(F, l);
        if (do_ctx && F.wg >= 32) filler(F, 1, -1);
        PH_END(P0 + 1)
    PH_BEGIN(P0 + 2)
        if (F.wg >= 192) s3_carries(F, (F.wg - 192) * NWAVES + F.wave);
        { LAS bf16* t2l = (LAS bf16*)(F.lds + 67584);
          const bf16* T2 = WSP(bf16, WS_T2M);
          for (int i = F.tid; i < 64 * 16; i += NTHR) { const int r = i >> 4, c = i & 15; *(LAS v4u*)(t2l + r * 136 + c * 8) = *(const v4u*)(T2 + r * 128 + c * 8); }
          LDS_WAIT(); __syncthreads();
          if (do_ctx && F.wg < 16) { const int b = F.wg >> 2, mq = F.wg & 3;
              dft2_unit(F, l, WSP(bf16, WS_TCM), 512, 64 * mq, 4, WSP(bf16, WS_REGA) + (size_t)(NLAT + CTXL * b) * PXC + PX_Z, PXC, (size_t)64 * PXC, 0.0078125f, NLAT + CTXL * b + 64 * mq, 1, nullptr);
          } else { const int w0 = do_ctx ? 16 : 0, nw = F.G - w0;
              dft2_latent_loop(F, l, F.wg - w0, nw, NB * 128, t2l); } }
        PH_END(P0 + 2)
    PH_BEGIN(P0 + 3)
        const int nc = do_ctx ? NCHUNK : 512;
        if (do_ctx) sc_phase(F, l, nc, 16, F.G - 16); else sc_phase(F, l, nc, 0, F.G);
        lru_b_phase(F, l, nc);
        PH_END(P0 + 3)
    PH_BEGIN(P0 + 4)
        pg8::Gemm g{(pg8::bf16_t*)HXP(), WSP(pg8::bf16_t, WS_WOUT) + (size_t)l * 1024 * 1024, NLAT, D, D, nullptr};
        pg8::StaticOrder S; S.init(NLAT, D, F.G, F.wg);
        pg8::EpiResid E{INP(I_X), INP(I_CTX), (pg8::bf16_t*)XBP(), WSP(float, WS_MODS) + (size_t)l * 5 * 6144 + 2 * 1024, NLAT, l == 0};
        pg8::gemm_phase<pg8::EpiResid, pg8::StaticOrder, true, true>(F.lds, g, S, E);
        PH_END(P0 + 4)
    PH_BEGIN(P0 + 5)
        if (do_ctx) {
            int* IDX = WSP(int, WS_IDX); for (int i = F.wg * NTHR + F.tid; i < NE * 256; i += F.G * NTHR) IDX[SLAB_L + i] = NLAT;
            unsigned* ctr = WSP(unsigned, WS_CTL) + 192 + 64 * l;
            ctx_outproj_tile(F, l);
            VM_WAIT(); __syncthreads();
            if (F.tid == 0) __hip_atomic_fetch_add(ctr, 1u, __ATOMIC_RELAXED, __HIP_MEMORY_SCOPE_AGENT);
            relaunder(F);
            s6_norm2_router(F, l, 0, NROW / 16, F.wg, F.G, ctr, (unsigned)F.G);
        } else s6_norm2_router(F, l, 0, NLAT / 16, F.wg, F.G, nullptr, 0u);
        PH_END(P0 + 5)
    PH_BEGIN(P0 + 6)
        const int np = do_ctx ? 128 : 64;
        if (F.wg >= np) { if (do_ctx) filler(F, 0, l, 2 * 16 * 256); else filler(F, 2, -1); }
        for (int p = F.wg; p < np; p += F.G) {
            if (p < 64) { const int b = p >> 4, e = p & 15; s7_topk_problem(F, WSP(float, WS_AFFL) + (size_t)p * SEQ, SEQ, CAP_L, (b * 16 + e) * CAP_L, b * SEQ, e); }
            else { const int q = p - 64, b = q >> 4, e = q & 15; s7_topk_problem(F, WSP(float, WS_AFFC) + (size_t)q * CTXL, CTXL, CAP_C, SLAB_L + e * 256 + b * CAP_C, NLAT + b * CTXL, e); } }
        filler(F, 0, l, do_ctx ? 2 * 16 * 256 : N_EXP_ITEMS);
        PH_END(P0 + 6)
    PH_BEGIN(P0 + 8)
        pg8::Gemm g{(pg8::bf16_t*)HXP(), WSP(pg8::bf16_t, WS_WGU + (size_t)l * WS_WEXP_L), SLAB_ROWS, NE * 2048, D, WSP(int, WS_IDX)};
        pg8::MoeOrder1 S{F.wg, do_ctx};
        pg8::EpiSwiGLU E{WSP(pg8::bf16_t, WS_REGA), D};
        pg8::gemm_phase<pg8::EpiSwiGLU, pg8::MoeOrder1, true, true, true>(F.lds, g, S, E);
        if (do_ctx && F.wg >= 128) filler(F, 2, -1);
        if (do_ctx) filler(F, 0, l);
        PH_END(P0 + 8)
    PH_BEGIN(P0 + 9)
        pg8::Gemm g{WSP(pg8::bf16_t, WS_REGA), WSP(pg8::bf16_t, WS_WD + (size_t)l * WS_WEXP_L), SLAB_ROWS, NE * 1024, D, nullptr};
        pg8::MoeOrder2 S{F.wg, do_ctx};
        pg8::EpiScaleBf16 E{WSP(pg8::bf16_t, WS_REGB), D, WSP(float, WS_GVAL)};
        pg8::gemm_phase<pg8::EpiScaleBf16, pg8::MoeOrder2, true, true>(F.lds, g, S, E);
        if (do_ctx && F.wg >= 64) filler(F, 2, -1);
        PH_END(P0 + 9)
    PH_BEGIN(P0 + 10) s11_combine(F, l, do_ctx, last); PH_END(P0 + 10)
}
__global__ void __launch_bounds__(NTHR, 2) fwd(Args args) {
    extern __shared__ __attribute__((aligned(16))) unsigned char lds_raw[];
    Frame F;
    F.lds = (LAS unsigned char*)lds_raw;
    F.tid = threadIdx.x; F.lane = F.tid & 63; F.wave = __builtin_amdgcn_readfirstlane(F.tid >> 6);
    F.G = gridDim.x; F.wg = blockIdx.x;
    volatile LAS unsigned* MISC = (volatile LAS unsigned*)(F.lds + MISC_OFF);
    if (F.tid < 64) MISC[F.tid] = 0u;
    if (F.tid == 0) { LAS unsigned long long* PT = (LAS unsigned long long*)(F.lds + PT_OFF);
#pragma unroll
        for (int i = 0; i < N_IN; ++i) PT[i] = (unsigned long long)args.in[i];
        PT[N_IN] = (unsigned long long)args.out; PT[N_IN + 1] = (unsigned long long)args.ws; }
    LDS_WAIT(); __syncthreads();
    const int lo = args.ph_lo, hi = args.ph_hi;
    unsigned* barw = (unsigned*)(args.ws + WS_CTL) + CW_BAR + args.bar_region * XCD_BAR_WORDS;
    XcdBarrier bar; bar.bar = barw; bar.x = 0; bar.st = MISC + 8;
    if (hi - lo > 1) bar = xcd_barrier_post(barw, MISC + 8);
    PH_BEGIN(0) p0_prep(F); PH_END(0)
    PH_BEGIN(1) p0b_mods(F); PH_END(1)
    PH_BEGIN(2) s0_norm1(F); PH_END(2)
    layer_steps<0>(F, args, bar, lo, hi);
    layer_steps<1>(F, args, bar, lo, hi);
}

extern "C" void kernel_launch(void* const* d_in, const int* in_sizes, int n_in, void* d_out, int out_size, void* d_ws, size_t ws_size, hipStream_t stream) {
    static int grid = 0;
    if (grid == 0) {
        if (n_in != N_IN || out_size != NLAT * D || ws_size < WS_END) { fprintf(stderr, "kernel_launch: unexpected shapes (n_in %d, out %d, ws %zu, need %zu)\n", n_in, out_size, ws_size, (size_t)WS_END); grid = -1; return; }
        int dev = 0, cus = 0, per_cu = 0;
        if (hipGetDevice(&dev) != hipSuccess || hipDeviceGetAttribute(&cus, hipDeviceAttributeMultiprocessorCount, dev) != hipSuccess) { grid = -1; return; }
        if (hipFuncSetAttribute((const void*)fwd, hipFuncAttributeMaxDynamicSharedMemorySize, LDS_BYTES) != hipSuccess) { fprintf(stderr, "kernel_launch: hipFuncSetAttribute failed\n"); grid = -1; return; }
        if (hipOccupancyMaxActiveBlocksPerMultiprocessor(&per_cu, (const void*)fwd, NTHR, LDS_BYTES) != hipSuccess || per_cu < 1) { fprintf(stderr, "kernel_launch: occupancy query says %d\n", per_cu); }
        (void)hipGetLastError();
        grid = cus;
        if (grid != 256) { fprintf(stderr, "kernel_launch: needs a 256-CU device (got %d)\n", grid); grid = -1; return; }
    }
    if (grid < 0) return;
    (void)hipMemsetAsync((char*)d_ws + WS_CTL, 0, CTL_ZERO_BYTES, stream);
    Args a{};
    for (int i = 0; i < N_IN; ++i) a.in[i] = (const float*)d_in[i];
    a.out = (float*)d_out; a.ws = (unsigned char*)d_ws;
#ifndef ONE_LAUNCH
#define ONE_LAUNCH 1
#endif
#ifndef PROBE_K
#define PROBE_K (-1)
#endif
#ifndef PROBE_N
#define PROBE_N 1
#endif
    if (PROBE_K >= 0) {
        a.ph_lo = 0; a.ph_hi = PROBE_K + 1; a.bar_region = 0; hipLaunchKernelGGL(fwd, dim3(grid), dim3(NTHR), LDS_BYTES, stream, a);
        for (int r = 1; r < PROBE_N; ++r) { a.ph_lo = PROBE_K; a.ph_hi = PROBE_K + 1; hipLaunchKernelGGL(fwd, dim3(grid), dim3(NTHR), LDS_BYTES, stream, a); }
        if (PROBE_K + 1 < N_PHASES) { a.ph_lo = PROBE_K + 1; a.ph_hi = N_PHASES; a.bar_region = 1; hipLaunchKernelGGL(fwd, dim3(grid), dim3(NTHR), LDS_BYTES, stream, a); }
    } else if (ONE_LAUNCH) { a.ph_lo = 0; a.ph_hi = N_PHASES; hipLaunchKernelGGL(fwd, dim3(grid), dim3(NTHR), LDS_BYTES, stream, a); }
    else for (int ph = 0; ph < N_PHASES; ++ph) { a.ph_lo = ph; a.ph_hi = ph + 1; hipLaunchKernelGGL(fwd, dim3(grid), dim3(NTHR), LDS_BYTES, stream, a); }
}
```
